# Optimizing an MI355X kernel written in HIP

```python
import math
import jax, jax.numpy as jnp
from jax import lax
import numpy as np

D_MODEL = 2048
BATCH = 4
SEQ = 4096
DEPTH = 2

N_MIXERS = 2
N_A_LAYERS = (DEPTH + 1) // 2
N_B_LAYERS = DEPTH // 2
BLOCK_Q = 128
ROPE_THETA = 10000.0

DA_HEAD_DIM = 128
DA_HEADS = D_MODEL // (2 * DA_HEAD_DIM)
DA_V_DIM = 2 * DA_HEAD_DIM
DA_QK_WIDTH = DA_HEADS * 2 * DA_HEAD_DIM
DA_V_WIDTH = DA_HEADS * DA_V_DIM
DA_IN = 2 * DA_QK_WIDTH + DA_V_WIDTH

FX_HEAD_DIM = 128
FX_HEADS = D_MODEL // FX_HEAD_DIM
FX_WIDTH = FX_HEADS * FX_HEAD_DIM
FX_IN = 3 * FX_WIDTH + FX_HEADS
FORGET_BIAS_INIT = 3.0

N_GROUPS = 4
EXPERTS_PER_GROUP = 8
EXPERT_DFF = D_MODEL // 4
TOP_K_INNER = 2

LN_EPS = 1e-5
RMS_EPS = 1e-5
DEEPNORM_ALPHA = (2.0 * DEPTH) ** 0.25
DEEPNORM_BETA = (8.0 * DEPTH) ** -0.25

kernel_name = "hybrid_diffattn_fox_hmoe_deepnorm_adaln"


def layer_norm(x, g, b):
    x32 = x.astype(jnp.float32)
    mu = jnp.mean(x32, axis=-1, keepdims=True)
    var = jnp.mean(jnp.square(x32 - mu), axis=-1, keepdims=True)
    y = (x32 - mu) * lax.rsqrt(var + LN_EPS)
    return (y * g.astype(jnp.float32) + b.astype(jnp.float32)).astype(x.dtype)


def rms_norm(x, g):
    x32 = x.astype(jnp.float32)
    y = x32 * lax.rsqrt(jnp.mean(jnp.square(x32), axis=-1, keepdims=True) + RMS_EPS)
    return (y * g.astype(jnp.float32)).astype(x.dtype)


def adaln_modulation(c, w_mod, b_mod):
    m = jax.nn.silu(c) @ w_mod + b_mod
    shift, scale, g = jnp.split(m, 3, axis=-1)
    return shift[:, None, :], scale[:, None, :], 1.0 + g[:, None, :]


def apply_rope(x, positions):
    d = x.shape[-1]
    inv_freq = jnp.power(ROPE_THETA, -jnp.arange(0, d, 2, dtype=jnp.float32) / d)
    ang = positions.astype(jnp.float32)[:, None] * inv_freq[None, :]
    cos = jnp.cos(ang)[:, None, :]
    sin = jnp.sin(ang)[:, None, :]
    x32 = x.astype(jnp.float32)
    x1, x2 = jnp.split(x32, 2, axis=-1)
    out = jnp.concatenate([x1 * cos - x2 * sin, x2 * cos + x1 * sin], axis=-1)
    return out.astype(x.dtype)


def causal_mask(i, length):
    q_pos = i * BLOCK_Q + jnp.arange(BLOCK_Q)
    k_pos = jnp.arange(length)
    return q_pos[:, None] >= k_pos[None, :]


def diff_lambda_init(layer_idx):
    return 0.8 - 0.6 * math.exp(-0.3 * (layer_idx - 1))


def differential_attention(h, positions, w_in, lam_q1, lam_k1, lam_q2, lam_k2, subln_w, w_out, lam_init):
    B, S, _ = h.shape
    proj = h @ w_in
    q, k, v = jnp.split(proj, [DA_QK_WIDTH, 2 * DA_QK_WIDTH], axis=-1)
    q = apply_rope(q.reshape(B, S, 2 * DA_HEADS, DA_HEAD_DIM), positions)
    k = apply_rope(k.reshape(B, S, 2 * DA_HEADS, DA_HEAD_DIM), positions)
    q = q.reshape(B, S, DA_HEADS, 2, DA_HEAD_DIM).transpose(0, 2, 3, 1, 4)
    k = k.reshape(B, S, DA_HEADS, 2, DA_HEAD_DIM).transpose(0, 2, 3, 1, 4)
    v = v.reshape(B, S, DA_HEADS, DA_V_DIM).transpose(0, 2, 1, 3)
    f32 = jnp.float32
    lam = (jnp.exp(jnp.sum(lam_q1.astype(f32) * lam_k1.astype(f32)))
           - jnp.exp(jnp.sum(lam_q2.astype(f32) * lam_k2.astype(f32))) + lam_init)
    scale = DA_HEAD_DIM ** -0.5
    outs = []
    for i in range(S // BLOCK_Q):
        L = (i + 1) * BLOCK_Q
        q_blk = q[:, :, :, i * BLOCK_Q:L]
        s = jnp.einsum('bhcqd,bhckd->bhcqk', q_blk, k[:, :, :, :L]).astype(f32) * scale
        s = jnp.where(causal_mask(i, L), s, -jnp.inf)
        p = jax.nn.softmax(s, axis=-1)
        a = p[:, :, 0] - lam * p[:, :, 1]
        outs.append(jnp.einsum('bhqk,bhkd->bhqd', a.astype(v.dtype), v[:, :, :L]))
    o = jnp.concatenate(outs, axis=2)
    o = rms_norm(o, subln_w) * (1.0 - lam_init)
    o = o.transpose(0, 2, 1, 3).reshape(B, S, DA_V_WIDTH)
    return o @ w_out


def forgetting_attention(h, w_in, forget_bias, w_out):
    B, S, _ = h.shape
    proj = h @ w_in
    q, k, v, f_logit = jnp.split(proj, [FX_WIDTH, 2 * FX_WIDTH, 3 * FX_WIDTH], axis=-1)
    q = q.reshape(B, S, FX_HEADS, FX_HEAD_DIM).transpose(0, 2, 1, 3)
    k = k.reshape(B, S, FX_HEADS, FX_HEAD_DIM).transpose(0, 2, 1, 3)
    v = v.reshape(B, S, FX_HEADS, FX_HEAD_DIM).transpose(0, 2, 1, 3)
    f32 = jnp.float32
    log_f = jax.nn.log_sigmoid(f_logit.astype(f32) + forget_bias.astype(f32))
    cum = jnp.cumsum(log_f, axis=1).transpose(0, 2, 1)
    scale = FX_HEAD_DIM ** -0.5
    outs = []
    for i in range(S // BLOCK_Q):
        L = (i + 1) * BLOCK_Q
        q_blk = q[:, :, i * BLOCK_Q:L]
        s = jnp.einsum('bhqd,bhkd->bhqk', q_blk, k[:, :, :L]).astype(f32) * scale
        s = s + (cum[:, :, i * BLOCK_Q:L, None] - cum[:, :, None, :L])
        s = jnp.where(causal_mask(i, L), s, -jnp.inf)
        p = jax.nn.softmax(s, axis=-1)
        outs.append(jnp.einsum('bhqk,bhkd->bhqd', p.astype(v.dtype), v[:, :, :L]))
    o = jnp.concatenate(outs, axis=2)
    o = o.transpose(0, 2, 1, 3).reshape(B, S, FX_WIDTH)
    return o @ w_out


def hierarchical_moe(h, w_group, b_group, w_router, b_router, w_gate, w_up, w_down):
    B, S, D = h.shape
    t = h.reshape(B * S, D)
    f32 = jnp.float32
    g_logits = (t @ w_group + b_group).astype(f32)
    g_probs = jax.nn.softmax(g_logits, axis=-1)
    g_idx = jnp.argmax(g_logits, axis=-1)
    g_w = jnp.take_along_axis(g_probs, g_idx[:, None], axis=1)[:, 0]
    e_all = (jnp.einsum('nd,gde->nge', t, w_router) + b_router).astype(f32)
    e_logits = jnp.take_along_axis(e_all, g_idx[:, None, None], axis=1)[:, 0]
    top_v, top_i = lax.top_k(e_logits, TOP_K_INNER)
    top_p = jax.nn.softmax(top_v, axis=-1)
    combine = jnp.sum(jax.nn.one_hot(top_i, EXPERTS_PER_GROUP, dtype=f32) * top_p[..., None], axis=1)
    weights = (g_w[:, None] * combine).astype(t.dtype)
    out = jnp.zeros_like(t)
    for g in range(N_GROUPS):
        wg = jnp.where((g_idx == g)[:, None], weights, jnp.zeros_like(weights))
        a = jnp.einsum('nd,edf->nef', t, w_gate[g])
        u = jnp.einsum('nd,edf->nef', t, w_up[g])
        hid = jax.nn.silu(a) * u * wg[:, :, None]
        out = out + jnp.einsum('nef,efd->nd', hid, w_down[g])
    return out.reshape(B, S, D)


def setup_inputs(seed: int = 0) -> dict:
    key = jax.random.key(seed)
    ks = jax.random.split(key, 32)
    nrm = jax.random.normal
    D = D_MODEL
    s_d = D ** -0.5
    x = nrm(ks[0], (BATCH, SEQ, D), jnp.float32)
    c = nrm(ks[1], (BATCH, D), jnp.float32)
    mix_mod_w = nrm(ks[2], (DEPTH, D, 3 * D)) * s_d * 0.1
    mix_mod_b = nrm(ks[3], (DEPTH, 3 * D)) * 0.02
    mix_ln_g = 1.0 + 0.02 * nrm(ks[4], (DEPTH, D))
    mix_ln_b = 0.02 * nrm(ks[5], (DEPTH, D))
    a_w_qk = nrm(ks[6], (N_A_LAYERS, D, 2 * DA_QK_WIDTH)) * s_d
    a_w_v = nrm(ks[7], (N_A_LAYERS, D, DA_V_WIDTH)) * s_d * DEEPNORM_BETA
    a_w_in = jnp.concatenate([a_w_qk, a_w_v], axis=-1)
    a_lam_q1 = 0.1 * nrm(ks[8], (N_A_LAYERS, DA_HEAD_DIM))
    a_lam_k1 = 0.1 * nrm(ks[9], (N_A_LAYERS, DA_HEAD_DIM))
    a_lam_q2 = 0.1 * nrm(ks[10], (N_A_LAYERS, DA_HEAD_DIM))
    a_lam_k2 = 0.1 * nrm(ks[11], (N_A_LAYERS, DA_HEAD_DIM))
    a_subln_w = 1.0 + 0.02 * nrm(ks[12], (N_A_LAYERS, DA_V_DIM))
    a_w_out = nrm(ks[13], (N_A_LAYERS, DA_V_WIDTH, D)) * DA_V_WIDTH ** -0.5 * DEEPNORM_BETA
    b_w_qk = nrm(ks[14], (N_B_LAYERS, D, 2 * FX_WIDTH)) * s_d
    b_w_v = nrm(ks[15], (N_B_LAYERS, D, FX_WIDTH)) * s_d * DEEPNORM_BETA
    b_w_f = nrm(ks[16], (N_B_LAYERS, D, FX_HEADS)) * s_d * 0.5
    b_w_in = jnp.concatenate([b_w_qk, b_w_v, b_w_f], axis=-1)
    b_forget_bias = FORGET_BIAS_INIT + 0.5 * nrm(ks[17], (N_B_LAYERS, FX_HEADS))
    b_w_out = nrm(ks[18], (N_B_LAYERS, FX_WIDTH, D)) * FX_WIDTH ** -0.5 * DEEPNORM_BETA
    ffn_mod_w = nrm(ks[19], (DEPTH, D, 3 * D)) * s_d * 0.1
    ffn_mod_b = nrm(ks[20], (DEPTH, 3 * D)) * 0.02
    ffn_ln_g = 1.0 + 0.02 * nrm(ks[21], (DEPTH, D))
    ffn_ln_b = 0.02 * nrm(ks[22], (DEPTH, D))
    moe_w_group = nrm(ks[23], (DEPTH, D, N_GROUPS)) * s_d
    moe_b_group = 0.01 * nrm(ks[24], (DEPTH, N_GROUPS))
    moe_w_router = nrm(ks[25], (DEPTH, N_GROUPS, D, EXPERTS_PER_GROUP)) * s_d
    moe_b_router = 0.01 * nrm(ks[26], (DEPTH, N_GROUPS, EXPERTS_PER_GROUP))
    moe_w_gate = nrm(ks[27], (DEPTH, N_GROUPS, EXPERTS_PER_GROUP, D, EXPERT_DFF)) * s_d
    moe_w_up = nrm(ks[28], (DEPTH, N_GROUPS, EXPERTS_PER_GROUP, D, EXPERT_DFF)) * s_d * DEEPNORM_BETA
    moe_w_down = nrm(ks[29], (DEPTH, N_GROUPS, EXPERTS_PER_GROUP, EXPERT_DFF, D)) * EXPERT_DFF ** -0.5 * DEEPNORM_BETA
    return {
        "x": x, "c": c,
        "mix_mod_w": mix_mod_w, "mix_mod_b": mix_mod_b, "mix_ln_g": mix_ln_g, "mix_ln_b": mix_ln_b,
        "a_w_in": a_w_in, "a_lam_q1": a_lam_q1, "a_lam_k1": a_lam_k1, "a_lam_q2": a_lam_q2,
        "a_lam_k2": a_lam_k2, "a_subln_w": a_subln_w, "a_w_out": a_w_out,
        "b_w_in": b_w_in, "b_forget_bias": b_forget_bias, "b_w_out": b_w_out,
        "ffn_mod_w": ffn_mod_w, "ffn_mod_b": ffn_mod_b, "ffn_ln_g": ffn_ln_g, "ffn_ln_b": ffn_ln_b,
        "moe_w_group": moe_w_group, "moe_b_group": moe_b_group,
        "moe_w_router": moe_w_router, "moe_b_router": moe_b_router,
        "moe_w_gate": moe_w_gate, "moe_w_up": moe_w_up, "moe_w_down": moe_w_down,
    }


def reference(x, c, mix_mod_w, mix_mod_b, mix_ln_g, mix_ln_b,
              a_w_in, a_lam_q1, a_lam_k1, a_lam_q2, a_lam_k2, a_subln_w, a_w_out,
              b_w_in, b_forget_bias, b_w_out,
              ffn_mod_w, ffn_mod_b, ffn_ln_g, ffn_ln_b,
              moe_w_group, moe_b_group, moe_w_router, moe_b_router,
              moe_w_gate, moe_w_up, moe_w_down):
    S = x.shape[1]
    positions = jnp.arange(S, dtype=jnp.int32)
    for i in range(DEPTH):
        j = i // N_MIXERS
        shift, scale, gate = adaln_modulation(c, mix_mod_w[i], mix_mod_b[i])
        h = x * (1.0 + scale) + shift
        if i % N_MIXERS == 0:
            y = differential_attention(h, positions, a_w_in[j], a_lam_q1[j], a_lam_k1[j],
                                       a_lam_q2[j], a_lam_k2[j], a_subln_w[j], a_w_out[j],
                                       diff_lambda_init(i + 1))
        else:
            y = forgetting_attention(h, b_w_in[j], b_forget_bias[j], b_w_out[j])
        x = layer_norm(DEEPNORM_ALPHA * x + gate * y, mix_ln_g[i], mix_ln_b[i])
        shift, scale, gate = adaln_modulation(c, ffn_mod_w[i], ffn_mod_b[i])
        h = x * (1.0 + scale) + shift
        y = hierarchical_moe(h, moe_w_group[i], moe_b_group[i], moe_w_router[i], moe_b_router[i],
                             moe_w_gate[i], moe_w_up[i], moe_w_down[i])
        x = layer_norm(DEEPNORM_ALPHA * x + gate * y, ffn_ln_g[i], ffn_ln_b[i])
    return x
```

```cpp
#include <hip/hip_runtime.h>
#include <cstdio>
#include <cstdint>
#include <cmath>

namespace {
constexpr int D = 2048, NB = 4, S = 4096, NTOK = NB * S;
constexpr int NTHR = 512;
constexpr int MAXSLOT = 40960;
constexpr int NPANEL = MAXSLOT / 256;
constexpr float LN_EPS = 1e-5f, RMS_EPS = 1e-5f;
constexpr float ALPHA = 1.41421356237309515f;
constexpr float LAM_INIT0 = 0.2f;

template <class F> __global__ void __launch_bounds__(NTHR) k_run(F f, int nvb) {
    for (int vb = blockIdx.x; vb < nvb; vb += gridDim.x) f(vb);
}

__device__ __forceinline__ float wave_sum(float v) {
#pragma unroll
    for (int o = 32; o >= 1; o >>= 1) v += __shfl_xor(v, o);
    return v;
}
__device__ __forceinline__ float wave_max(float v) {
#pragma unroll
    for (int o = 32; o >= 1; o >>= 1) v = fmaxf(v, __shfl_xor(v, o));
    return v;
}

struct ModF {
    const float* c; const float* w0; const float* w1; const float* b0; const float* b1; float* out;
    __device__ void operator()(int vb) const {
        __shared__ float sc[NB][D];
        const int tid = threadIdx.x;
        const int set = vb / 12, nb = vb % 12, n = nb * NTHR + tid;
        const int layer = set >> 1;
        const float* W = ((set & 1) ? w1 : w0) + (size_t)layer * D * 3 * D;
        const float* Bv = ((set & 1) ? b1 : b0) + (size_t)layer * 3 * D;
        __syncthreads();
        for (int i = tid; i < NB * D; i += NTHR) { const float v = c[i]; sc[i / D][i % D] = v / (1.f + expf(-v)); }
        __syncthreads();
        float a0 = 0.f, a1 = 0.f, a2 = 0.f, a3 = 0.f;
#pragma unroll 8
        for (int k = 0; k < D; ++k) { const float w = W[(size_t)k * (3 * D) + n]; a0 += sc[0][k] * w; a1 += sc[1][k] * w; a2 += sc[2][k] * w; a3 += sc[3][k] * w; }
        const float bb = Bv[n];
        float* o = out + (size_t)set * NB * 3 * D + n;
        o[0 * 3 * D] = a0 + bb; o[1 * 3 * D] = a1 + bb; o[2 * 3 * D] = a2 + bb; o[3 * 3 * D] = a3 + bb;
    }
};

struct ModulateF {
    const float* x; const float* mod; float* h;
    __device__ void operator()(int vb) const {
        const size_t i4 = (size_t)vb * NTHR + threadIdx.x;
        const size_t e = i4 * 4; const int t = (int)(e / D), d = (int)(e % D), b = t / S;
        const float4 xv = *(const float4*)(x + e);
        const float4 sh = *(const float4*)(mod + (size_t)b * 3 * D + d);
        const float4 sc = *(const float4*)(mod + (size_t)b * 3 * D + D + d);
        float4 o; o.x = xv.x * (1.f + sc.x) + sh.x; o.y = xv.y * (1.f + sc.y) + sh.y; o.z = xv.z * (1.f + sc.z) + sh.z; o.w = xv.w * (1.f + sc.w) + sh.w;
        *(float4*)(h + e) = o;
    }
};

struct GemmF {
    const float* A; const float* B; float* C;
    const int* rowidx;
    const int* panel_e;
    long long strideBe;
    int lda, ldb, ldc, M, N, K;
    int transB, causal;
    int tilesN, pad0;
    __device__ void operator()(int vb) const {
        __shared__ float As[16][132];
        __shared__ float Bs[16][132];
        const int tm = vb / tilesN, tn = vb % tilesN, m0 = tm * 128, n0 = tn * 128;
        const float* Bp = B;
        if (panel_e) { const int e = panel_e[m0 >> 8]; if (e < 0) return; Bp += (size_t)e * strideBe; }
        if (causal == 1 && n0 > m0 + 127) return;
        int Kend = K; if (causal == 2 && m0 + 128 < K) Kend = m0 + 128;
        const int tid = threadIdx.x, tx = tid & 31, ty = tid >> 5;
        float acc[8][4];
#pragma unroll
        for (int i = 0; i < 8; ++i)
#pragma unroll
            for (int j = 0; j < 4; ++j) acc[i][j] = 0.f;
        const int ar = tid >> 2, ak = (tid & 3) * 4;
        long long arow = m0 + ar; bool aval = arow < M;
        if (rowidx && aval) { const int ri = rowidx[arow]; aval = ri >= 0; arow = ri; }
        const float* Ap = A + (aval ? arow : 0) * (long long)lda + ak;
        int bk, bn; if (!transB) { bk = tid >> 5; bn = (tid & 31) * 4; } else { bn = tid >> 2; bk = (tid & 3) * 4; }
        const bool bval = (n0 + bn) < N;
        for (int k0 = 0; k0 < Kend; k0 += 16) {
            float4 av = make_float4(0.f, 0.f, 0.f, 0.f), bv = make_float4(0.f, 0.f, 0.f, 0.f);
            if (aval) av = *(const float4*)(Ap + k0);
            if (bval) { if (!transB) bv = *(const float4*)(Bp + (size_t)(k0 + bk) * ldb + n0 + bn); else bv = *(const float4*)(Bp + (size_t)(n0 + bn) * ldb + k0 + bk); }
            __syncthreads();
            As[ak + 0][ar] = av.x; As[ak + 1][ar] = av.y; As[ak + 2][ar] = av.z; As[ak + 3][ar] = av.w;
            if (!transB) { *(float4*)&Bs[bk][bn] = bv; } else { Bs[bk + 0][bn] = bv.x; Bs[bk + 1][bn] = bv.y; Bs[bk + 2][bn] = bv.z; Bs[bk + 3][bn] = bv.w; }
            __syncthreads();
#pragma unroll
            for (int kk = 0; kk < 16; ++kk) {
                const float4 a0 = *(const float4*)&As[kk][ty * 8], a1 = *(const float4*)&As[kk][ty * 8 + 4], b = *(const float4*)&Bs[kk][tx * 4];
                const float a[8] = {a0.x, a0.y, a0.z, a0.w, a1.x, a1.y, a1.z, a1.w};
#pragma unroll
                for (int i = 0; i < 8; ++i) { acc[i][0] += a[i] * b.x; acc[i][1] += a[i] * b.y; acc[i][2] += a[i] * b.z; acc[i][3] += a[i] * b.w; }
            }
        }
        const int col = n0 + tx * 4;
        if (col < N) {
#pragma unroll
            for (int i = 0; i < 8; ++i) { const int row = m0 + ty * 8 + i; if (row < M) *(float4*)(C + (size_t)row * ldc + col) = make_float4(acc[i][0], acc[i][1], acc[i][2], acc[i][3]); }
        }
        __syncthreads();
    }
};

struct RopeTab { float inv_freq[64]; };
struct RopeTableF {
    float* tab; RopeTab rt;
    __device__ void operator()(int vb) const {
        const int idx = vb * NTHR + threadIdx.x; const int s = idx >> 6, i = idx & 63;
        const float angf = (float)s * rt.inv_freq[i];
        double r = (double)angf;
        const double k = rint(r * 0.63661977236758134308);
        r = fma(-k, 1.57079632679489655800e+00, r); r = fma(-k, 6.12323399573676603587e-17, r);
        const int q = ((int)k) & 3;
        const double r2 = r * r;
        double sn = -1.0 / 6227020800.0 * -1.0;
        sn = 1.0 / 6227020800.0;
        sn = sn * r2 - 1.0 / 39916800.0; sn = sn * r2 + 1.0 / 362880.0; sn = sn * r2 - 1.0 / 5040.0; sn = sn * r2 + 1.0 / 120.0; sn = sn * r2 - 1.0 / 6.0; sn = sn * r2 + 1.0; sn = sn * r;
        double cs = -1.0 / 87178291200.0;
        cs = cs * r2 + 1.0 / 479001600.0; cs = cs * r2 - 1.0 / 3628800.0; cs = cs * r2 + 1.0 / 40320.0; cs = cs * r2 - 1.0 / 720.0; cs = cs * r2 + 1.0 / 24.0; cs = cs * r2 - 0.5; cs = cs * r2 + 1.0;
        double c, sv;
        if (q == 0) { c = cs; sv = sn; } else if (q == 1) { c = -sn; sv = cs; } else if (q == 2) { c = -cs; sv = -sn; } else { c = sn; sv = -cs; }
        tab[(size_t)idx * 2] = (float)c; tab[(size_t)idx * 2 + 1] = (float)sv;
    }
};
struct RopeF {
    float* p; const float* tab; int ld, pad0;
    __device__ void operator()(int vb) const {
        const int idx = vb * NTHR + threadIdx.x;
        const int i = idx & 63, head = (idx >> 6) & 31, s = idx >> 11;
        float* q = p + (size_t)s * ld + head * 128 + i;
        const float c = tab[((size_t)s * 64 + i) * 2], sn = tab[((size_t)s * 64 + i) * 2 + 1];
        const float x1 = q[0], x2 = q[64];
        q[0] = x1 * c - x2 * sn; q[64] = x2 * c + x1 * sn;
    }
};

struct LamF {
    const float* q1; const float* k1; const float* q2; const float* k2; float* lam;
    __device__ void operator()(int vb) const {
        const int tid = threadIdx.x;
        if (tid < 64) {
            float a = q1[tid] * k1[tid] + q1[tid + 64] * k1[tid + 64], b = q2[tid] * k2[tid] + q2[tid + 64] * k2[tid + 64];
            a = wave_sum(a); b = wave_sum(b);
            if (tid == 0) lam[0] = expf(a) - expf(b) + LAM_INIT0;
        }
    }
};

struct SoftmaxF {
    float* S1; float* S2;
    const float* lam; const float* cum;
    float scale; int pad0;
    __device__ void operator()(int vb) const {
        const int tid = threadIdx.x, wave = tid >> 6, lane = tid & 63;
        const int i = vb * 8 + wave;
        float* r1 = S1 + (size_t)i * S; float* r2 = S2 ? S2 + (size_t)i * S : nullptr;
        const float ci = cum ? cum[i] : 0.f;
        float m1 = -INFINITY, m2 = -INFINITY;
        for (int j = lane; j <= i; j += 64) {
            float s = r1[j] * scale; if (cum) s += ci - cum[j]; m1 = fmaxf(m1, s);
            if (r2) m2 = fmaxf(m2, r2[j] * scale);
        }
        m1 = wave_max(m1); m2 = wave_max(m2);
        float l1 = 0.f, l2 = 0.f;
        for (int j = lane; j <= i; j += 64) {
            float s = r1[j] * scale; if (cum) s += ci - cum[j]; l1 += expf(s - m1);
            if (r2) l2 += expf(r2[j] * scale - m2);
        }
        l1 = wave_sum(l1); l2 = wave_sum(l2);
        const float lm = r2 ? lam[0] : 0.f;
        const int jend = ((i >> 7) + 1) << 7;
        for (int j = lane; j < jend; j += 64) {
            float o = 0.f;
            if (j <= i) {
                float s = r1[j] * scale; if (cum) s += ci - cum[j];
                o = expf(s - m1) / l1;
                if (r2) o -= lm * (expf(r2[j] * scale - m2) / l2);
            }
            r1[j] = o;
        }
    }
};

struct RmsF {
    float* o; const float* w;
    __device__ void operator()(int vb) const {
        const int tid = threadIdx.x, wave = tid >> 6, lane = tid & 63;
        const size_t g = (size_t)vb * 8 + wave;
        float4 v = *(float4*)(o + g * 256 + lane * 4);
        float ss = v.x * v.x + v.y * v.y + v.z * v.z + v.w * v.w; ss = wave_sum(ss);
        const float r = 1.0f / sqrtf(ss * (1.f / 256.f) + RMS_EPS) * (1.f - LAM_INIT0);
        const float4 ww = *(const float4*)(w + lane * 4);
        v.x = v.x * r * ww.x; v.y = v.y * r * ww.y; v.z = v.z * r * ww.z; v.w = v.w * r * ww.w;
        *(float4*)(o + g * 256 + lane * 4) = v;
    }
};

struct CumF {
    const float* proj; const float* fb; float* cum; int ld, pad0;
    __device__ void operator()(int vb) const {
        __shared__ float tot[NTHR];
        const int h = vb, tid = threadIdx.x;
        float v[8]; float run = 0.f;
#pragma unroll
        for (int j = 0; j < 8; ++j) { const float x = proj[(size_t)(tid * 8 + j) * ld + 6144 + h] + fb[h];
            const float ls = fminf(x, 0.f) - log1pf(expf(-fabsf(x))); run += ls; v[j] = run; }
        __syncthreads();
        tot[tid] = run;
        __syncthreads();
        if (tid == 0) { float a = 0.f; for (int i = 0; i < NTHR; ++i) { const float t = tot[i]; tot[i] = a; a += t; } }
        __syncthreads();
        const float off = tot[tid];
#pragma unroll
        for (int j = 0; j < 8; ++j) cum[(size_t)h * S + tid * 8 + j] = v[j] + off;
        __syncthreads();
    }
};

struct LnF {
    const float* x; const float* ya; const int* tok_slot;
    const float* mod; const float* g; const float* bta; float* out;
    __device__ void operator()(int vb) const {
        const int tid = threadIdx.x, wave = tid >> 6, lane = tid & 63;
        const int t = vb * 8 + wave, b = t / S;
        const float* xr = x + (size_t)t * D; const float* gt = mod + (size_t)b * 3 * D + 2 * D;
        const float* y0; const float* y1 = nullptr;
        if (tok_slot) { y0 = ya + (size_t)tok_slot[2 * t] * D; y1 = ya + (size_t)tok_slot[2 * t + 1] * D; } else y0 = ya + (size_t)t * D;
        float4 z[8]; float sum = 0.f;
#pragma unroll
        for (int i = 0; i < 8; ++i) { const int d = (i * 64 + lane) * 4;
            const float4 xv = *(const float4*)(xr + d), gv = *(const float4*)(gt + d); float4 yv = *(const float4*)(y0 + d);
            if (y1) { const float4 y2 = *(const float4*)(y1 + d); yv.x += y2.x; yv.y += y2.y; yv.z += y2.z; yv.w += y2.w; }
            z[i].x = ALPHA * xv.x + (1.f + gv.x) * yv.x; z[i].y = ALPHA * xv.y + (1.f + gv.y) * yv.y; z[i].z = ALPHA * xv.z + (1.f + gv.z) * yv.z; z[i].w = ALPHA * xv.w + (1.f + gv.w) * yv.w;
            sum += (z[i].x + z[i].y) + (z[i].z + z[i].w); }
        sum = wave_sum(sum); const float mu = sum * (1.f / D);
        float var = 0.f;
#pragma unroll
        for (int i = 0; i < 8; ++i) { const float a = z[i].x - mu, bq = z[i].y - mu, c = z[i].z - mu, dd = z[i].w - mu; var += (a * a + bq * bq) + (c * c + dd * dd); }
        var = wave_sum(var) * (1.f / D);
        const float rs = 1.0f / sqrtf(var + LN_EPS);
#pragma unroll
        for (int i = 0; i < 8; ++i) { const int d = (i * 64 + lane) * 4; const float4 gg = *(const float4*)(g + d), bb = *(const float4*)(bta + d);
            float4 o; o.x = (z[i].x - mu) * rs * gg.x + bb.x; o.y = (z[i].y - mu) * rs * gg.y + bb.y; o.z = (z[i].z - mu) * rs * gg.z + bb.z; o.w = (z[i].w - mu) * rs * gg.w + bb.w;
            *(float4*)(out + (size_t)t * D + d) = o; }
    }
};

struct InitF {
    int* cnt; int* slot_token; int* panel_e;
    __device__ void operator()(int vb) const {
        const int i = vb * NTHR + threadIdx.x;
        if (i < 32) cnt[i] = 0;
        if (i < NPANEL) panel_e[i] = -1;
        if (i < MAXSLOT) slot_token[i] = -1;
    }
};
struct RouteF {
    const float* h; const float* wg; const float* bg; const float* wr; const float* br;
    int* cnt; int* tok_e; int* tok_pos; float* tok_w;
    __device__ void operator()(int vb) const {
        const int tid = threadIdx.x, wave = tid >> 6, lane = tid & 63;
        const int t = vb * 8 + wave;
        const float* hr = h + (size_t)t * D;
        float hv[32];
#pragma unroll
        for (int i = 0; i < 32; ++i) hv[i] = hr[lane + 64 * i];
        float p0 = 0.f, p1 = 0.f, p2 = 0.f, p3 = 0.f;
#pragma unroll
        for (int i = 0; i < 32; ++i) { const float4 w = *(const float4*)(wg + (size_t)(lane + 64 * i) * 4); p0 += hv[i] * w.x; p1 += hv[i] * w.y; p2 += hv[i] * w.z; p3 += hv[i] * w.w; }
        float gl[4] = {wave_sum(p0) + bg[0], wave_sum(p1) + bg[1], wave_sum(p2) + bg[2], wave_sum(p3) + bg[3]};
        int gi = 0; float gm = gl[0];
#pragma unroll
        for (int c = 1; c < 4; ++c) if (gl[c] > gm) { gm = gl[c]; gi = c; }
        float gs = 0.f;
#pragma unroll
        for (int c = 0; c < 4; ++c) gs += expf(gl[c] - gm);
        const float gw = 1.f / gs;
        const float* wrg = wr + (size_t)gi * D * 8;
        float e[8];
#pragma unroll
        for (int c = 0; c < 8; ++c) e[c] = 0.f;
#pragma unroll
        for (int i = 0; i < 32; ++i) { const float4 wa = *(const float4*)(wrg + (size_t)(lane + 64 * i) * 8), wb = *(const float4*)(wrg + (size_t)(lane + 64 * i) * 8 + 4);
            e[0] += hv[i] * wa.x; e[1] += hv[i] * wa.y; e[2] += hv[i] * wa.z; e[3] += hv[i] * wa.w; e[4] += hv[i] * wb.x; e[5] += hv[i] * wb.y; e[6] += hv[i] * wb.z; e[7] += hv[i] * wb.w; }
#pragma unroll
        for (int c = 0; c < 8; ++c) e[c] = wave_sum(e[c]) + br[gi * 8 + c];
        int i0 = 0; float v0 = e[0];
#pragma unroll
        for (int c = 1; c < 8; ++c) if (e[c] > v0) { v0 = e[c]; i0 = c; }
        int i1 = -1; float v1 = -INFINITY;
#pragma unroll
        for (int c = 0; c < 8; ++c) if (c != i0 && e[c] > v1) { v1 = e[c]; i1 = c; }
        const float ex = expf(v1 - v0), pa = 1.f / (1.f + ex), pb = ex / (1.f + ex);
        if (lane == 0) {
            const int e0 = gi * 8 + i0, e1 = gi * 8 + i1;
            tok_e[2 * t] = e0; tok_e[2 * t + 1] = e1;
            tok_w[2 * t] = gw * pa; tok_w[2 * t + 1] = gw * pb;
            tok_pos[2 * t] = atomicAdd(cnt + e0, 1); tok_pos[2 * t + 1] = atomicAdd(cnt + e1, 1);
        }
    }
};
struct ScatterF {
    const int* cnt; const int* tok_e; const int* tok_pos; const float* tok_w;
    int* tok_slot; int* slot_token; float* slot_w; int* panel_e;
    __device__ void operator()(int vb) const {
        const int i = vb * NTHR + threadIdx.x;
        if (i < 2 * NTOK) {
            const int e = tok_e[i]; int off = 0;
            for (int q = 0; q < e; ++q) off += (cnt[q] + 255) & ~255;
            const int slot = off + tok_pos[i];
            tok_slot[i] = slot; slot_token[slot] = i >> 1; slot_w[slot] = tok_w[i];
        }
        if (vb == 0 && threadIdx.x < 32) {
            const int e = threadIdx.x; int off = 0;
            for (int q = 0; q < e; ++q) off += (cnt[q] + 255) & ~255;
            const int np = (cnt[e] + 255) >> 8;
            for (int p = 0; p < np; ++p) panel_e[(off >> 8) + p] = e;
        }
    }
};
struct HidF {
    float* a; const float* u; const float* slot_w; const int* slot_token; const int* panel_e;
    __device__ void operator()(int vb) const {
        const size_t i4 = (size_t)vb * NTHR + threadIdx.x; const size_t e = i4 * 4; const int slot = (int)(e / 512);
        if (panel_e[slot >> 8] < 0) return;
        float4 o = make_float4(0.f, 0.f, 0.f, 0.f);
        if (slot_token[slot] >= 0) { const float w = slot_w[slot]; const float4 av = *(const float4*)(a + e), uv = *(const float4*)(u + e);
            o.x = av.x / (1.f + expf(-av.x)) * uv.x * w; o.y = av.y / (1.f + expf(-av.y)) * uv.y * w; o.z = av.z / (1.f + expf(-av.z)) * uv.z * w; o.w = av.w / (1.f + expf(-av.w)) * uv.w * w; }
        *(float4*)(a + e) = o;
    }
};

template <class F> void launch(const F& f, int nvb, hipStream_t s) {
    const int grid = nvb < 8192 ? nvb : 8192;
    hipLaunchKernelGGL(k_run<F>, dim3(grid), dim3(NTHR), 0, s, f, nvb);
}
void gemm(hipStream_t st, const float* A, int lda, const float* B, int ldb, float* C, int ldc, int M, int N, int K, int transB, int causal,
          const int* rowidx = nullptr, const int* panel_e = nullptr, long long strideBe = 0) {
    GemmF g{}; g.A = A; g.B = B; g.C = C; g.rowidx = rowidx; g.panel_e = panel_e; g.strideBe = strideBe; g.lda = lda; g.ldb = ldb; g.ldc = ldc; g.M = M; g.N = N; g.K = K;
    g.transB = transB; g.causal = causal; g.tilesN = (N + 127) / 128; g.pad0 = 0;
    launch(g, ((M + 127) / 128) * g.tilesN, st);
}
}

extern "C" void kernel_launch(void* const* d_in, const int* in_sizes, int n_in, void* d_out, int out_size, void* d_ws, size_t ws_size, hipStream_t stream) {
    (void)in_sizes; (void)out_size;
    if (n_in != 27) { fprintf(stderr, "kernel_launch: expected 27 inputs, got %d\n", n_in); return; }
    const float* x = (const float*)d_in[0]; const float* c = (const float*)d_in[1];
    const float* mix_mod_w = (const float*)d_in[2]; const float* mix_mod_b = (const float*)d_in[3]; const float* mix_ln_g = (const float*)d_in[4]; const float* mix_ln_b = (const float*)d_in[5];
    const float* a_w_in = (const float*)d_in[6]; const float* a_lq1 = (const float*)d_in[7]; const float* a_lk1 = (const float*)d_in[8]; const float* a_lq2 = (const float*)d_in[9]; const float* a_lk2 = (const float*)d_in[10];
    const float* a_subln = (const float*)d_in[11]; const float* a_w_out = (const float*)d_in[12];
    const float* b_w_in = (const float*)d_in[13]; const float* b_fb = (const float*)d_in[14]; const float* b_w_out = (const float*)d_in[15];
    const float* ffn_mod_w = (const float*)d_in[16]; const float* ffn_mod_b = (const float*)d_in[17]; const float* ffn_ln_g = (const float*)d_in[18]; const float* ffn_ln_b = (const float*)d_in[19];
    const float* moe_wg = (const float*)d_in[20]; const float* moe_bg = (const float*)d_in[21]; const float* moe_wr = (const float*)d_in[22]; const float* moe_br = (const float*)d_in[23];
    const float* moe_gate = (const float*)d_in[24]; const float* moe_up = (const float*)d_in[25]; const float* moe_down = (const float*)d_in[26];
    float* out = (float*)d_out;

    size_t off = 0; float* ws = (float*)d_ws;
    auto take = [&](size_t n) { float* p = ws + off; off += (n + 63) & ~(size_t)63; return p; };
    float* modv = take((size_t)4 * NB * 3 * D);
    float* ropet = take((size_t)S * 64 * 2);
    float* lam = take(64);
    float* cum = take((size_t)16 * S);
    int* cnt = (int*)take(64);
    int* tok_e = (int*)take(2 * NTOK); int* tok_pos = (int*)take(2 * NTOK); float* tok_w = take(2 * NTOK); int* tok_slot = (int*)take(2 * NTOK);
    int* slot_token = (int*)take(MAXSLOT); float* slot_w = take(MAXSLOT); int* panel_e = (int*)take(256);
    float* xA = take((size_t)NTOK * D); float* xB = take((size_t)NTOK * D); float* hbuf = take((size_t)NTOK * D);
    float* abuf = take((size_t)MAXSLOT * 512); float* ubuf = take((size_t)MAXSLOT * 512);
    float* region = ws + off;
    float* obuf = take((size_t)NTOK * D); float* projb = take((size_t)S * 6160); float* sc1 = take((size_t)S * S); float* sc2 = take((size_t)S * S);
    float* y2 = region;
    if (off * sizeof(float) > ws_size) { fprintf(stderr, "kernel_launch: workspace too small (%zu > %zu)\n", off * sizeof(float), ws_size); return; }

    { ModF f{}; f.c = c; f.w0 = mix_mod_w; f.w1 = ffn_mod_w; f.b0 = mix_mod_b; f.b1 = ffn_mod_b; f.out = modv; launch(f, 48, stream); }
    { RopeTableF f{}; f.tab = ropet; for (int i = 0; i < 64; ++i) f.rt.inv_freq[i] = (float)pow(10000.0, -(2.0 * i) / 128.0); launch(f, S * 64 / NTHR, stream); }
    { LamF f{}; f.q1 = a_lq1; f.k1 = a_lk1; f.q2 = a_lq2; f.k2 = a_lk2; f.lam = lam; launch(f, 1, stream); }
    const float scale = 0.08838834764831845f;

    const float* xin = x;
    for (int layer = 0; layer < 2; ++layer) {
        const float* modm = modv + (size_t)(2 * layer) * NB * 3 * D; const float* modf = modv + (size_t)(2 * layer + 1) * NB * 3 * D;
        { ModulateF f{}; f.x = xin; f.mod = modm; f.h = hbuf; launch(f, NTOK * D / 4 / NTHR, stream); }
        const int ldp = layer == 0 ? 6144 : 6160;
        const float* w_in = layer == 0 ? a_w_in : b_w_in;
        for (int b = 0; b < NB; ++b) {
            gemm(stream, hbuf + (size_t)b * S * D, D, w_in, ldp, projb, ldp, S, ldp, D, 0, 0);
            if (layer == 0) {
                { RopeF f{}; f.p = projb; f.tab = ropet; f.ld = ldp; f.pad0 = 0; launch(f, S * 32 * 64 / NTHR, stream); }
                for (int h = 0; h < 8; ++h) {
                    gemm(stream, projb + (2 * h) * 128, ldp, projb + 2048 + (2 * h) * 128, ldp, sc1, S, S, S, 128, 1, 1);
                    gemm(stream, projb + (2 * h + 1) * 128, ldp, projb + 2048 + (2 * h + 1) * 128, ldp, sc2, S, S, S, 128, 1, 1);
                    { SoftmaxF f{}; f.S1 = sc1; f.S2 = sc2; f.lam = lam; f.cum = nullptr; f.scale = scale; f.pad0 = 0; launch(f, S / 8, stream); }
                    gemm(stream, sc1, S, projb + 4096 + h * 256, ldp, obuf + (size_t)b * S * D + h * 256, D, S, 256, S, 0, 2);
                }
            } else {
                { CumF f{}; f.proj = projb; f.fb = b_fb; f.cum = cum; f.ld = ldp; f.pad0 = 0; launch(f, 16, stream); }
                for (int h = 0; h < 16; ++h) {
                    gemm(stream, projb + h * 128, ldp, projb + 2048 + h * 128, ldp, sc1, S, S, S, 128, 1, 1);
                    { SoftmaxF f{}; f.S1 = sc1; f.S2 = nullptr; f.lam = lam; f.cum = cum + (size_t)h * S; f.scale = scale; f.pad0 = 0; launch(f, S / 8, stream); }
                    gemm(stream, sc1, S, projb + 4096 + h * 128, ldp, obuf + (size_t)b * S * D + h * 128, D, S, 128, S, 0, 2);
                }
            }
        }
        if (layer == 0) { RmsF f{}; f.o = obuf; f.w = a_subln; launch(f, NTOK * 8 / 8, stream); }
        gemm(stream, obuf, D, layer == 0 ? a_w_out : b_w_out, D, hbuf, D, NTOK, D, D, 0, 0);
        { LnF f{}; f.x = xin; f.ya = hbuf; f.tok_slot = nullptr; f.mod = modm; f.g = mix_ln_g + (size_t)layer * D; f.bta = mix_ln_b + (size_t)layer * D; f.out = xA; launch(f, NTOK / 8, stream); }
        { ModulateF f{}; f.x = xA; f.mod = modf; f.h = hbuf; launch(f, NTOK * D / 4 / NTHR, stream); }
        { InitF f{}; f.cnt = cnt; f.slot_token = slot_token; f.panel_e = panel_e; launch(f, MAXSLOT / NTHR, stream); }
        { RouteF f{}; f.h = hbuf; f.wg = moe_wg + (size_t)layer * D * 4; f.bg = moe_bg + layer * 4; f.wr = moe_wr + (size_t)layer * 4 * D * 8; f.br = moe_br + layer * 32;
          f.cnt = cnt; f.tok_e = tok_e; f.tok_pos = tok_pos; f.tok_w = tok_w; launch(f, NTOK / 8, stream); }
        { ScatterF f{}; f.cnt = cnt; f.tok_e = tok_e; f.tok_pos = tok_pos; f.tok_w = tok_w; f.tok_slot = tok_slot; f.slot_token = slot_token; f.slot_w = slot_w; f.panel_e = panel_e;
          launch(f, 2 * NTOK / NTHR, stream); }
        const size_t wl = (size_t)layer * 32 * D * 512;
        gemm(stream, hbuf, D, moe_gate + wl, 512, abuf, 512, MAXSLOT, 512, D, 0, 0, slot_token, panel_e, (long long)D * 512);
        gemm(stream, hbuf, D, moe_up + wl, 512, ubuf, 512, MAXSLOT, 512, D, 0, 0, slot_token, panel_e, (long long)D * 512);
        { HidF f{}; f.a = abuf; f.u = ubuf; f.slot_w = slot_w; f.slot_token = slot_token; f.panel_e = panel_e; launch(f, MAXSLOT * 512 / 4 / NTHR, stream); }
        gemm(stream, abuf, 512, moe_down + wl, D, y2, D, MAXSLOT, D, 512, 0, 0, nullptr, panel_e, (long long)512 * D);
        float* xo = layer == 0 ? xB : out;
        { LnF f{}; f.x = xA; f.ya = y2; f.tok_slot = tok_slot; f.mod = modf; f.g = ffn_ln_g + (size_t)layer * D; f.bta = ffn_ln_b + (size_t)layer * D; f.out = xo; launch(f, NTOK / 8, stream); }
        xin = xB;
    }
}
```

```cpp
#include <hip/hip_runtime.h>
#include <cstdio>
#include <cstdint>
#include <cmath>
#include <cstring>

namespace pg8 {
#define PG8_LAS __attribute__((address_space(3)))
typedef unsigned short bf16_t;
typedef short bf16x8 __attribute__((ext_vector_type(8)));
typedef float f32x4 __attribute__((ext_vector_type(4)));
typedef unsigned u32x4 __attribute__((ext_vector_type(4)));
constexpr int BM = 256, BK = 64, HALF = 128, HTB = HALF * BK * 2  , STAGE_BYTES = 8 * HTB, NXCD = 8, WGM = 8;

__host__ __device__ __forceinline__ int lds_byte(int r, int c) { const int st = (r >> 4) * 2 + (c >> 5), rr = r & 15, cc = c & 31, ob = rr * 64 + cc * 2; return st * 1024 + (ob ^ (((ob >> 9) & 1) << 5)); }
__host__ __device__ __forceinline__ void stage_rc(int b, int& R, int& C) { const int st = b / 1024, sb = b % 1024, swz = sb ^ (((sb >> 9) & 1) << 5); R = (st >> 1) * 16 + swz / 64; C = (st & 1) * 32 + (swz % 64) / 2; }
__host__ __device__ __forceinline__ int perm32(int rho) { const int n = rho >> 4, i = rho & 15; return 8 * (i >> 2) + 4 * n + (i & 3); }

struct Unit { int pm, pn; };
struct Gemm { const bf16_t* A; const bf16_t* Bt; int M, N, K; };

struct StaticOrder {
    int nM, nN, nwg, G, c;
    __host__ __device__ void init(int M, int N, int G_, int c_) { nM = M / BM; nN = N / BM; nwg = nM * nN; G = G_; c = c_; }
    __host__ __device__ bool next(int i, Unit& u) const {
        const long L = (long)i * G + c; if (L >= nwg) return false;
        int wgid = (int)L; { const int q = nwg / NXCD, r = nwg % NXCD, xcd = wgid % NXCD, off = wgid / NXCD; wgid = (xcd < r ? xcd * (q + 1) : r * (q + 1) + (xcd - r) * q) + off; }
        const int nig = WGM * nN, gid = wgid / nig, fm = gid * WGM, gsz = (nM - fm) < WGM ? (nM - fm) : WGM;
        u.pm = fm + ((wgid % nig) % gsz); u.pn = (wgid % nig) / gsz; return true;
    }
    __device__ __forceinline__ void a_ready(const Unit&) const {}
    __device__ __forceinline__ void done(const Unit&) const {}
};

__device__ __forceinline__ unsigned cvt_pk_bf16(float lo, float hi) { unsigned r; asm volatile("v_cvt_pk_bf16_f32 %0, %1, %2" : "=v"(r) : "v"(lo), "v"(hi)); return r; }
typedef float f32x2 __attribute__((ext_vector_type(2)));

struct EpiF32 {
    static constexpr bool PERM = false, AFTER_DRAIN = false;
    float* C; int ldc;
    __device__ __forceinline__ void operator()(const f32x4 (&acc)[2][2][4][2], const Unit& u, int wr, int wc, int fr, int fq) const {
        const int col0 = u.pn * BM + wc * 32 + 4 * fq;
#pragma unroll
        for (int ai = 0; ai < 2; ++ai)
#pragma unroll
            for (int m = 0; m < 4; ++m) { float* rowp = C + (size_t)(u.pm * BM + ai * HALF + wr * 64 + m * 16 + fr) * ldc + col0;
#pragma unroll
                for (int bj = 0; bj < 2; ++bj)
#pragma unroll
                    for (int n = 0; n < 2; ++n) *(f32x4*)(rowp + bj * HALF + n * 16) = acc[ai][bj][m][n]; }
    }
};


struct EpiB16 {
    static constexpr bool PERM = true, AFTER_DRAIN = false;
    bf16_t* C; int ldc;
    __device__ __forceinline__ void operator()(const f32x4 (&acc)[2][2][4][2], const Unit& u, int wr, int wc, int fr, int fq) const {
        const int col0 = u.pn * BM + wc * 32 + 8 * fq;
#pragma unroll
        for (int ai = 0; ai < 2; ++ai)
#pragma unroll
            for (int m = 0; m < 4; ++m) { bf16_t* rowp = C + (size_t)(u.pm * BM + ai * HALF + wr * 64 + m * 16 + fr) * ldc + col0;
#pragma unroll
                for (int bj = 0; bj < 2; ++bj) { const f32x4 v0 = acc[ai][bj][m][0], v1 = acc[ai][bj][m][1];
                    u32x4 w; w.x = cvt_pk_bf16(v0[0], v0[1]); w.y = cvt_pk_bf16(v0[2], v0[3]); w.z = cvt_pk_bf16(v1[0], v1[1]); w.w = cvt_pk_bf16(v1[2], v1[3]);
                    *(u32x4*)(rowp + bj * HALF) = w; } }
    }
};

struct EpiQKV {
    static constexpr bool PERM = true, AFTER_DRAIN = false;
    bf16_t* qkv;
    unsigned* nrm2;
    PG8_LAS float* rowsq;
    const float* rope;
    __device__ __forceinline__ void operator()(const f32x4 (&acc)[2][2][4][2], const Unit& u, int wr, int wc, int fr, int fq) const {
        if (rope && u.pn < 16) {
            const int slot = 2 * u.pn + (wc >> 1), type = slot >> 4, head = slot & 15, i0 = (wc & 1) * 32 + 8 * fq;
            bf16_t* base = qkv + (size_t)type * ((size_t)16384 * 2048);
            f32x4 cn[4];
            { const int row0 = u.pm * BM + wr * 64 + fr, sq0 = row0 & 4095; const f32x4* cs0 = (const f32x4*)(rope + ((size_t)sq0 * 64 + i0) * 2);
#pragma unroll
              for (int q = 0; q < 4; ++q) cn[q] = cs0[q]; }
#pragma unroll
            for (int r = 0; r < 8; ++r) { const int ai = r >> 2, m = r & 3;
                const int row = u.pm * BM + ai * HALF + wr * 64 + m * 16 + fr, b = row >> 12, sq = row & 4095;
                const f32x4 c0 = cn[0], c1 = cn[1], c2 = cn[2], c3 = cn[3];
                if (r + 1 < 8) { const int rn = r + 1, rown = u.pm * BM + (rn >> 2) * HALF + wr * 64 + (rn & 3) * 16 + fr, sqn = rown & 4095; const f32x4* csn = (const f32x4*)(rope + ((size_t)sqn * 64 + i0) * 2);
#pragma unroll
                    for (int q = 0; q < 4; ++q) cn[q] = csn[q]; }
                __builtin_amdgcn_sched_barrier(0);
                float o1[8], o2[8];
#pragma unroll
                for (int n = 0; n < 2; ++n) { const f32x4 x1 = acc[ai][0][m][n], x2 = acc[ai][1][m][n], ca = n == 0 ? c0 : c2, cb = n == 0 ? c1 : c3;
                    o1[4 * n + 0] = x1[0] * ca[0] - x2[0] * ca[1]; o2[4 * n + 0] = x2[0] * ca[0] + x1[0] * ca[1];
                    o1[4 * n + 1] = x1[1] * ca[2] - x2[1] * ca[3]; o2[4 * n + 1] = x2[1] * ca[2] + x1[1] * ca[3];
                    o1[4 * n + 2] = x1[2] * cb[0] - x2[2] * cb[1]; o2[4 * n + 2] = x2[2] * cb[0] + x1[2] * cb[1];
                    o1[4 * n + 3] = x1[3] * cb[2] - x2[3] * cb[3]; o2[4 * n + 3] = x2[3] * cb[2] + x1[3] * cb[3]; }
                bf16_t* dst = base + ((size_t)(b * 16 + head) * 4096 + sq) * 128 + i0;
                u32x4 w; w.x = cvt_pk_bf16(o1[0], o1[1]); w.y = cvt_pk_bf16(o1[2], o1[3]); w.z = cvt_pk_bf16(o1[4], o1[5]); w.w = cvt_pk_bf16(o1[6], o1[7]);
                *(u32x4*)dst = w;
                w.x = cvt_pk_bf16(o2[0], o2[1]); w.y = cvt_pk_bf16(o2[2], o2[3]); w.z = cvt_pk_bf16(o2[4], o2[5]); w.w = cvt_pk_bf16(o2[6], o2[7]);
                *(u32x4*)(dst + 64) = w;
                __builtin_amdgcn_sched_barrier(0); }
            return;
        }
        const int d = wc * 32 + 8 * fq;
        if (nrm2 && u.pn < 16) {
#pragma unroll
            for (int bj = 0; bj < 2; ++bj)
#pragma unroll
                for (int ai = 0; ai < 2; ++ai)
#pragma unroll
                    for (int m = 0; m < 4; ++m) { const f32x4 v0 = acc[ai][bj][m][0], v1 = acc[ai][bj][m][1];
                        float sq = (v0[0] * v0[0] + v0[1] * v0[1]) + (v0[2] * v0[2] + v0[3] * v0[3]) + (v1[0] * v1[0] + v1[1] * v1[1]) + (v1[2] * v1[2] + v1[3] * v1[3]);
                        { const auto r = __builtin_amdgcn_permlane16_swap(__float_as_uint(sq), __float_as_uint(sq), false, false); sq = __uint_as_float(r[0]) + __uint_as_float(r[1]); }
                        { const auto r = __builtin_amdgcn_permlane32_swap(__float_as_uint(sq), __float_as_uint(sq), false, false); sq = __uint_as_float(r[0]) + __uint_as_float(r[1]); }
                        if (fq == 0) rowsq[(wc * 2 + bj) * 256 + ai * HALF + wr * 64 + m * 16 + fr] = sq; }
            asm volatile("s_waitcnt lgkmcnt(0)" ::: "memory"); __builtin_amdgcn_s_barrier();
            { const int t = (wr * 4 + wc) * 64 + fq * 16 + fr;
              float mx = (rowsq[t] + rowsq[512 + t]) + (rowsq[1024 + t] + rowsq[1536 + t]);
              mx = fmaxf(mx, __shfl_xor(mx, 1)); mx = fmaxf(mx, __shfl_xor(mx, 2)); mx = fmaxf(mx, __shfl_xor(mx, 4)); mx = fmaxf(mx, __shfl_xor(mx, 8)); mx = fmaxf(mx, __shfl_xor(mx, 16)); mx = fmaxf(mx, __shfl_xor(mx, 32));
              const int slot = 2 * u.pn + (wr), type = slot >> 4, head = slot & 15, b = (u.pm * BM) >> 12;
              if (fr == 0 && fq == 0) atomicMax(nrm2 + type * 64 + b * 16 + head, __float_as_uint(mx)); }
        }
#pragma unroll
        for (int bj = 0; bj < 2; ++bj) { const int slot = 2 * u.pn + bj, type = slot >> 4, head = slot & 15; bf16_t* base = qkv + (size_t)type * ((size_t)16384 * 2048);
#pragma unroll
            for (int ai = 0; ai < 2; ++ai)
#pragma unroll
                for (int m = 0; m < 4; ++m) { const int row = u.pm * BM + ai * HALF + wr * 64 + m * 16 + fr, b = row >> 12, sq = row & 4095;
                    const f32x4 v0 = acc[ai][bj][m][0], v1 = acc[ai][bj][m][1];
                    u32x4 w; w.x = cvt_pk_bf16(v0[0], v0[1]); w.y = cvt_pk_bf16(v0[2], v0[3]); w.z = cvt_pk_bf16(v1[0], v1[1]); w.w = cvt_pk_bf16(v1[2], v1[3]);
                    *(u32x4*)(base + ((size_t)(b * 16 + head) * 4096 + sq) * 128 + d) = w; } }
    }
};

struct EpiSwiGLU {
    static constexpr bool PERM = true, AFTER_DRAIN = false;
    bf16_t* hid; const float* slot_w;
    __device__ __forceinline__ void operator()(const f32x4 (&acc)[2][2][4][2], const Unit& u, int wr, int wc, int fr, int fq) const {
        const int col = (u.pn & 3) * 128 + wc * 32 + 8 * fq;
        float wv[2][4];
#pragma unroll
        for (int ai = 0; ai < 2; ++ai)
#pragma unroll
            for (int m = 0; m < 4; ++m) wv[ai][m] = slot_w[u.pm * BM + ai * HALF + wr * 64 + m * 16 + fr];
        __builtin_amdgcn_sched_barrier(0);
#pragma unroll
        for (int ai = 0; ai < 2; ++ai)
#pragma unroll
            for (int m = 0; m < 4; ++m) { const int row = u.pm * BM + ai * HALF + wr * 64 + m * 16 + fr; const float w = wv[ai][m];
                float o[8];
#pragma unroll
                for (int n = 0; n < 2; ++n)
#pragma unroll
                    for (int i = 0; i < 4; ++i) { const float g = acc[ai][0][m][n][i], up = acc[ai][1][m][n][i];
                        o[4 * n + i] = g * __builtin_amdgcn_rcpf(1.f + __expf(-g)) * up * w; }
                u32x4 q; q.x = cvt_pk_bf16(o[0], o[1]); q.y = cvt_pk_bf16(o[2], o[3]); q.z = cvt_pk_bf16(o[4], o[5]); q.w = cvt_pk_bf16(o[6], o[7]);
                *(u32x4*)(hid + (size_t)row * 512 + col) = q; }
    }
};
struct EpiScatter {
    static constexpr bool PERM = true, AFTER_DRAIN = false;
    bf16_t* y2; const int* slot_dst;
    __device__ __forceinline__ void operator()(const f32x4 (&acc)[2][2][4][2], const Unit& u, int wr, int wc, int fr, int fq) const {
        const int col = (u.pn & 7) * 256 + wc * 32 + 8 * fq;
        int dv[2][4];
#pragma unroll
        for (int ai = 0; ai < 2; ++ai)
#pragma unroll
            for (int m = 0; m < 4; ++m) dv[ai][m] = slot_dst[u.pm * BM + ai * HALF + wr * 64 + m * 16 + fr];
        __builtin_amdgcn_sched_barrier(0);
#pragma unroll
        for (int ai = 0; ai < 2; ++ai)
#pragma unroll
            for (int m = 0; m < 4; ++m) { const int dst = dv[ai][m];
                if (dst >= 0) {
#pragma unroll
                    for (int bj = 0; bj < 2; ++bj) { const f32x4 v0 = acc[ai][bj][m][0], v1 = acc[ai][bj][m][1];
                        u32x4 q; q.x = cvt_pk_bf16(v0[0], v0[1]); q.y = cvt_pk_bf16(v0[2], v0[3]); q.z = cvt_pk_bf16(v1[0], v1[1]); q.w = cvt_pk_bf16(v1[2], v1[3]);
                        *(u32x4*)(y2 + (size_t)dst * 2048 + col + bj * HALF) = q; } } }
    }
};
struct MoeOrder {
    const int* panel_e; int npan, NJ, G, c;
    __device__ __forceinline__ bool next(int i, Unit& u) const {
        int pm, j;
        if ((G & 7) == 0) { const int xc = c & 7, p0 = (xc * npan) >> 3, p1 = ((xc + 1) * npan) >> 3, idx = (c >> 3) + (G >> 3) * i; if (idx >= (p1 - p0) * NJ) return false; pm = p0 + idx / NJ; j = idx - (idx / NJ) * NJ; }
        else { const int L = i * G + c; if (L >= npan * NJ) return false; pm = L / NJ; j = L - pm * NJ; }
        u.pm = pm; u.pn = panel_e[pm] * NJ + j; return true; }
    __device__ __forceinline__ void a_ready(const Unit&) const {}
    __device__ __forceinline__ void done(const Unit&) const {}
};

template <class Epi, class Sched, bool ALIGN_EPI = false, bool SP2 = false>
__device__ __forceinline__ void gemm_phase(PG8_LAS unsigned char* lds, const Gemm g, const Sched& S, const Epi& E) {
    int tid_ = threadIdx.x; asm volatile("" : "+v"(tid_));
    const int tid = tid_, wid = __builtin_amdgcn_readfirstlane(tid >> 6), lane = tid & 63, wr = wid >> 2, wc = wid & 3, fr = lane & 15, fq = lane >> 4;
    const int K = g.K, nt = K / BK;
    unsigned voffA[2], voffB[2];
#pragma unroll
    for (int i = 0; i < 2; ++i) { int R, C; stage_rc(tid * 16 + i * 8192, R, C); const int Rb = Epi::PERM ? ((R & ~31) + perm32(R & 31)) : R;
        voffA[i] = (unsigned)(R * K + C) * 2u; voffB[i] = (unsigned)(Rb * K + C) * 2u; }
    const size_t kstep = (size_t)(BK * 2);
    const size_t hstep = (size_t)HALF * K * 2;
    const size_t tstep = 2 * hstep;
    const unsigned ldsw = (unsigned)wid * 1024u;
    const int aoff = lds_byte(wr * 64 + fr, fq * 8), boff = lds_byte(wc * 32 + fr, fq * 8);
#define PG8_SA(b, h) (((b) * 2 + (h)) * HTB)
#define PG8_SB(b, h) ((4 + (b) * 2 + (h)) * HTB)
#define PG8_STAGE(bufoff, gbase, voff) do { _Pragma("unroll") for (int _i = 0; _i < 2; ++_i) \
        __builtin_amdgcn_global_load_lds((const unsigned*)((const char*)(gbase) + (voff)[_i]), (PG8_LAS unsigned*)(lds + (bufoff) + ldsw + _i * 8192), 16, 0, 0); } while (0)
#define PG8_LDA(dst, b, h) do { _Pragma("unroll") for (int m = 0; m < 4; ++m) _Pragma("unroll") for (int k = 0; k < 2; ++k) dst[m][k] = *(const PG8_LAS bf16x8*)(lds + PG8_SA(b, h) + aoff + m * 2048 + k * 1024); } while (0)
#define PG8_LDB(dst, b, h) do { _Pragma("unroll") for (int n = 0; n < 2; ++n) _Pragma("unroll") for (int k = 0; k < 2; ++k) dst[n][k] = *(const PG8_LAS bf16x8*)(lds + PG8_SB(b, h) + boff + n * 2048 + k * 1024); } while (0)
#define PG8_MMA(ai, bj, At, Bt) do { __builtin_amdgcn_s_setprio(1); _Pragma("unroll") for (int m = 0; m < 4; ++m) _Pragma("unroll") for (int n = 0; n < 2; ++n) _Pragma("unroll") for (int k = 0; k < 2; ++k) \
        acc[ai][bj][m][n] = __builtin_amdgcn_mfma_f32_16x16x32_bf16(Bt[n][k], At[m][k], acc[ai][bj][m][n], 0, 0, 0); __builtin_amdgcn_s_setprio(0); } while (0)
#define PG8_WAIT_V(n) asm volatile("s_waitcnt vmcnt(" #n ")" ::: "memory")
#define PG8_WAIT_L(n) asm volatile("s_waitcnt lgkmcnt(" #n ")" ::: "memory")
#define PG8_BAR __builtin_amdgcn_s_barrier()
#define PG8_SCHED __builtin_amdgcn_sched_barrier(0)
    Unit cur, nxt; int ui = 0;
    if (!S.next(0, cur)) return;
    f32x4 acc[2][2][4][2];
#pragma unroll
    for (int a = 0; a < 2; ++a)
#pragma unroll
        for (int b = 0; b < 2; ++b)
#pragma unroll
            for (int m = 0; m < 4; ++m)
#pragma unroll
                for (int n = 0; n < 2; ++n) acc[a][b][m][n] = (f32x4){0.f, 0.f, 0.f, 0.f};
    bf16x8 At[4][2], B0[2][2], B1[2][2];
    const char* cA = (const char*)g.A + (size_t)cur.pm * tstep; const char* cB = (const char*)g.Bt + (size_t)cur.pn * tstep;
    S.a_ready(cur);
    if constexpr (SP2) {
        PG8_STAGE(PG8_SB(0, 0), cB, voffB); PG8_STAGE(PG8_SB(0, 1), cB + hstep, voffB); PG8_STAGE(PG8_SA(0, 0), cA, voffA); PG8_STAGE(PG8_SA(0, 1), cA + hstep, voffA);
        if (wr == 1) PG8_BAR;
        PG8_WAIT_V(2); PG8_BAR;
        PG8_STAGE(PG8_SB(1, 0), cB + kstep, voffB); PG8_STAGE(PG8_SA(1, 0), cA + kstep, voffA); PG8_STAGE(PG8_SB(1, 1), cB + hstep + kstep, voffB);
        PG8_WAIT_V(6); PG8_BAR;
    } else {
        PG8_STAGE(PG8_SB(0, 0), cB, voffB); PG8_STAGE(PG8_SA(0, 0), cA, voffA); PG8_STAGE(PG8_SB(0, 1), cB + hstep, voffB); PG8_STAGE(PG8_SA(0, 1), cA + hstep, voffA);
        if (wr == 1) PG8_BAR;
        PG8_WAIT_V(4); PG8_BAR;
        PG8_STAGE(PG8_SB(1, 0), cB + kstep, voffB); PG8_STAGE(PG8_SA(1, 0), cA + kstep, voffA); PG8_STAGE(PG8_SB(1, 1), cB + hstep + kstep, voffB);
        PG8_WAIT_V(6); PG8_BAR;
    }
    for (;;) {
        const bool has_next = S.next(ui + 1, nxt);
        const char* nA = has_next ? (const char*)g.A + (size_t)nxt.pm * tstep : cA; const char* nB = has_next ? (const char*)g.Bt + (size_t)nxt.pn * tstep : cB;
        for (int t = 0; t < nt; t += 2) {
            const bool last = (t == nt - 2);
            const char* a1 = cA + (size_t)(t + 1) * kstep;
            const char* a2 = last ? nA : cA + (size_t)(t + 2) * kstep; const char* b2 = last ? nB : cB + (size_t)(t + 2) * kstep;
            const char* a3 = a2 + kstep; const char* b3 = b2 + kstep;
            if (last && has_next) S.a_ready(nxt);
            if constexpr (SP2) {
            PG8_LDB(B0, 0, 0); PG8_LDB(B1, 0, 1); PG8_SCHED; PG8_LDA(At, 0, 0); PG8_STAGE(PG8_SA(1, 1), a1 + hstep, voffA);
            PG8_WAIT_V(8); PG8_WAIT_L(0); PG8_BAR; PG8_MMA(0, 0, At, B0); PG8_MMA(0, 1, At, B1); PG8_BAR; PG8_SCHED;
            PG8_LDA(At, 0, 1); PG8_STAGE(PG8_SB(0, 0), b2, voffB); PG8_STAGE(PG8_SB(0, 1), b2 + hstep, voffB); PG8_STAGE(PG8_SA(0, 0), a2, voffA);
            PG8_WAIT_V(8); PG8_WAIT_L(0); PG8_BAR; PG8_MMA(1, 0, At, B0); PG8_MMA(1, 1, At, B1); PG8_BAR; PG8_SCHED;
            PG8_LDB(B0, 1, 0); PG8_LDB(B1, 1, 1); PG8_SCHED; PG8_LDA(At, 1, 0); PG8_STAGE(PG8_SA(0, 1), a2 + hstep, voffA);
            PG8_WAIT_V(8); PG8_WAIT_L(0); PG8_BAR; PG8_MMA(0, 0, At, B0); PG8_MMA(0, 1, At, B1); PG8_BAR; PG8_SCHED;
            PG8_LDA(At, 1, 1); PG8_STAGE(PG8_SB(1, 0), b3, voffB); PG8_STAGE(PG8_SB(1, 1), b3 + hstep, voffB); PG8_STAGE(PG8_SA(1, 0), a3, voffA);
            PG8_WAIT_V(8); PG8_WAIT_L(0); PG8_BAR; PG8_MMA(1, 0, At, B0); PG8_MMA(1, 1, At, B1); PG8_BAR; PG8_SCHED;
            } else {
            PG8_LDB(B0, 0, 0); PG8_SCHED; PG8_LDA(At, 0, 0); PG8_STAGE(PG8_SA(1, 1), a1 + hstep, voffA);
            PG8_WAIT_L(8); PG8_BAR; PG8_WAIT_L(0); PG8_MMA(0, 0, At, B0); PG8_BAR; PG8_SCHED;
            PG8_LDB(B1, 0, 1); PG8_STAGE(PG8_SB(0, 0), b2, voffB);
            PG8_BAR; PG8_WAIT_L(0); PG8_MMA(0, 1, At, B1); PG8_BAR;
            PG8_LDA(At, 0, 1); PG8_STAGE(PG8_SA(0, 0), a2, voffA);
            PG8_BAR; PG8_WAIT_L(0); PG8_MMA(1, 0, At, B0); PG8_BAR; PG8_SCHED;
            PG8_STAGE(PG8_SB(0, 1), b2 + hstep, voffB);
            PG8_WAIT_V(6); PG8_BAR; PG8_MMA(1, 1, At, B1); PG8_BAR;
            PG8_LDB(B0, 1, 0); PG8_SCHED; PG8_LDA(At, 1, 0); PG8_STAGE(PG8_SA(0, 1), a2 + hstep, voffA);
            PG8_WAIT_L(8); PG8_BAR; PG8_WAIT_L(0); PG8_MMA(0, 0, At, B0); PG8_BAR; PG8_SCHED;
            PG8_LDB(B1, 1, 1); PG8_STAGE(PG8_SB(1, 0), b3, voffB);
            PG8_BAR; PG8_WAIT_L(0); PG8_MMA(0, 1, At, B1); PG8_BAR;
            PG8_LDA(At, 1, 1); PG8_STAGE(PG8_SA(1, 0), a3, voffA);
            PG8_BAR; PG8_WAIT_L(0); PG8_MMA(1, 0, At, B0); PG8_BAR; PG8_SCHED;
            PG8_STAGE(PG8_SB(1, 1), b3 + hstep, voffB);
            PG8_WAIT_V(6); PG8_BAR; PG8_MMA(1, 1, At, B1); PG8_BAR;
            }
        }
        if constexpr (ALIGN_EPI) { if (wr == 0) PG8_BAR; }
        if constexpr (!Epi::AFTER_DRAIN) { E(acc, cur, wr, wc, fr, fq); S.done(cur); }
        if (!has_next) break;
#pragma unroll
        for (int a = 0; a < 2; ++a)
#pragma unroll
            for (int b = 0; b < 2; ++b)
#pragma unroll
                for (int m = 0; m < 4; ++m)
#pragma unroll
                    for (int n = 0; n < 2; ++n) acc[a][b][m][n] = (f32x4){0.f, 0.f, 0.f, 0.f};
        cur = nxt; cA = nA; cB = nB; ++ui;
        if constexpr (ALIGN_EPI) { if (wr == 1) PG8_BAR; }
    }
    PG8_WAIT_V(0);
    if constexpr (!ALIGN_EPI) { if (wr == 0) PG8_BAR; }
    PG8_BAR;
    if constexpr (Epi::AFTER_DRAIN) { E.fused(acc, cur, wr, wc, fr, fq, lds, wid, lane); S.done(cur); }
#undef PG8_SA
#undef PG8_SB
#undef PG8_STAGE
#undef PG8_LDA
#undef PG8_LDB
#undef PG8_MMA
#undef PG8_WAIT_V
#undef PG8_WAIT_L
#undef PG8_BAR
#undef PG8_SCHED
}
template <class Epi, class Sched>
__device__ __forceinline__ void gemm_phase_gather(PG8_LAS unsigned char* lds, const Gemm g, const int* rowmap, const Sched& S, const Epi& E) {
    constexpr bool ALIGN_EPI = true, SP2 = true;
    int tid_ = threadIdx.x; asm volatile("" : "+v"(tid_));
    const int tid = tid_, wid = __builtin_amdgcn_readfirstlane(tid >> 6), lane = tid & 63, wr = wid >> 2, wc = wid & 3, fr = lane & 15, fq = lane >> 4;
    const int K = g.K, nt = K / BK;
    unsigned voffA[2], voffB[2]; int rowA[2];
#pragma unroll
    for (int i = 0; i < 2; ++i) { int R, C; stage_rc(tid * 16 + i * 8192, R, C); const int Rb = Epi::PERM ? ((R & ~31) + perm32(R & 31)) : R;
        voffA[i] = (unsigned)C * 2u; voffB[i] = (unsigned)(Rb * K + C) * 2u; rowA[i] = R; }
    const size_t kstep = (size_t)(BK * 2);
    const size_t hstep = (size_t)HALF * K * 2;
    const size_t tstep = 2 * hstep;
    const unsigned ldsw = (unsigned)wid * 1024u;
    const int aoff = lds_byte(wr * 64 + fr, fq * 8), boff = lds_byte(wc * 32 + fr, fq * 8);
#define PG8_SA(b, h) (((b) * 2 + (h)) * HTB)
#define PG8_SB(b, h) ((4 + (b) * 2 + (h)) * HTB)
#define PG8_STAGE(bufoff, gbase, voff) do { _Pragma("unroll") for (int _i = 0; _i < 2; ++_i) \
        __builtin_amdgcn_global_load_lds((const unsigned*)((const char*)(gbase) + (voff)[_i]), (PG8_LAS unsigned*)(lds + (bufoff) + ldsw + _i * 8192), 16, 0, 0); } while (0)
#define PG8_LDA(dst, b, h) do { _Pragma("unroll") for (int m = 0; m < 4; ++m) _Pragma("unroll") for (int k = 0; k < 2; ++k) dst[m][k] = *(const PG8_LAS bf16x8*)(lds + PG8_SA(b, h) + aoff + m * 2048 + k * 1024); } while (0)
#define PG8_LDB(dst, b, h) do { _Pragma("unroll") for (int n = 0; n < 2; ++n) _Pragma("unroll") for (int k = 0; k < 2; ++k) dst[n][k] = *(const PG8_LAS bf16x8*)(lds + PG8_SB(b, h) + boff + n * 2048 + k * 1024); } while (0)
#define PG8_MMA(ai, bj, At, Bt) do { __builtin_amdgcn_s_setprio(1); _Pragma("unroll") for (int m = 0; m < 4; ++m) _Pragma("unroll") for (int n = 0; n < 2; ++n) _Pragma("unroll") for (int k = 0; k < 2; ++k) \
        acc[ai][bj][m][n] = __builtin_amdgcn_mfma_f32_16x16x32_bf16(Bt[n][k], At[m][k], acc[ai][bj][m][n], 0, 0, 0); __builtin_amdgcn_s_setprio(0); } while (0)
#define PG8_WAIT_V(n) asm volatile("s_waitcnt vmcnt(" #n ")" ::: "memory")
#define PG8_WAIT_L(n) asm volatile("s_waitcnt lgkmcnt(" #n ")" ::: "memory")
#define PG8_BAR __builtin_amdgcn_s_barrier()
#define PG8_SCHED __builtin_amdgcn_sched_barrier(0)
    Unit cur, nxt; int ui = 0;
    if (!S.next(0, cur)) return;
    unsigned cA0[2], cA1[2], nA0[2], nA1[2];
#define PG8_ROWS(pm_, o0, o1) do { _Pragma("unroll") for (int _i = 0; _i < 2; ++_i) { const int s0_ = rowmap[(pm_) * BM + rowA[_i]], s1_ = rowmap[(pm_) * BM + HALF + rowA[_i]]; \
        o0[_i] = (unsigned)((s0_ < 0 ? 0 : (s0_ >> 1)) * K) * 2u + voffA[_i]; o1[_i] = (unsigned)((s1_ < 0 ? 0 : (s1_ >> 1)) * K) * 2u + voffA[_i]; } } while (0)
    PG8_ROWS(cur.pm, cA0, cA1);
    f32x4 acc[2][2][4][2];
#pragma unroll
    for (int a = 0; a < 2; ++a)
#pragma unroll
        for (int b = 0; b < 2; ++b)
#pragma unroll
            for (int m = 0; m < 4; ++m)
#pragma unroll
                for (int n = 0; n < 2; ++n) acc[a][b][m][n] = (f32x4){0.f, 0.f, 0.f, 0.f};
    bf16x8 At[4][2], B0[2][2], B1[2][2];
    const char* const Ab = (const char*)g.A; const char* cB = (const char*)g.Bt + (size_t)cur.pn * tstep;
    S.a_ready(cur);
    if constexpr (SP2) {
        PG8_STAGE(PG8_SB(0, 0), cB, voffB); PG8_STAGE(PG8_SB(0, 1), cB + hstep, voffB); PG8_STAGE(PG8_SA(0, 0), Ab, cA0); PG8_STAGE(PG8_SA(0, 1), Ab, cA1);
        if (wr == 1) PG8_BAR;
        PG8_WAIT_V(2); PG8_BAR;
        PG8_STAGE(PG8_SB(1, 0), cB + kstep, voffB); PG8_STAGE(PG8_SA(1, 0), Ab + kstep, cA0); PG8_STAGE(PG8_SB(1, 1), cB + hstep + kstep, voffB);
        PG8_WAIT_V(6); PG8_BAR;
    } else {
        static_assert(SP2, "gather variant: SP2 schedule only");
    }
    for (;;) {
        const bool has_next = S.next(ui + 1, nxt);
        const char* nB = has_next ? (const char*)g.Bt + (size_t)nxt.pn * tstep : cB;
        if (has_next) PG8_ROWS(nxt.pm, nA0, nA1); else { nA0[0] = cA0[0]; nA0[1] = cA0[1]; nA1[0] = cA1[0]; nA1[1] = cA1[1]; }
        for (int t = 0; t < nt; t += 2) {
            const bool last = (t == nt - 2);
            const char* a1 = Ab + (size_t)(t + 1) * kstep;
            const char* a2 = last ? Ab : Ab + (size_t)(t + 2) * kstep; const char* b2 = last ? nB : cB + (size_t)(t + 2) * kstep;
            const char* a3 = a2 + kstep; const char* b3 = b2 + kstep;
            unsigned x0[2], x1[2];
            x0[0] = last ? nA0[0] : cA0[0]; x0[1] = last ? nA0[1] : cA0[1]; x1[0] = last ? nA1[0] : cA1[0]; x1[1] = last ? nA1[1] : cA1[1];
            if (last && has_next) S.a_ready(nxt);
            if constexpr (SP2) {
            PG8_LDB(B0, 0, 0); PG8_LDB(B1, 0, 1); PG8_SCHED; PG8_LDA(At, 0, 0); PG8_STAGE(PG8_SA(1, 1), a1, cA1);
            PG8_WAIT_V(8); PG8_WAIT_L(0); PG8_BAR; PG8_MMA(0, 0, At, B0); PG8_MMA(0, 1, At, B1); PG8_BAR; PG8_SCHED;
            PG8_LDA(At, 0, 1); PG8_STAGE(PG8_SB(0, 0), b2, voffB); PG8_STAGE(PG8_SB(0, 1), b2 + hstep, voffB); PG8_STAGE(PG8_SA(0, 0), a2, x0);
            PG8_WAIT_V(8); PG8_WAIT_L(0); PG8_BAR; PG8_MMA(1, 0, At, B0); PG8_MMA(1, 1, At, B1); PG8_BAR; PG8_SCHED;
            PG8_LDB(B0, 1, 0); PG8_LDB(B1, 1, 1); PG8_SCHED; PG8_LDA(At, 1, 0); PG8_STAGE(PG8_SA(0, 1), a2, x1);
            PG8_WAIT_V(8); PG8_WAIT_L(0); PG8_BAR; PG8_MMA(0, 0, At, B0); PG8_MMA(0, 1, At, B1); PG8_BAR; PG8_SCHED;
            PG8_LDA(At, 1, 1); PG8_STAGE(PG8_SB(1, 0), b3, voffB); PG8_STAGE(PG8_SB(1, 1), b3 + hstep, voffB); PG8_STAGE(PG8_SA(1, 0), a3, x0);
            PG8_WAIT_V(8); PG8_WAIT_L(0); PG8_BAR; PG8_MMA(1, 0, At, B0); PG8_MMA(1, 1, At, B1); PG8_BAR; PG8_SCHED;
            }
        }
        if constexpr (ALIGN_EPI) { if (wr == 0) PG8_BAR; }
        if constexpr (!Epi::AFTER_DRAIN) { E(acc, cur, wr, wc, fr, fq); S.done(cur); }
        if (!has_next) break;
#pragma unroll
        for (int a = 0; a < 2; ++a)
#pragma unroll
            for (int b = 0; b < 2; ++b)
#pragma unroll
                for (int m = 0; m < 4; ++m)
#pragma unroll
                    for (int n = 0; n < 2; ++n) acc[a][b][m][n] = (f32x4){0.f, 0.f, 0.f, 0.f};
        cur = nxt; cB = nB; ++ui; cA0[0] = nA0[0]; cA0[1] = nA0[1]; cA1[0] = nA1[0]; cA1[1] = nA1[1];
        if constexpr (ALIGN_EPI) { if (wr == 1) PG8_BAR; }
    }
    PG8_WAIT_V(0);
    if constexpr (!ALIGN_EPI) { if (wr == 0) PG8_BAR; }
    PG8_BAR;
    if constexpr (Epi::AFTER_DRAIN) { E.fused(acc, cur, wr, wc, fr, fq, lds, wid, lane); S.done(cur); }
#undef PG8_SA
#undef PG8_SB
#undef PG8_STAGE
#undef PG8_LDA
#undef PG8_LDB
#undef PG8_MMA
#undef PG8_WAIT_V
#undef PG8_WAIT_L
#undef PG8_BAR
#undef PG8_SCHED
#undef PG8_ROWS
}
}

#include <hip/hip_bf16.h>
namespace swa {
constexpr int D = 128; constexpr float THR = 8.f; constexpr bool WSKIP = false;
constexpr float SCALE = 0.08838834764831845f;
constexpr int NW = 8, QBLK = 32, KVBLK = 64, QB = NW * QBLK;
constexpr int SHM_V = KVBLK * D * 2, SHM_K = KVBLK * D * 2;
constexpr int SWA_LDS_BYTES = 2 * SHM_V + 2 * SHM_K + NW * 64 * 4;
constexpr int BZ_OFF = 69632;

using bf16 = __hip_bfloat16;
typedef short bf16x8 __attribute__((ext_vector_type(8)));
typedef short s16x4 __attribute__((ext_vector_type(4)));
typedef float f32x16 __attribute__((ext_vector_type(16)));
typedef float f32x4 __attribute__((ext_vector_type(4)));
typedef unsigned u32x4 __attribute__((ext_vector_type(4)));
template <class A, class Bt> struct same_t { static constexpr bool v = false; };
template <class A> struct same_t<A, A> { static constexpr bool v = true; };

#define KSWZ(row, colB) ((row) * 256 + ((colB) ^ (((row) & 7) << 4)))
#define SBAR() __builtin_amdgcn_sched_barrier(0)
__device__ __forceinline__ int v_st(int k, int c) { const int kk = (k & ~0xC) | ((k & 4) << 1) | ((k & 8) >> 1); return ((kk >> 3) * 4 + (c >> 5)) * 512 + ((kk & 7) * 32 + (c & 31)) * 2; }
__device__ __forceinline__ int v_rd_base(int lane) { return ((lane & 3) << 3) | (((lane >> 2) & 3) << 6) | (((lane >> 4) & 1) << 5) | (((lane >> 5) & 1) << 8); }
constexpr int v_rd_off(int d0, int ks, int half) { return d0 * 512 + ks * 4096 + half * 2048; }
__device__ __forceinline__ int crow(int r, int hi) { return (r & 3) + 8 * (r >> 2) + 4 * hi; }
__device__ __forceinline__ unsigned cvtpk(float lo, float hi) {
    unsigned r; asm volatile("v_cvt_pk_bf16_f32 %0, %1, %2" : "=v"(r) : "v"(lo), "v"(hi)); return r;
}
__device__ __forceinline__ bf16x8 pack8(f32x4 a, f32x4 b) {
    u32x4 w = {cvtpk(a[0], a[1]), cvtpk(a[2], a[3]), cvtpk(b[0], b[1]), cvtpk(b[2], b[3])};
    return *reinterpret_cast<bf16x8*>(&w);
}
template <class T> __device__ __forceinline__ bf16x8 load8(const T* p) {
    if constexpr (same_t<T, float>::v) { return pack8(*(const f32x4*)p, *(const f32x4*)(p + 4)); }
    else { return *reinterpret_cast<const bf16x8*>(p); }
}
__device__ __forceinline__ void mask_tile(f32x16& p0, f32x16& p1, int dq, unsigned W) {
    const float NEG = -__builtin_inff();
#pragma unroll
    for (int r = 0; r < 16; ++r) {
        const int c = (r & 3) + 8 * (r >> 2);
        if ((unsigned)(dq - c) >= W) p0[r] = NEG;
        if ((unsigned)(dq - c - 32) >= W) p1[r] = NEG;
    }
}
__device__ __forceinline__ void partialSM(f32x16& p0, f32x16& p1, float& m_reg, float& mn, float& alpha) {
    float pmax = p0[0]; for (int r = 1; r < 16; ++r) pmax = fmaxf(pmax, p0[r]); for (int r = 0; r < 16; ++r) pmax = fmaxf(pmax, p1[r]);
    { auto rr = __builtin_amdgcn_permlane32_swap(__float_as_uint(pmax), __float_as_uint(pmax), false, false);
      pmax = fmaxf(__uint_as_float(rr[0]), __uint_as_float(rr[1])); }
    constexpr float C2 = 1.4426950408889634f * SCALE;
    if (__builtin_expect(__all((pmax - m_reg) * SCALE <= THR), 1)) { mn = m_reg; alpha = 1.f; }
    else { mn = fmaxf(m_reg, pmax); alpha = __builtin_amdgcn_exp2f((m_reg - mn) * C2); m_reg = mn; }
    const float mnL = -mn * C2;
    for (int r = 0; r < 16; ++r) p0[r] = fmaf(p0[r], C2, mnL); for (int r = 0; r < 16; ++r) p1[r] = fmaf(p1[r], C2, mnL);
    for (int r = 0; r < 16; ++r) p0[r] = __builtin_amdgcn_exp2f(p0[r]);
}
__device__ __forceinline__ void finishSM(f32x16& p0, f32x16& p1, float alpha, float& l_reg, bf16x8& pa0, bf16x8& pa1, bf16x8& pa2, bf16x8& pa3) {
    for (int r = 0; r < 16; ++r) p1[r] = __builtin_amdgcn_exp2f(p1[r]);
    float ps = 0; for (int r = 0; r < 16; ++r) ps += p0[r]; for (int r = 0; r < 16; ++r) ps += p1[r];
    { auto rr = __builtin_amdgcn_permlane32_swap(__float_as_uint(ps), __float_as_uint(ps), false, false);
      ps = __uint_as_float(rr[0]) + __uint_as_float(rr[1]); }
    l_reg = l_reg * alpha + ps;
#define PK4(P, B_, OUT) do { unsigned a0 = cvtpk(P[B_+0], P[B_+1]), a1 = cvtpk(P[B_+2], P[B_+3]);                          \
        unsigned b0 = cvtpk(P[B_+4], P[B_+5]), b1 = cvtpk(P[B_+6], P[B_+7]);                                             \
        auto r0 = __builtin_amdgcn_permlane32_swap(a0, b0, false, false); auto r1 = __builtin_amdgcn_permlane32_swap(a1, b1, false, false); \
        u32x4 w = {r0[0], r1[0], r0[1], r1[1]}; OUT = *reinterpret_cast<bf16x8*>(&w); } while (0)
    PK4(p0, 0, pa0); PK4(p0, 8, pa1); PK4(p1, 0, pa2); PK4(p1, 8, pa3);
#undef PK4
}
template <int KB, bool SK, bool BIAS>
__device__ __forceinline__ void qkt(f32x16& p0, f32x16& p1, const char* K_lds, int r32, int hi, const bf16x8* qr, bool act, const float* bz) {
    if (SK && !act) { const float NEG = -__builtin_inff();
#pragma unroll
        for (int r = 0; r < 16; ++r) { p0[r] = NEG; p1[r] = NEG; } return; }
    if constexpr (BIAS) {
#pragma unroll
        for (int g = 0; g < 4; ++g) { const f32x4 b0 = *(const f32x4*)(bz + 8 * g + 4 * hi), b1 = *(const f32x4*)(bz + 32 + 8 * g + 4 * hi);
#pragma unroll
            for (int i = 0; i < 4; ++i) { p0[4 * g + i] = b0[i]; p1[4 * g + i] = b1[i]; } }
    } else { p0 = f32x16{}; p1 = f32x16{}; }
    const char* kb[4];
#pragma unroll
    for (int dd = 0; dd < 4; ++dd) kb[dd] = K_lds + KB * SHM_K + KSWZ(r32, (dd * 16 + hi * 8) * 2);
#pragma unroll
    for (int d0 = 0; d0 < 8; ++d0) { const char* a = kb[d0 & 3] + (d0 >> 2) * 128;
        bf16x8 b0 = *reinterpret_cast<const bf16x8*>(a);
        bf16x8 b1 = *reinterpret_cast<const bf16x8*>(a + 32 * 256);
        p0 = __builtin_amdgcn_mfma_f32_32x32x16_bf16(b0, qr[d0], p0, 0, 0, 0);
        p1 = __builtin_amdgcn_mfma_f32_32x32x16_bf16(b1, qr[d0], p1, 0, 0, 0); }
}
template <int VB, bool SK>
__device__ __forceinline__ void pv_tile(f32x16* o, int vb0, bf16x8 pa0, bf16x8 pa1, bf16x8 pa2, bf16x8 pa3, bool act) {
    if (SK && !act) return;
#define TRRD(dst, off) asm volatile("ds_read_b64_tr_b16 %0, %1 offset:%2" : "=&v"(dst) : "v"(vb0), "i"(off) : "memory")
#define PV_D0(d0) do { s16x4 l0, l1, l2, l3, h0, h1, h2, h3; constexpr int b_ = VB * SHM_V + v_rd_off(d0, 0, 0);     \
        TRRD(l0, b_); TRRD(h0, b_ + 2048); TRRD(l1, b_ + 4096); TRRD(h1, b_ + 6144); TRRD(l2, b_ + 8192); TRRD(h2, b_ + 10240); TRRD(l3, b_ + 12288); TRRD(h3, b_ + 14336); \
        asm volatile("s_waitcnt lgkmcnt(0)" ::: "memory"); SBAR();                 \
        o[d0] = __builtin_amdgcn_mfma_f32_32x32x16_bf16(pa0, (bf16x8){l0[0], l0[1], l0[2], l0[3], h0[0], h0[1], h0[2], h0[3]}, o[d0], 0, 0, 0);   \
        o[d0] = __builtin_amdgcn_mfma_f32_32x32x16_bf16(pa1, (bf16x8){l1[0], l1[1], l1[2], l1[3], h1[0], h1[1], h1[2], h1[3]}, o[d0], 0, 0, 0);   \
        o[d0] = __builtin_amdgcn_mfma_f32_32x32x16_bf16(pa2, (bf16x8){l2[0], l2[1], l2[2], l2[3], h2[0], h2[1], h2[2], h2[3]}, o[d0], 0, 0, 0);   \
        o[d0] = __builtin_amdgcn_mfma_f32_32x32x16_bf16(pa3, (bf16x8){l3[0], l3[1], l3[2], l3[3], h3[0], h3[1], h3[2], h3[3]}, o[d0], 0, 0, 0); } while (0)
    PV_D0(0); PV_D0(1); PV_D0(2); PV_D0(3);
#undef PV_D0
#undef TRRD
}

template <class TIn, class TOut> struct BlockRef { const TIn* Q; const TIn* K; const TIn* V; TOut* O; const float* Bz; int P0; int JLO; };
template <class TIn> struct Seam {
    bf16x8 qr[8];
    bf16x8 st_v0, st_v1, st_k0, st_k1; f32x4 sf0, sf1, sf2, sf3;
    f32x4 tq[16];
};
__device__ __forceinline__ int swa_jlo(int P0, int W) { const int lowk = P0 - W + 1; return lowk > 0 ? lowk / KVBLK : 0; }
__device__ __forceinline__ int swa_jlo2(int P0, int W, int jlo) { const int j = swa_jlo(P0, W); return j > jlo ? j : jlo; }
#define ROW(p, k0, rr) ((p) + (size_t)((k0) + (rr)) * D + sc)
#define VMW() asm volatile("s_waitcnt vmcnt(0)" ::: "memory")
#define VMWN(n) asm volatile("s_waitcnt vmcnt(%0)" :: "i"(n) : "memory")
#define SLOAD_H(Kp, Vp, k0) do { S.st_v0 = load8<TIn>(ROW(Vp, k0, sr)); S.st_v1 = load8<TIn>(ROW(Vp, k0, 32 + sr));              \
                         S.st_k0 = load8<TIn>(ROW(Kp, k0, sr)); S.st_k1 = load8<TIn>(ROW(Kp, k0, 32 + sr)); } while (0)
#define SWRITE_HK(bf) do { *(bf16x8*)(K_lds + (bf) * SHM_K + kws) = S.st_k0; *(bf16x8*)(K_lds + (bf) * SHM_K + kws + 32 * 256) = S.st_k1; } while (0)
#define SWRITE_HV(bf) do { *(bf16x8*)(V_lds + (bf) * SHM_V + vst0) = S.st_v0; *(bf16x8*)(V_lds + (bf) * SHM_V + vst1) = S.st_v1; } while (0)
#define SWRITE_H(bf) do { SWRITE_HV(bf); SWRITE_HK(bf); } while (0)
#define SLOAD_F(p, k0) do { S.sf0 = *(const f32x4*)ROW(p, k0, sr); S.sf1 = *(const f32x4*)(ROW(p, k0, sr) + 4);                \
                            S.sf2 = *(const f32x4*)ROW(p, k0, 32 + sr); S.sf3 = *(const f32x4*)(ROW(p, k0, 32 + sr) + 4); } while (0)
#define SWRITE_KF(bf) do { *(bf16x8*)(K_lds + (bf) * SHM_K + kws) = pack8(S.sf0, S.sf1); *(bf16x8*)(K_lds + (bf) * SHM_K + kws + 32 * 256) = pack8(S.sf2, S.sf3); } while (0)
#define SWRITE_VF(bf) do { *(bf16x8*)(V_lds + (bf) * SHM_V + vst0) = pack8(S.sf0, S.sf1); *(bf16x8*)(V_lds + (bf) * SHM_V + vst1) = pack8(S.sf2, S.sf3); } while (0)
template <class TIn, class TOut>
__device__ __forceinline__ void causal_swa_prime(const BlockRef<TIn, TOut>& cur, int W, char* lds, Seam<TIn>& S) {
    constexpr bool F32 = same_t<TIn, float>::v;
    int tid_ = threadIdx.x; asm volatile("" : "+v"(tid_)); const int tid = tid_, wid = __builtin_amdgcn_readfirstlane(tid >> 6), lane = tid & 63, r32 = lane & 31, hi = lane >> 5;
    const int sr = tid >> 4, sc = (tid & 15) * 8, kws = KSWZ(sr, sc * 2); char* K_lds = lds + 2 * SHM_V;
    const int kb0 = swa_jlo2(cur.P0, W, cur.JLO) * KVBLK;
    for (int d0 = 0; d0 < 8; ++d0) S.qr[d0] = load8<TIn>(cur.Q + (size_t)(wid * QBLK + r32) * D + d0 * 16 + hi * 8);
    if constexpr (F32) { SLOAD_F((const float*)cur.K, kb0); VMW(); SWRITE_KF(0); SBAR(); SLOAD_F((const float*)cur.V, kb0); }
    else { SLOAD_H(cur.K, cur.V, kb0); VMW(); SWRITE_HK(0); }
    __syncthreads();
}
template <class TIn, class TOut, int OLD, bool BIAS>
__device__ __forceinline__ void causal_swa_block(const BlockRef<TIn, TOut>& cur, const BlockRef<TIn, TOut>& nxt, int skv, int W, char* lds, Seam<TIn>& S) {
    constexpr bool F32 = same_t<TIn, float>::v;
    int tid_ = threadIdx.x; asm volatile("" : "+v"(tid_)); const int tid = tid_, wid = __builtin_amdgcn_readfirstlane(tid >> 6), lane = tid & 63, r32 = lane & 31, hi = lane >> 5;
    const int j_lo = swa_jlo2(cur.P0, W, cur.JLO);
    int j_hi = (cur.P0 + QB - 1) / KVBLK + 1; if (j_hi > skv / KVBLK) j_hi = skv / KVBLK;
    const int NT = j_hi - j_lo;
    const float* bzl = (const float*)(lds + BZ_OFF);
    if constexpr (BIAS) {
        float* bzw = (float*)(lds + BZ_OFF); const int nk = j_hi * KVBLK;
        for (int i = j_lo * KVBLK + tid * 4; i < nk; i += 64 * NW * 4) *(f32x4*)(bzw + i) = *(const f32x4*)(cur.Bz + i);
        __syncthreads();
    }
#define BZP(t) (bzl + KBASE(t))
    const int kbn = swa_jlo2(nxt.P0, W, nxt.JLO) * KVBLK;
    const int qlo = cur.P0 + wid * QBLK, qm = qlo + r32 - 4 * hi;
    char* V_lds = lds; char* K_lds = lds + 2 * SHM_V;
    float* ws = (float*)(lds + 2 * SHM_V + 2 * SHM_K) + wid * 64; float* li_l = ws, * al_l = ws + 32;
    float m_reg = -1e30f, l_reg = 0; f32x16 o[4] = {};
    const int sr = tid >> 4, sc = (tid & 15) * 8, vst0 = v_st(sr, sc), vst1 = v_st(32 + sr, sc), kws = KSWZ(sr, sc * 2);
    const int vb0 = (int)(uintptr_t)V_lds + v_rd_base(lane);
    const TIn* Kh = cur.K; const TIn* Vh = cur.V;
#define RESC(a) do { if (__any((a) < 1.f)) { if (hi == 0) al_l[r32] = (a); asm volatile("s_waitcnt lgkmcnt(0)" ::: "memory");              \
                     for (int d_ = 0; d_ < 4; ++d_) for (int r = 0; r < 16; ++r) o[d_][r] *= al_l[crow(r, hi)]; } } while (0)
#define KBASE(t) ((j_lo + (t)) * KVBLK)
#define ACT(t) (KBASE(t) <= qlo + QBLK - 1 && KBASE(t) + KVBLK - 1 >= qlo - W + 1)
#define MASKT(P0_, P1_, t) do { const int kb_ = KBASE(t); if ((!SK || ACT(t)) && (kb_ + KVBLK - 1 > qlo || kb_ <= qlo + QBLK - 1 - W)) mask_tile(P0_, P1_, qm - kb_, (unsigned)W); } while (0)
    constexpr int NQL = F32 ? 16 : 8;
    constexpr bool SK = WSKIP && !F32;
#define SEAM_K0() do { VMWN(NQL); if constexpr (F32) { SWRITE_KF(0); SBAR(); SLOAD_F((const float*)nxt.V, kbn); } else { SWRITE_HK(0); } SBAR(); } while (0)
    f32x16 pA0, pA1, pB0, pB1; float mnA, mnB, alA, alB; bf16x8 pa0, pa1, pa2, pa3;
    if constexpr (F32) { VMW(); SWRITE_VF(0); SBAR(); } else { SWRITE_HV(0); SBAR(); }
    if (NT > 1) { if constexpr (F32) SLOAD_F((const float*)Kh, KBASE(1)); else SLOAD_H(Kh, Vh, KBASE(1)); }
    SBAR(); qkt<0, SK, BIAS>(pA0, pA1, K_lds, r32, hi, S.qr, ACT(0), BZP(0));
    if constexpr (F32) { if (NT > 1) { VMW(); SWRITE_KF(1); SBAR(); SLOAD_F((const float*)Vh, KBASE(1)); } }
    MASKT(pA0, pA1, 0); partialSM(pA0, pA1, m_reg, mnA, alA);
    if (NT > 1) { VMW(); if constexpr (F32) { SWRITE_VF(1); SBAR(); if (NT > 2) SLOAD_F((const float*)Kh, KBASE(2)); } else SWRITE_H(1); }
    __syncthreads();
#define HALF_STEP(PX0, PX1, mnX, alX, PY0, PY1, alY, t, KB, VB, SB) do {                                                      \
        SBAR(); qkt<KB, SK, BIAS>(PX0, PX1, K_lds, r32, hi, S.qr, ACT(t), BZP(t));                                             \
        finishSM(PY0, PY1, alY, l_reg, pa0, pa1, pa2, pa3); SBAR();                                                           \
        if ((t) + 1 < NT) { if constexpr (F32) { VMW(); SWRITE_KF(SB); SBAR(); SLOAD_F((const float*)Vh, KBASE((t) + 1)); }  \
                            else { SLOAD_H(Kh, Vh, KBASE((t) + 1)); } SBAR(); }                                               \
        pv_tile<VB, SK>(o, vb0, pa0, pa1, pa2, pa3, ACT((t) - 1)); MASKT(PX0, PX1, (t)); partialSM(PX0, PX1, m_reg, mnX, alX);                                        \
        __syncthreads();                                                                                                      \
        if ((t) + 1 < NT) { VMW(); if constexpr (F32) { SWRITE_VF(SB); SBAR(); if ((t) + 2 < NT) SLOAD_F((const float*)Kh, KBASE((t) + 2)); } \
                            else { SWRITE_H(SB); } }                                                                          \
        RESC(alX); __syncthreads(); } while (0)
    for (int t = 1; t + 1 < NT; t += 2) {
        HALF_STEP(pB0, pB1, mnB, alB, pA0, pA1, alA, t, 1, 0, 0);
        HALF_STEP(pA0, pA1, mnA, alA, pB0, pB1, alB, t + 1, 0, 1, 1);
    }
    const bool even = (NT & 1) == 0;
    if (even) { SBAR(); qkt<1, SK, BIAS>(pB0, pB1, K_lds, r32, hi, S.qr, ACT(NT - 1), BZP(NT - 1)); SBAR(); }
#define QROW(e) (nxt.Q + (size_t)(wid * QBLK + r32) * D + ((e) >> 1) * 16 + hi * 8 + ((e) & 1) * 4)
    if constexpr (F32) { SLOAD_F((const float*)nxt.K, kbn); SBAR();
#pragma unroll
        for (int e = 0; e < 8; ++e) S.tq[e] = *(const f32x4*)QROW(e); }
    else { SLOAD_H(nxt.K, nxt.V, kbn); SBAR();
#pragma unroll
        for (int d0 = 0; d0 < 8; ++d0) S.qr[d0] = load8<TIn>(nxt.Q + (size_t)(wid * QBLK + r32) * D + d0 * 16 + hi * 8); }
    SBAR();
    finishSM(pA0, pA1, alA, l_reg, pa0, pa1, pa2, pa3); SBAR();
    if constexpr (F32) {
#pragma unroll
        for (int e = 8; e < 16; ++e) S.tq[e] = *(const f32x4*)QROW(e); SBAR(); }
#undef QROW
    pv_tile<0, SK>(o, vb0, pa0, pa1, pa2, pa3, ACT(even ? NT - 2 : NT - 1));
    if (even) { MASKT(pB0, pB1, NT - 1); partialSM(pB0, pB1, m_reg, mnB, alB); __syncthreads(); RESC(alB);
        finishSM(pB0, pB1, alB, l_reg, pa0, pa1, pa2, pa3); SBAR(); pv_tile<1, SK>(o, vb0, pa0, pa1, pa2, pa3, ACT(NT - 1)); }
    SBAR(); SEAM_K0();
    if (hi == 0) li_l[r32] = l_reg; asm volatile("s_waitcnt lgkmcnt(0)" ::: "memory");
    float rli[16];
#pragma unroll
    for (int r = 0; r < 16; ++r) rli[r] = __builtin_amdgcn_rcpf(li_l[crow(r, hi)]);
    TOut* Ow = cur.O + (size_t)(wid * QBLK) * OLD;
#pragma unroll
    for (int r = 0; r < 16; ++r) { const int orow = crow(r, hi);
#pragma unroll
        for (int d0 = 0; d0 < 4; ++d0) { const float v = o[d0][r] * rli[r];
            if constexpr (same_t<TOut, float>::v) { Ow[(size_t)orow * OLD + d0 * 32 + r32] = v; }
            else { const float vn = __uint_as_float((unsigned)__builtin_amdgcn_update_dpp(0, (int)__float_as_uint(v), 0xB1, 0xf, 0xf, true));
                   if ((r32 & 1) == 0) *(unsigned*)(Ow + (size_t)orow * OLD + d0 * 32 + r32) = cvtpk(v, vn); } } }
    if constexpr (F32) {
#pragma unroll
        for (int d0 = 0; d0 < 8; ++d0) S.qr[d0] = pack8(S.tq[2 * d0], S.tq[2 * d0 + 1]); }
    __syncthreads();
#undef RESC
#undef KBASE
#undef BZP
#undef ACT
#undef MASKT
#undef SEAM_K0
#undef HALF_STEP
}
#undef ROW
#undef VMW
#undef VMWN
#undef SLOAD_H
#undef SWRITE_HK
#undef SWRITE_HV
#undef SWRITE_H
#undef SLOAD_F
#undef SWRITE_KF
#undef SWRITE_VF
}

namespace {
constexpr int D = 2048, NB = 4, S = 4096, NTOK = NB * S;
constexpr int NTHR = 512;
constexpr int MAXSLOT = 40960;
constexpr int NPANEL = MAXSLOT / 256;
constexpr float LN_EPS = 1e-5f, RMS_EPS = 1e-5f;
constexpr float ALPHA = 1.41421356237309515f;
constexpr float LAM_INIT0 = 0.2f;


#define XB_TMO      128
#define XB_XCNT(j)  (256  + 64 * (j))
#define XB_XSUB(j)  (1280 + 64 * (j))
#define XB_XGEN(j)  (2304 + 64 * (j))
#define XB_TOP      3328
#define XB_TOPGEN   3392
#define XCD_BAR_WORDS 3456
#define XB_SPIN_CAP (1u << 18)
#define LAS __attribute__((address_space(3)))
__device__ __forceinline__ unsigned xb_ld(unsigned* p)              { return __hip_atomic_load(p, __ATOMIC_RELAXED, __HIP_MEMORY_SCOPE_AGENT); }
__device__ __forceinline__ unsigned xb_add(unsigned* p, unsigned v) { return __hip_atomic_fetch_add(p, v, __ATOMIC_RELAXED, __HIP_MEMORY_SCOPE_AGENT); }
__device__ __forceinline__ unsigned xb_xcc_id() { return (unsigned)__builtin_amdgcn_s_getreg((3 << 11) | 20) & 0xFu; }
#define XB_SPIN(cond, bar) do { unsigned _sp = 0; while (cond) { __builtin_amdgcn_s_sleep(1); \
    if ((++_sp & 255u) == 0u) { if (xb_ld(&(bar)[XB_TMO])) break; if (_sp > XB_SPIN_CAP) { atomicAdd(&(bar)[XB_TMO], 1u); break; } } } } while (0)
struct XcdBarrier { unsigned* bar; unsigned x; volatile LAS unsigned* st; };
__device__ __forceinline__ XcdBarrier xcd_barrier_post(unsigned* bar, volatile LAS unsigned* st) {
    XcdBarrier b; b.bar = bar; b.x = (unsigned)__builtin_amdgcn_readfirstlane((int)xb_xcc_id()); b.st = st;
    if (threadIdx.x == 0) (void)xb_add(&bar[XB_XCNT(b.x)], 1u);
    return b;
}
__device__ __forceinline__ void xcd_barrier_complete(unsigned* bar, unsigned x, unsigned& nloc, unsigned& nx) {
    const unsigned G = gridDim.x * gridDim.y * gridDim.z;
    unsigned sum, cnt, mine, sp = 0u;
    for (;;) {
        sum = 0u; cnt = 0u; mine = 0u;
#pragma unroll
        for (unsigned j = 0; j < 16; ++j) { const unsigned c = xb_ld(&bar[XB_XCNT(j)]); sum += c; cnt += (c > 0u) ? 1u : 0u; mine = (j == x) ? c : mine; }
        if (sum == G) break;
        __builtin_amdgcn_s_sleep(1);
        if ((++sp & 255u) == 0u) { if (xb_ld(&bar[XB_TMO])) break; if (sp > XB_SPIN_CAP) { atomicAdd(&bar[XB_TMO], 1u); break; } }
    }
    nloc = mine > 0u ? mine : 1u; nx = cnt > 0u ? cnt : 1u;
}
__device__ __forceinline__ void xcd_barrier(const XcdBarrier& b) {
    asm volatile("s_waitcnt vmcnt(0)" ::: "memory");
    __syncthreads();
    int t0_ = threadIdx.x; asm volatile("" : "+v"(t0_));
    if (t0_ == 0) {
        unsigned* bar = b.bar;
        unsigned bx = b.x; asm volatile("" : "+s"(bx));
        __builtin_amdgcn_s_waitcnt(0);
        unsigned nloc = b.st[0], nx = b.st[1];
        if (nloc == 0u) { xcd_barrier_complete(bar, bx, nloc, nx); b.st[0] = nloc; b.st[1] = nx; }
        const unsigned old = xb_add(&bar[XB_XSUB(bx)], 1u);
        const unsigned gen = old / nloc;
        if (old + 1u == (gen + 1u) * nloc) {
            __builtin_amdgcn_fence(__ATOMIC_RELEASE, "agent");
            asm volatile("s_waitcnt vmcnt(0)" ::: "memory");
            const unsigned og = xb_add(&bar[XB_TOP], 1u);
            const unsigned tg = og / nx;
            if (og + 1u == (tg + 1u) * nx) xb_add(&bar[XB_TOPGEN], 1u);
            else XB_SPIN(xb_ld(&bar[XB_TOPGEN]) == tg, bar);
            __builtin_amdgcn_fence(__ATOMIC_ACQUIRE, "agent");
            xb_add(&bar[XB_XGEN(bx)], 1u);
            asm volatile("s_waitcnt vmcnt(0)" ::: "memory");
        } else {
            XB_SPIN(xb_ld(&bar[XB_XGEN(bx)]) == gen, bar);
            __builtin_amdgcn_fence(__ATOMIC_ACQUIRE, "agent");
            asm volatile("s_waitcnt vmcnt(0)" ::: "memory");
        }
    }
    __syncthreads();
}

__device__ __forceinline__ float wave_sum(float v) {
#pragma unroll
    for (int o = 32; o >= 1; o >>= 1) v += __shfl_xor(v, o);
    return v;
}
__device__ __forceinline__ float wave_max(float v) {
#pragma unroll
    for (int o = 32; o >= 1; o >>= 1) v = fmaxf(v, __shfl_xor(v, o));
    return v;
}

extern __shared__ __attribute__((aligned(16))) unsigned char g_lds[];
constexpr int RING_BYTES = 131072, LDS_BYTES = 147456, LDSCTL_OFF = LDS_BYTES - 256;
__device__ __forceinline__ int obid() { int b = blockIdx.x; asm volatile("" : "+s"(b)); return b; }
__device__ __forceinline__ int otid() { int t = threadIdx.x; asm volatile("" : "+v"(t)); return t; }

struct ModF {
    const float* c; const float* w0; const float* w1; float* modp;
    __device__ __forceinline__ void operator()(int vb) const {
        float (*sc)[128] = (float (*)[128])g_lds;
        const int tid = otid();
        const int kc = vb & 15, nb = (vb >> 4) % 12, set = vb / 192, n = nb * NTHR + tid, k0 = kc * 128;
        const float* W = ((set & 1) ? w1 : w0) + (size_t)(set >> 1) * D * 3 * D + (size_t)k0 * (3 * D) + n;
        __syncthreads();
        { const float v = c[(tid >> 7) * D + k0 + (tid & 127)]; sc[tid >> 7][tid & 127] = v / (1.f + expf(-v)); }
        __syncthreads();
        float a0 = 0.f, a1 = 0.f, a2 = 0.f, a3 = 0.f;
#pragma unroll 16
        for (int k = 0; k < 128; ++k) { const float w = W[(size_t)k * (3 * D)]; a0 += sc[0][k] * w; a1 += sc[1][k] * w; a2 += sc[2][k] * w; a3 += sc[3][k] * w; }
        float* o = modp + ((size_t)(kc * 4 + set) * NB) * 3 * D + n;
        o[0 * 3 * D] = a0; o[1 * 3 * D] = a1; o[2 * 3 * D] = a2; o[3 * 3 * D] = a3;
    }
};
struct ModRedF {
    const float* modp; const float* b0; const float* b1; float* out;
    __device__ __forceinline__ void operator()(int vb) const {
        const int i = vb * NTHR + otid();
        const int n = i % (3 * D), set = i / (NB * 3 * D);
        float a = ((set & 1) ? b1 : b0)[(size_t)(set >> 1) * 3 * D + n];
#pragma unroll
        for (int kc = 0; kc < 16; ++kc) a += modp[(size_t)kc * 4 * NB * 3 * D + i];
        out[i] = a;
    }
};

typedef unsigned short bf16_t;
__device__ __forceinline__ unsigned pkbf(float lo, float hi) { unsigned r; asm volatile("v_cvt_pk_bf16_f32 %0, %1, %2" : "=v"(r) : "v"(lo), "v"(hi)); return r; }
struct ModulateF {
    const float* x; const float* mod; float* h; bf16_t* hb;
    __device__ __forceinline__ void operator()(int vb) const {
        const size_t i4 = (size_t)vb * NTHR + otid();
        const size_t e = i4 * 4; const int t = (int)(e / D), d = (int)(e % D), b = t / S;
        const float4 xv = *(const float4*)(x + e);
        const float4 sh = *(const float4*)(mod + (size_t)b * 3 * D + d);
        const float4 sc = *(const float4*)(mod + (size_t)b * 3 * D + D + d);
        float4 o; o.x = xv.x * (1.f + sc.x) + sh.x; o.y = xv.y * (1.f + sc.y) + sh.y; o.z = xv.z * (1.f + sc.z) + sh.z; o.w = xv.w * (1.f + sc.w) + sh.w;
        if (h) *(float4*)(h + e) = o;
        if (hb) { uint2 w; w.x = pkbf(o.x, o.y); w.y = pkbf(o.z, o.w); *(uint2*)(hb + e) = w; }
    }
};
struct Mod0F {
    const float* x; const float* modp; const float* bias; bf16_t* hb;
    __device__ __forceinline__ void run() const {
        float* sv = (float*)g_lds;
        const int tid = otid(), wave = tid >> 6, lane = tid & 63;
        const int G = gridDim.x, per = G >> 2, bid = obid();
        if (per == 0 || bid >= 4 * per) return;
        const int b = bid / per, r = bid - b * per;
        __syncthreads();
        for (int i = tid; i < 2 * D; i += NTHR) { float a = bias[i];
#pragma unroll
            for (int kc = 0; kc < 16; ++kc) a += modp[((size_t)(kc * 4 + 0) * NB + b) * 3 * D + i];
            sv[i] = a; }
        __syncthreads();
        for (int row = r * 8 + wave; row < S; row += per * 8) { const size_t t = (size_t)b * S + row;
            float4 xv[8];
#pragma unroll
            for (int i = 0; i < 8; ++i) xv[i] = *(const float4*)(x + t * D + (i * 64 + lane) * 4);
#pragma unroll
            for (int i = 0; i < 8; ++i) { const int d = (i * 64 + lane) * 4; const float4 s4 = *(const float4*)(sv + d), c4 = *(const float4*)(sv + D + d);
                uint2 w; w.x = pkbf(xv[i].x * (1.f + c4.x) + s4.x, xv[i].y * (1.f + c4.y) + s4.y); w.y = pkbf(xv[i].z * (1.f + c4.z) + s4.z, xv[i].w * (1.f + c4.w) + s4.w);
                *(uint2*)(hb + t * D + d) = w; } }
        __syncthreads();
    }
};
struct ConvF {
    const float* src; bf16_t* dst;
    __device__ __forceinline__ void operator()(int vb) const {
        const size_t e = ((size_t)vb * NTHR + otid()) * 4;
        const float4 v = *(const float4*)(src + e); uint2 w; w.x = pkbf(v.x, v.y); w.y = pkbf(v.z, v.w); *(uint2*)(dst + e) = w;
    }
};
struct TransF {
    const float* W; bf16_t* WT; int K, ldw, ncols, ileave;
    __device__ __forceinline__ int nitems() const { return (K / 64) * (ncols / 64); }
    __device__ __forceinline__ void load(int it, int lane, float4 (&v)[16]) const {
        const int nblk = ncols / 64, kb = it / nblk, nb = it - kb * nblk, k0 = 64 * kb, n0 = 64 * nb;
        const int n4 = lane & 15, kr = lane >> 4;
        const float* src = W + (size_t)(k0 + kr * 16) * ldw + n0 + 4 * n4;
#pragma unroll
        for (int i = 0; i < 16; ++i) v[i] = *(const float4*)(src + (size_t)i * ldw);
    }
    __device__ __forceinline__ void item(int it, int wave, int lane) const { float4 v[16]; load(it, lane, v); finish(it, wave, lane, v); }
    __device__ __forceinline__ void finish(int it, int wave, int lane, const float4 (&v)[16]) const {
        unsigned char* scr = g_lds + wave * 16384;
        const int nblk = ncols / 64, kb = it / nblk, nb = it - kb * nblk, k0 = 64 * kb, n0 = 64 * nb;
        const int n4 = lane & 15, kr = lane >> 4;
#pragma unroll
        for (int j = 0; j < 4; ++j) { uint4 lo4, hi4;
            const float e0 = j == 0 ? v[0].x : j == 1 ? v[0].y : j == 2 ? v[0].z : v[0].w; (void)e0;
#define TF_EL(i) (j == 0 ? v[i].x : j == 1 ? v[i].y : j == 2 ? v[i].z : v[i].w)
            lo4.x = pkbf(TF_EL(0), TF_EL(1)); lo4.y = pkbf(TF_EL(2), TF_EL(3)); lo4.z = pkbf(TF_EL(4), TF_EL(5)); lo4.w = pkbf(TF_EL(6), TF_EL(7));
            hi4.x = pkbf(TF_EL(8), TF_EL(9)); hi4.y = pkbf(TF_EL(10), TF_EL(11)); hi4.z = pkbf(TF_EL(12), TF_EL(13)); hi4.w = pkbf(TF_EL(14), TF_EL(15));
#undef TF_EL
            unsigned char* d = scr + (4 * n4 + j) * 144 + kr * 32;
            *(uint4*)d = lo4; *(uint4*)(d + 16) = hi4; }
        asm volatile("s_waitcnt lgkmcnt(0)" ::: "memory");
        const int c = lane & 7;
#pragma unroll
        for (int j = 0; j < 8; ++j) { const int n = (lane >> 3) + 8 * j; const uint4 o = *(const uint4*)(scr + n * 144 + c * 16);
            const int nn = n0 + n;
            const int dr = ileave == 0 ? nn : (ileave == 3 ? (nn < 4096 ? ((nn >> 8) * 256 + ((nn >> 6) & 1) * 128 + ((nn >> 7) & 1) * 64 + (nn & 63)) : nn)
                                                         : ((nn >> 7) * 256 + (ileave - 1) * 128 + (nn & 127)));
            *(uint4*)(WT + (size_t)dr * K + k0 + 8 * c) = o; }
        asm volatile("s_waitcnt lgkmcnt(0)" ::: "memory");
    }
    __device__ __forceinline__ void run() const {
        const int tid = otid(), wave = tid >> 6, lane = tid & 63;
        for (int it = obid() * 8 + wave; it < nitems(); it += gridDim.x * 8) item(it, wave, lane);
    }
};

struct GemmF {
    const float* A; const float* B; float* C;
    const int* rowidx;
    const int* panel_e;
    long long strideBe;
    int lda, ldb, ldc, M, N, K;
    int transB, causal;
    int tilesN, pad0;
    __device__ __forceinline__ void operator()(int vb) const {
        float (*As)[132] = (float (*)[132])g_lds; float (*Bs)[132] = (float (*)[132])(g_lds + 16 * 132 * 4);
        const int tm = vb / tilesN, tn = vb % tilesN, m0 = tm * 128, n0 = tn * 128;
        const float* Bp = B;
        if (panel_e) { const int e = panel_e[m0 >> 8]; if (e < 0) return; Bp += (size_t)e * strideBe; }
        if (causal == 1 && n0 > m0 + 127) return;
        int Kend = K; if (causal == 2 && m0 + 128 < K) Kend = m0 + 128;
        const int tid = otid(), tx = tid & 31, ty = tid >> 5;
        float acc[8][4];
#pragma unroll
        for (int i = 0; i < 8; ++i)
#pragma unroll
            for (int j = 0; j < 4; ++j) acc[i][j] = 0.f;
        const int ar = tid >> 2, ak = (tid & 3) * 4;
        long long arow = m0 + ar; bool aval = arow < M;
        if (rowidx && aval) { const int ri = rowidx[arow]; aval = ri >= 0; arow = ri; }
        const float* Ap = A + (aval ? arow : 0) * (long long)lda + ak;
        int bk, bn; if (!transB) { bk = tid >> 5; bn = (tid & 31) * 4; } else { bn = tid >> 2; bk = (tid & 3) * 4; }
        const bool bval = (n0 + bn) < N;
        for (int k0 = 0; k0 < Kend; k0 += 16) {
            float4 av = make_float4(0.f, 0.f, 0.f, 0.f), bv = make_float4(0.f, 0.f, 0.f, 0.f);
            if (aval) av = *(const float4*)(Ap + k0);
            if (bval) { if (!transB) bv = *(const float4*)(Bp + (size_t)(k0 + bk) * ldb + n0 + bn); else bv = *(const float4*)(Bp + (size_t)(n0 + bn) * ldb + k0 + bk); }
            __syncthreads();
            As[ak + 0][ar] = av.x; As[ak + 1][ar] = av.y; As[ak + 2][ar] = av.z; As[ak + 3][ar] = av.w;
            if (!transB) { *(float4*)&Bs[bk][bn] = bv; } else { Bs[bk + 0][bn] = bv.x; Bs[bk + 1][bn] = bv.y; Bs[bk + 2][bn] = bv.z; Bs[bk + 3][bn] = bv.w; }
            __syncthreads();
#pragma unroll
            for (int kk = 0; kk < 16; ++kk) {
                const float4 a0 = *(const float4*)&As[kk][ty * 8], a1 = *(const float4*)&As[kk][ty * 8 + 4], b = *(const float4*)&Bs[kk][tx * 4];
                const float a[8] = {a0.x, a0.y, a0.z, a0.w, a1.x, a1.y, a1.z, a1.w};
#pragma unroll
                for (int i = 0; i < 8; ++i) { acc[i][0] += a[i] * b.x; acc[i][1] += a[i] * b.y; acc[i][2] += a[i] * b.z; acc[i][3] += a[i] * b.w; }
            }
        }
        const int col = n0 + tx * 4;
        if (col < N) {
#pragma unroll
            for (int i = 0; i < 8; ++i) { const int row = m0 + ty * 8 + i; if (row < M) *(float4*)(C + (size_t)row * ldc + col) = make_float4(acc[i][0], acc[i][1], acc[i][2], acc[i][3]); }
        }
        __syncthreads();
    }
};

struct RopeTab { float inv_freq[64]; };
struct RopeTableF {
    float* tab;
    __device__ __forceinline__ void operator()(int vb) const {
        const int idx = vb * NTHR + otid(); const int s = idx >> 6, i = idx & 63;
        const float inv_freq = (float)exp2(-(double)i * (13.287712379549449 / 64.0));
        const float angf = (float)s * inv_freq;
        double r = (double)angf;
        const double k = rint(r * 0.63661977236758134308);
        r = fma(-k, 1.57079632679489655800e+00, r); r = fma(-k, 6.12323399573676603587e-17, r);
        const int q = ((int)k) & 3;
        const double r2 = r * r;
        double sn = -1.0 / 6227020800.0 * -1.0;
        sn = 1.0 / 6227020800.0;
        sn = sn * r2 - 1.0 / 39916800.0; sn = sn * r2 + 1.0 / 362880.0; sn = sn * r2 - 1.0 / 5040.0; sn = sn * r2 + 1.0 / 120.0; sn = sn * r2 - 1.0 / 6.0; sn = sn * r2 + 1.0; sn = sn * r;
        double cs = -1.0 / 87178291200.0;
        cs = cs * r2 + 1.0 / 479001600.0; cs = cs * r2 - 1.0 / 3628800.0; cs = cs * r2 + 1.0 / 40320.0; cs = cs * r2 - 1.0 / 720.0; cs = cs * r2 + 1.0 / 24.0; cs = cs * r2 - 0.5; cs = cs * r2 + 1.0;
        double c, sv;
        if (q == 0) { c = cs; sv = sn; } else if (q == 1) { c = -sn; sv = cs; } else if (q == 2) { c = -cs; sv = -sn; } else { c = sn; sv = -cs; }
        tab[(size_t)idx * 2] = (float)c; tab[(size_t)idx * 2 + 1] = (float)sv;
    }
};
struct RopeF {
    float* p; const float* tab; int ld, pad0;
    __device__ __forceinline__ void operator()(int vb) const {
        const int idx = vb * NTHR + otid();
        const int i = idx & 63, head = (idx >> 6) & 31, s = idx >> 11;
        float* q = p + (size_t)s * ld + head * 128 + i;
        const float c = tab[((size_t)s * 64 + i) * 2], sn = tab[((size_t)s * 64 + i) * 2 + 1];
        const float x1 = q[0], x2 = q[64];
        q[0] = x1 * c - x2 * sn; q[64] = x2 * c + x1 * sn;
    }
};

struct LamF {
    const float* q1; const float* k1; const float* q2; const float* k2; float* lam;
    __device__ __forceinline__ void operator()(int vb) const {
        const int tid = otid();
        if (tid < 64) {
            float a = q1[tid] * k1[tid] + q1[tid + 64] * k1[tid + 64], b = q2[tid] * k2[tid] + q2[tid + 64] * k2[tid + 64];
            a = wave_sum(a); b = wave_sum(b);
            if (tid == 0) lam[0] = expf(a) - expf(b) + LAM_INIT0;
        }
    }
};

struct SoftmaxF {
    float* S1; float* S2;
    const float* lam; const float* cum;
    float scale; int pad0;
    __device__ __forceinline__ void operator()(int vb) const {
        const int tid = otid(), wave = tid >> 6, lane = tid & 63;
        const int i = vb * 8 + wave;
        float* r1 = S1 + (size_t)i * S; float* r2 = S2 ? S2 + (size_t)i * S : nullptr;
        const float ci = cum ? cum[i] : 0.f;
        float m1 = -INFINITY, m2 = -INFINITY;
        for (int j = lane; j <= i; j += 64) {
            float s = r1[j] * scale; if (cum) s += ci - cum[j]; m1 = fmaxf(m1, s);
            if (r2) m2 = fmaxf(m2, r2[j] * scale);
        }
        m1 = wave_max(m1); m2 = wave_max(m2);
        float l1 = 0.f, l2 = 0.f;
        for (int j = lane; j <= i; j += 64) {
            float s = r1[j] * scale; if (cum) s += ci - cum[j]; l1 += expf(s - m1);
            if (r2) l2 += expf(r2[j] * scale - m2);
        }
        l1 = wave_sum(l1); l2 = wave_sum(l2);
        const float lm = r2 ? lam[0] : 0.f;
        const int jend = ((i >> 7) + 1) << 7;
        for (int j = lane; j < jend; j += 64) {
            float o = 0.f;
            if (j <= i) {
                float s = r1[j] * scale; if (cum) s += ci - cum[j];
                o = expf(s - m1) / l1;
                if (r2) o -= lm * (expf(r2[j] * scale - m2) / l2);
            }
            r1[j] = o;
        }
    }
};

struct RmsF {
    float* o; const float* w; bf16_t* ob;
    __device__ __forceinline__ void operator()(int vb) const {
        const int tid = otid(), wave = tid >> 6, lane = tid & 63;
        const size_t g = (size_t)vb * 8 + wave;
        float4 v = *(float4*)(o + g * 256 + lane * 4);
        float ss = v.x * v.x + v.y * v.y + v.z * v.z + v.w * v.w; ss = wave_sum(ss);
        const float r = 1.0f / sqrtf(ss * (1.f / 256.f) + RMS_EPS) * (1.f - LAM_INIT0);
        const float4 ww = *(const float4*)(w + lane * 4);
        v.x = v.x * r * ww.x; v.y = v.y * r * ww.y; v.z = v.z * r * ww.z; v.w = v.w * r * ww.w;
        *(float4*)(o + g * 256 + lane * 4) = v;
        if (ob) { uint2 q; q.x = pkbf(v.x, v.y); q.y = pkbf(v.z, v.w); *(uint2*)(ob + g * 256 + lane * 4) = q; }
    }
};

struct CumF {
    const float* proj; const float* fb; float* cum; int ld, pad0;
    __device__ __forceinline__ void operator()(int vb) const {
        float* tot = (float*)g_lds;
        const int h = vb, tid = otid();
        float v[8]; float run = 0.f;
#pragma unroll
        for (int j = 0; j < 8; ++j) { const float x = proj[(size_t)(tid * 8 + j) * ld + 6144 + h] + fb[h];
            const float ls = fminf(x, 0.f) - log1pf(expf(-fabsf(x))); run += ls; v[j] = run; }
        __syncthreads();
        tot[tid] = run;
        __syncthreads();
        if (tid == 0) { float a = 0.f; for (int i = 0; i < NTHR; ++i) { const float t = tot[i]; tot[i] = a; a += t; } }
        __syncthreads();
        const float off = tot[tid];
#pragma unroll
        for (int j = 0; j < 8; ++j) cum[(size_t)h * S + tid * 8 + j] = v[j] + off;
        __syncthreads();
    }
};

struct LnF {
    const float* x; const float* ya; const int* tok_slot;
    const bf16_t* yb;
    const float* mod; const float* g; const float* bta; float* out;
    __device__ __forceinline__ void operator()(int vb) const {
        const int tid = otid(), wave = tid >> 6, lane = tid & 63;
        const int t = vb * 8 + wave, b = t / S;
        const float* xr = x + (size_t)t * D; const float* gt = mod + (size_t)b * 3 * D + 2 * D;
        const float* y0; const float* y1 = nullptr;
        if (tok_slot) { y0 = ya + (size_t)tok_slot[2 * t] * D; y1 = ya + (size_t)tok_slot[2 * t + 1] * D; } else y0 = ya + (size_t)t * D;
        if (yb) { y0 = xr; y1 = nullptr; }
        float4 z[8]; float sum = 0.f;
#pragma unroll
        for (int i = 0; i < 8; ++i) { const int d = (i * 64 + lane) * 4;
            const float4 xv = *(const float4*)(xr + d), gv = *(const float4*)(gt + d); float4 yv;
            if (yb) { const uint2 a = *(const uint2*)(yb + (size_t)(2 * t) * D + d), bq = *(const uint2*)(yb + (size_t)(2 * t + 1) * D + d);
                yv.x = __uint_as_float(a.x << 16) + __uint_as_float(bq.x << 16); yv.y = __uint_as_float(a.x & 0xffff0000u) + __uint_as_float(bq.x & 0xffff0000u);
                yv.z = __uint_as_float(a.y << 16) + __uint_as_float(bq.y << 16); yv.w = __uint_as_float(a.y & 0xffff0000u) + __uint_as_float(bq.y & 0xffff0000u); }
            else yv = *(const float4*)(y0 + d);
            if (y1) { const float4 y2 = *(const float4*)(y1 + d); yv.x += y2.x; yv.y += y2.y; yv.z += y2.z; yv.w += y2.w; }
            z[i].x = ALPHA * xv.x + (1.f + gv.x) * yv.x; z[i].y = ALPHA * xv.y + (1.f + gv.y) * yv.y; z[i].z = ALPHA * xv.z + (1.f + gv.z) * yv.z; z[i].w = ALPHA * xv.w + (1.f + gv.w) * yv.w;
            sum += (z[i].x + z[i].y) + (z[i].z + z[i].w); }
        sum = wave_sum(sum); const float mu = sum * (1.f / D);
        float var = 0.f;
#pragma unroll
        for (int i = 0; i < 8; ++i) { const float a = z[i].x - mu, bq = z[i].y - mu, c = z[i].z - mu, dd = z[i].w - mu; var += (a * a + bq * bq) + (c * c + dd * dd); }
        var = wave_sum(var) * (1.f / D);
        const float rs = 1.0f / sqrtf(var + LN_EPS);
#pragma unroll
        for (int i = 0; i < 8; ++i) { const int d = (i * 64 + lane) * 4; const float4 gg = *(const float4*)(g + d), bb = *(const float4*)(bta + d);
            float4 o; o.x = (z[i].x - mu) * rs * gg.x + bb.x; o.y = (z[i].y - mu) * rs * gg.y + bb.y; o.z = (z[i].z - mu) * rs * gg.z + bb.z; o.w = (z[i].w - mu) * rs * gg.w + bb.w;
            *(float4*)(out + (size_t)t * D + d) = o; }
    }
};

typedef short bf16x8_t __attribute__((ext_vector_type(8)));
typedef _Float16 f16x8_t __attribute__((ext_vector_type(8)));
typedef float f32x4_t __attribute__((ext_vector_type(4)));
template <int MODE, bool XBF> struct RowF {
    const bf16_t* xb; bf16_t* outb;
    const float* x; const bf16_t* y; const bf16_t* yb; const float* modg; const float* g; const float* bta; float* out;
    const float* modn; bf16_t* hb; const bf16_t* whi; const bf16_t* wlo;
    const float* bg; const float* br; int* wgcnt; int* tok_e; int* tok_pos; float* tok_w; float* flog;
    __device__ __forceinline__ void run(int nvb) const {
        constexpr int NCB = MODE == 0 ? 3 : 1, NC = NCB * 16, HS = 2056, LOGIT_BATCHES = MODE == 0 ? 2 : 1;
        _Float16* H = (_Float16*)g_lds; float* P = (float*)(g_lds + 66048); float* Lg = (float*)(g_lds + 90624);
        LAS int* lc = (LAS int*)(g_lds + 93696);
        float* Vg = (float*)(g_lds + 93952); float* Vb = Vg + D; float* Vgate = Vb + D; float* Vsh = Vgate + D; float* Vsc = Vsh + D;
        const int tid = otid(), wave = tid >> 6, lane = tid & 63, G = gridDim.x;
        __syncthreads();
        float* Bs = (float*)(g_lds + 134912);
        if (MODE == 0) { if (tid < 32) lc[tid] = 0; if (tid < 36) Bs[tid] = tid < 4 ? bg[tid] : br[tid - 4]; }
        { const float4 a = *(const float4*)(g + tid * 4), c = *(const float4*)(bta + tid * 4); *(float4*)(Vg + tid * 4) = a; *(float4*)(Vb + tid * 4) = c; }
        int bcur = -1;
        float4 xv[8]; uint2 xq[8], ya[8], yc[8];
#define ROWF_LOAD(t_) do { _Pragma("unroll") for (int i_ = 0; i_ < 8; ++i_) { const int d_ = (i_ * 64 + lane) * 4; \
                    if (XBF) { xq[i_] = *(const uint2*)(xb + (size_t)(t_) * D + d_); xv[i_] = make_float4(0.f, 0.f, 0.f, 0.f); } else { xv[i_] = *(const float4*)(x + (size_t)(t_) * D + d_); xq[i_] = make_uint2(0u, 0u); } \
                    if (MODE != 0) { ya[i_] = *(const uint2*)(yb + (size_t)(2 * (t_)) * D + d_); yc[i_] = *(const uint2*)(yb + (size_t)(2 * (t_) + 1) * D + d_); } \
                    else { ya[i_] = *(const uint2*)(y + (size_t)(t_) * D + d_); yc[i_] = make_uint2(0u, 0u); } } } while (0)
        if (obid() < nvb) ROWF_LOAD(obid() * 16 + wave * 2);
        for (int vb = obid(); vb < nvb; vb += G) {
            const int b = (vb * 16) / S;
            if (b != bcur) {
                __syncthreads();
                const int tq = otid() * 4;
                { float4 a = *(const float4*)(modg + (size_t)b * 3 * D + 2 * D + tq); a.x += 1.f; a.y += 1.f; a.z += 1.f; a.w += 1.f; *(float4*)(Vgate + tq) = a; }
                if (MODE != 2) { const float4 sh4 = *(const float4*)(modn + (size_t)b * 3 * D + tq); float4 c = *(const float4*)(modn + (size_t)b * 3 * D + D + tq); c.x += 1.f; c.y += 1.f; c.z += 1.f; c.w += 1.f;
                    *(float4*)(Vsh + tq) = sh4; *(float4*)(Vsc + tq) = c; }
                __syncthreads(); bcur = b; }
            const int t0 = vb * 16 + wave * 2;
#pragma unroll
            for (int r = 0; r < 2; ++r) { const int t = t0 + r;
                float4 z[8]; float sum = 0.f;
#pragma unroll
                for (int i = 0; i < 8; ++i) { const int d = (i * 64 + lane) * 4;
                    const float4 gv = *(const float4*)(Vgate + d); float4 yv;
                    yv.x = __uint_as_float(ya[i].x << 16); yv.y = __uint_as_float(ya[i].x & 0xffff0000u); yv.z = __uint_as_float(ya[i].y << 16); yv.w = __uint_as_float(ya[i].y & 0xffff0000u);
                    if (MODE != 0) { yv.x += __uint_as_float(yc[i].x << 16); yv.y += __uint_as_float(yc[i].x & 0xffff0000u); yv.z += __uint_as_float(yc[i].y << 16); yv.w += __uint_as_float(yc[i].y & 0xffff0000u); }
                    float4 xf = xv[i]; if (XBF) { xf.x = __uint_as_float(xq[i].x << 16); xf.y = __uint_as_float(xq[i].x & 0xffff0000u); xf.z = __uint_as_float(xq[i].y << 16); xf.w = __uint_as_float(xq[i].y & 0xffff0000u); }
                    z[i].x = ALPHA * xf.x + gv.x * yv.x; z[i].y = ALPHA * xf.y + gv.y * yv.y; z[i].z = ALPHA * xf.z + gv.z * yv.z; z[i].w = ALPHA * xf.w + gv.w * yv.w;
                    sum += (z[i].x + z[i].y) + (z[i].z + z[i].w); }
                if (r == 0) { __builtin_amdgcn_sched_barrier(0); ROWF_LOAD(t0 + 1); __builtin_amdgcn_sched_barrier(0); }
                else if (vb + G < nvb) { __builtin_amdgcn_sched_barrier(0); ROWF_LOAD((vb + G) * 16 + wave * 2); __builtin_amdgcn_sched_barrier(0); }
                sum = wave_sum(sum); const float mu = sum * (1.f / D);
                float var = 0.f;
#pragma unroll
                for (int i = 0; i < 8; ++i) { const float a = z[i].x - mu, bq = z[i].y - mu, c = z[i].z - mu, dd = z[i].w - mu; var += (a * a + bq * bq) + (c * c + dd * dd); }
                var = wave_sum(var) * (1.f / D);
                const float rs = 1.0f / sqrtf(var + LN_EPS);
#pragma unroll
                for (int i = 0; i < 8; ++i) { const int d = (i * 64 + lane) * 4; const float4 gg = *(const float4*)(Vg + d), bb = *(const float4*)(Vb + d);
                    float4 o; o.x = (z[i].x - mu) * rs * gg.x + bb.x; o.y = (z[i].y - mu) * rs * gg.y + bb.y; o.z = (z[i].z - mu) * rs * gg.z + bb.z; o.w = (z[i].w - mu) * rs * gg.w + bb.w;
                    if (MODE == 2) { *(float4*)(out + (size_t)t * D + d) = o; continue; }
                    { uint2 ow; ow.x = pkbf(o.x, o.y); ow.y = pkbf(o.z, o.w); *(uint2*)(outb + (size_t)t * D + d) = ow; }
                    const float4 s4 = *(const float4*)(Vsh + d), c4 = *(const float4*)(Vsc + d);
                    float4 h; h.x = o.x * c4.x + s4.x; h.y = o.y * c4.y + s4.y; h.z = o.z * c4.z + s4.z; h.w = o.w * c4.w + s4.w;
                    uint2 w; w.x = pkbf(h.x, h.y); w.y = pkbf(h.z, h.w); *(uint2*)(hb + (size_t)t * D + d) = w;
                    typedef _Float16 f16x4_t __attribute__((ext_vector_type(4)));
                    f16x4_t hq; hq[0] = (_Float16)h.x; hq[1] = (_Float16)h.y; hq[2] = (_Float16)h.z; hq[3] = (_Float16)h.w;
                    *(f16x4_t*)(H + (wave * 2 + r) * HS + d) = hq; } }
            if (MODE == 2) continue;
            __syncthreads();
            f32x4_t acc[NCB];
#pragma unroll
            for (int cb = 0; cb < NCB; ++cb) acc[cb] = (f32x4_t){0.f, 0.f, 0.f, 0.f};
            const int row = lane & 15, kg = lane >> 4, col = lane & 15;
            constexpr int KBATCH = 8 / LOGIT_BATCHES;
#pragma unroll
            for (int kq = 0; kq < LOGIT_BATCHES; ++kq) {
                f16x8_t Bw[KBATCH][NCB];
#pragma unroll
                for (int k2 = 0; k2 < KBATCH; ++k2)
#pragma unroll
                    for (int cb = 0; cb < NCB; ++cb) Bw[k2][cb] = *(const f16x8_t*)((const _Float16*)whi + ((size_t)((wave * 8 + kq * KBATCH + k2) * NCB + cb) * 64 + lane) * 8);
                __builtin_amdgcn_sched_barrier(0);
#pragma unroll
                for (int k2 = 0; k2 < KBATCH; ++k2) { const int kb = wave * 256 + (kq * KBATCH + k2) * 32 + kg * 8;
                    const f16x8_t A = *(const f16x8_t*)(H + row * HS + kb);
#pragma unroll
                    for (int cb = 0; cb < NCB; ++cb) acc[cb] = __builtin_amdgcn_mfma_f32_16x16x32_f16(A, Bw[k2][cb], acc[cb], 0, 0, 0); }
                __builtin_amdgcn_sched_barrier(0); }
#pragma unroll
            for (int cb = 0; cb < NCB; ++cb)
#pragma unroll
                for (int i = 0; i < 4; ++i) P[(wave * 16 + 4 * (lane >> 4) + i) * 48 + cb * 16 + col] = acc[cb][i];
            __syncthreads();
            for (int idx = tid; idx < 16 * NC; idx += NTHR) { const int r = idx / NC, c = idx - r * NC; float a = 0.f;
#pragma unroll
                for (int w = 0; w < 8; ++w) a += P[(w * 16 + r) * 48 + c];
                Lg[r * 48 + c] = a; }
            __syncthreads();
#pragma unroll
            for (int r = 0; r < 2; ++r) { const int t = t0 + r; const float* lr = Lg + (wave * 2 + r) * 48;
                if (MODE == 1) { if (lane < 16) flog[(size_t)t * 16 + lane] = lr[lane]; }
                else {
                    float gl[4] = {lr[0] + Bs[0], lr[1] + Bs[1], lr[2] + Bs[2], lr[3] + Bs[3]};
                    int gi = 0; float gm = gl[0];
#pragma unroll
                    for (int c = 1; c < 4; ++c) if (gl[c] > gm) { gm = gl[c]; gi = c; }
                    float gs = 0.f;
#pragma unroll
                    for (int c = 0; c < 4; ++c) gs += expf(gl[c] - gm);
                    const float gw = 1.f / gs;
                    float e[8];
#pragma unroll
                    for (int c = 0; c < 8; ++c) e[c] = lr[4 + gi * 8 + c] + Bs[4 + gi * 8 + c];
                    int i0 = 0; float v0 = e[0];
#pragma unroll
                    for (int c = 1; c < 8; ++c) if (e[c] > v0) { v0 = e[c]; i0 = c; }
                    int i1 = -1; float v1 = -INFINITY;
#pragma unroll
                    for (int c = 0; c < 8; ++c) if (c != i0 && e[c] > v1) { v1 = e[c]; i1 = c; }
                    const float ex = expf(v1 - v0), pa = 1.f / (1.f + ex), pb = ex / (1.f + ex);
                    if (lane == 0) {
                        const int e0 = gi * 8 + i0, e1 = gi * 8 + i1;
                        tok_e[2 * t] = e0; tok_e[2 * t + 1] = e1;
                        tok_w[2 * t] = gw * pa; tok_w[2 * t + 1] = gw * pb;
                        tok_pos[2 * t] = __hip_atomic_fetch_add(lc + e0, 1, __ATOMIC_RELAXED, __HIP_MEMORY_SCOPE_WORKGROUP); tok_pos[2 * t + 1] = __hip_atomic_fetch_add(lc + e1, 1, __ATOMIC_RELAXED, __HIP_MEMORY_SCOPE_WORKGROUP);
                    }
                }
            }
        }
#undef ROWF_LOAD
        if (MODE == 0) { __syncthreads(); const int t2 = otid(); if (t2 < 32) wgcnt[obid() * 32 + t2] = lc[t2]; }
    }
};
struct SmallWF {
    const float* wg; const float* wr; const float* bwin; bf16_t* rhi; bf16_t* rlo; bf16_t* fhi; bf16_t* flo;
    __device__ __forceinline__ void operator()(int vb) const {
        const int i = vb * NTHR + otid();
        float w; bf16_t* ph; bf16_t* pl; int k, col, ncb;
        if (i < 2 * 48 * D) { const int layer = i / (48 * D); k = i % D; col = (i / D) % 48; ncb = 3;
            if (col < 4) w = wg[((size_t)layer * D + k) * 4 + col];
            else if (col < 36) { const int gq = (col - 4) >> 3, e = (col - 4) & 7; w = wr[(((size_t)layer * 4 + gq) * D + k) * 8 + e]; }
            else w = 0.f;
            ph = rhi + (size_t)layer * 48 * D; pl = rlo + (size_t)layer * 48 * D; }
        else { const int j = i - 2 * 48 * D; k = j % D; col = j / D; ncb = 1; w = bwin[(size_t)k * 6160 + 6144 + col]; ph = fhi; pl = flo; }
        const size_t o = ((size_t)((((k >> 8) * 8 + ((k >> 5) & 7)) * ncb + (col >> 4)) * 64 + ((k >> 3) & 3) * 16 + (col & 15))) * 8 + (k & 7);
        (void)pl; ((_Float16*)ph)[o] = (_Float16)w;
    }
};

struct InitF {
    int* cnt; int* slot_token; int* panel_e; unsigned* nrm2;
    __device__ __forceinline__ void operator()(int vb) const {
        const int i = vb * NTHR + otid();
        if (i < 32) cnt[i] = 0;
        if (nrm2 && i < 512) nrm2[i] = 0u;
        if (i < NPANEL) panel_e[i] = -1;
        if (i < MAXSLOT) slot_token[i] = -1;
    }
};
struct RouteF {
    const float* h; const float* wg; const float* bg; const float* wr; const float* br;
    int* cnt; int* tok_e; int* tok_pos; float* tok_w;
    __device__ __forceinline__ void operator()(int vb) const {
        const int tid = otid(), wave = tid >> 6, lane = tid & 63;
        const int t = vb * 8 + wave;
        const float* hr = h + (size_t)t * D;
        float hv[32];
#pragma unroll
        for (int i = 0; i < 32; ++i) hv[i] = hr[lane + 64 * i];
        float p0 = 0.f, p1 = 0.f, p2 = 0.f, p3 = 0.f;
#pragma unroll
        for (int i = 0; i < 32; ++i) { const float4 w = *(const float4*)(wg + (size_t)(lane + 64 * i) * 4); p0 += hv[i] * w.x; p1 += hv[i] * w.y; p2 += hv[i] * w.z; p3 += hv[i] * w.w; }
        float gl[4] = {wave_sum(p0) + bg[0], wave_sum(p1) + bg[1], wave_sum(p2) + bg[2], wave_sum(p3) + bg[3]};
        int gi = 0; float gm = gl[0];
#pragma unroll
        for (int c = 1; c < 4; ++c) if (gl[c] > gm) { gm = gl[c]; gi = c; }
        float gs = 0.f;
#pragma unroll
        for (int c = 0; c < 4; ++c) gs += expf(gl[c] - gm);
        const float gw = 1.f / gs;
        const float* wrg = wr + (size_t)gi * D * 8;
        float e[8];
#pragma unroll
        for (int c = 0; c < 8; ++c) e[c] = 0.f;
#pragma unroll
        for (int i = 0; i < 32; ++i) { const float4 wa = *(const float4*)(wrg + (size_t)(lane + 64 * i) * 8), wb = *(const float4*)(wrg + (size_t)(lane + 64 * i) * 8 + 4);
            e[0] += hv[i] * wa.x; e[1] += hv[i] * wa.y; e[2] += hv[i] * wa.z; e[3] += hv[i] * wa.w; e[4] += hv[i] * wb.x; e[5] += hv[i] * wb.y; e[6] += hv[i] * wb.z; e[7] += hv[i] * wb.w; }
#pragma unroll
        for (int c = 0; c < 8; ++c) e[c] = wave_sum(e[c]) + br[gi * 8 + c];
        int i0 = 0; float v0 = e[0];
#pragma unroll
        for (int c = 1; c < 8; ++c) if (e[c] > v0) { v0 = e[c]; i0 = c; }
        int i1 = -1; float v1 = -INFINITY;
#pragma unroll
        for (int c = 0; c < 8; ++c) if (c != i0 && e[c] > v1) { v1 = e[c]; i1 = c; }
        const float ex = expf(v1 - v0), pa = 1.f / (1.f + ex), pb = ex / (1.f + ex);
        if (lane == 0) {
            const int e0 = gi * 8 + i0, e1 = gi * 8 + i1;
            tok_e[2 * t] = e0; tok_e[2 * t + 1] = e1;
            tok_w[2 * t] = gw * pa; tok_w[2 * t + 1] = gw * pb;
            tok_pos[2 * t] = atomicAdd(cnt + e0, 1); tok_pos[2 * t + 1] = atomicAdd(cnt + e1, 1);
        }
    }
};
struct ScatterF {
    const int* cnt; const int* tok_e; const int* tok_pos; const float* tok_w;
    int* tok_slot; int* slot_token; float* slot_w; int* panel_e; int* npan;
    __device__ __forceinline__ void operator()(int vb) const {
        const int i = vb * NTHR + otid();
        if (i < 2 * NTOK) {
            const int e = tok_e[i]; int off = 0;
            for (int q = 0; q < e; ++q) off += (cnt[q] + 255) & ~255;
            const int slot = off + tok_pos[i];
            tok_slot[i] = slot; slot_token[slot] = i; slot_w[slot] = tok_w[i];
        }
        if (vb == 0 && otid() < 32) {
            const int e = otid(); int off = 0;
            for (int q = 0; q < e; ++q) off += (cnt[q] + 255) & ~255;
            const int np = (cnt[e] + 255) >> 8;
            for (int p = 0; p < np; ++p) panel_e[(off >> 8) + p] = e;
            if (e == 31) npan[0] = (off >> 8) + np;
        }
    }
};
struct GatherF {
    const bf16_t* hb; bf16_t* Hs; const int* slot_token; float* slot_w; const int* npan;
    __device__ __forceinline__ void operator()(int vb) const {
        const int tid = otid(), wave = tid >> 6, lane = tid & 63;
        const int slot = vb * 8 + wave;
        if (slot >= npan[0] * 256) return;
        const int st = slot_token[slot];
        uint4* dst = (uint4*)(Hs + (size_t)slot * D) + lane;
        if (st >= 0) { const uint4* src = (const uint4*)(hb + (size_t)(st >> 1) * D) + lane;
#pragma unroll
            for (int j = 0; j < 4; ++j) dst[64 * j] = src[64 * j]; }
        else { const uint4 z = make_uint4(0u, 0u, 0u, 0u);
#pragma unroll
            for (int j = 0; j < 4; ++j) dst[64 * j] = z;
            if (lane == 0) slot_w[slot] = 0.f; }
    }
};
struct ScatF {
    const int* wgcnt; const int* tok_e; const int* tok_pos; const float* tok_w;
    int* slot_token; float* slot_w; int* panel_e; int* npan;
    __device__ __forceinline__ void operator()(int vb) const {
        int* base = (int*)g_lds;
        int* sego = base + 256 * 32;
        int* tot = sego + 16 * 32;
        int* off = tot + 32;
        const int tid = otid(), G = gridDim.x;
        __syncthreads();
        { const int e = tid & 31, seg = tid >> 5; int run = 0;
#pragma unroll
          for (int j = 0; j < 16; ++j) { const int w = seg * 16 + j; const int c = w < G ? wgcnt[w * 32 + e] : 0; base[w * 32 + e] = run; run += c; }
          sego[seg * 32 + e] = run; }
        __syncthreads();
        if (tid < 32) { int run = 0;
#pragma unroll
            for (int sgi = 0; sgi < 16; ++sgi) { const int c = sego[sgi * 32 + tid]; sego[sgi * 32 + tid] = run; run += c; }
            tot[tid] = run; }
        __syncthreads();
        if (tid == 0) { int run = 0; for (int e = 0; e < 32; ++e) { off[e] = run; run += (tot[e] + 255) & ~255; } }
        __syncthreads();
        const int i = vb * NTHR + tid;
        if (i < 2 * NTOK) {
            const int e = tok_e[i], w = ((i >> 1) >> 4) % G;
            const int slot = off[e] + sego[(w >> 4) * 32 + e] + base[w * 32 + e] + tok_pos[i];
            slot_token[slot] = i; slot_w[slot] = tok_w[i];
        } else if (i < 2 * NTOK + 32 * 256) {
            const int idx = i - 2 * NTOK, e = idx >> 8, r = idx & 255, c = tot[e], npad = ((c + 255) & ~255) - c;
            if (r < npad) slot_w[off[e] + c + r] = 0.f;
        }
        if (vb == 0 && tid < 32) {
            const int e = tid, np = (tot[e] + 255) >> 8;
            for (int q = 0; q < np; ++q) panel_e[(off[e] >> 8) + q] = e;
            if (e == 31) npan[0] = (off[e] >> 8) + np;
        }
        __syncthreads();
    }
};
struct HidF {
    float* a; const float* u; const float* slot_w; const int* slot_token; const int* panel_e;
    __device__ __forceinline__ void operator()(int vb) const {
        const size_t i4 = (size_t)vb * NTHR + otid(); const size_t e = i4 * 4; const int slot = (int)(e / 512);
        if (panel_e[slot >> 8] < 0) return;
        float4 o = make_float4(0.f, 0.f, 0.f, 0.f);
        if (slot_token[slot] >= 0) { const float w = slot_w[slot]; const float4 av = *(const float4*)(a + e), uv = *(const float4*)(u + e);
            o.x = av.x / (1.f + expf(-av.x)) * uv.x * w; o.y = av.y / (1.f + expf(-av.y)) * uv.y * w; o.z = av.z / (1.f + expf(-av.z)) * uv.z * w; o.w = av.w / (1.f + expf(-av.w)) * uv.w * w; }
        *(float4*)(a + e) = o;
    }
};

struct RopeHF {
    bf16_t* q; bf16_t* k; const float* tab;
    __device__ __forceinline__ void operator()(int vb) const {
        const size_t idx = (size_t)vb * NTHR + otid();
        const int i = (int)(idx & 63), s = (int)((idx >> 6) & 4095), bh = (int)((idx >> 18) & 63), which = (int)(idx >> 24);
        bf16_t* pp = (which ? k : q) + ((size_t)bh * S + s) * 128 + i;
        const float c = tab[((size_t)s * 64 + i) * 2], sn = tab[((size_t)s * 64 + i) * 2 + 1];
        const float x1 = __uint_as_float((unsigned)pp[0] << 16), x2 = __uint_as_float((unsigned)pp[64] << 16);
        pp[0] = (bf16_t)(pkbf(x1 * c - x2 * sn, 0.f) & 0xffffu); pp[64] = (bf16_t)(pkbf(x2 * c + x1 * sn, 0.f) & 0xffffu);
    }
};
struct CombineF {
    const bf16_t* o1; const bf16_t* o2; const float* lam; const float* w; bf16_t* ob;
    __device__ __forceinline__ void load(int vb, int wave, int lane, uint2 (&a)[4], uint2 (&bq)[4]) const {
        const size_t g0 = ((size_t)vb * 8 + wave) * 4;
#pragma unroll
        for (int j = 0; j < 4; ++j) { a[j] = *(const uint2*)(o1 + (g0 + j) * 256 + lane * 4); bq[j] = *(const uint2*)(o2 + (g0 + j) * 256 + lane * 4); }
    }
    __device__ __forceinline__ void finish(int vb, int wave, int lane, const uint2 (&a)[4], const uint2 (&bq)[4], float lm, const float4 ww) const {
        const size_t g0 = ((size_t)vb * 8 + wave) * 4;
#pragma unroll
        for (int j = 0; j < 4; ++j) {
            const float v0 = __uint_as_float(a[j].x << 16) - lm * __uint_as_float(bq[j].x << 16), v1 = __uint_as_float(a[j].x & 0xffff0000u) - lm * __uint_as_float(bq[j].x & 0xffff0000u);
            const float v2 = __uint_as_float(a[j].y << 16) - lm * __uint_as_float(bq[j].y << 16), v3 = __uint_as_float(a[j].y & 0xffff0000u) - lm * __uint_as_float(bq[j].y & 0xffff0000u);
            float ss = v0 * v0 + v1 * v1 + v2 * v2 + v3 * v3; ss = wave_sum(ss);
            const float r = 1.0f / sqrtf(ss * (1.f / 256.f) + RMS_EPS) * (1.f - LAM_INIT0);
            uint2 q; q.x = pkbf(v0 * r * ww.x, v1 * r * ww.y); q.y = pkbf(v2 * r * ww.z, v3 * r * ww.w);
            *(uint2*)(ob + (g0 + j) * 256 + lane * 4) = q; }
    }
    __device__ __forceinline__ void run(int nvb) const {
        const int tid = otid(), wave = __builtin_amdgcn_readfirstlane(tid >> 6), lane = tid & 63, G = gridDim.x, it0 = obid();
        const int nit = it0 < nvb ? (nvb - it0 + G - 1) / G : 0;
        if (nit <= 0) return;
        const int last = it0 + (nit - 1) * G;
        const float lm = lam[0]; const float4 ww = *(const float4*)(w + lane * 4);
        uint2 a0[4], b0[4], a1[4], b1[4];
        int it = it0, k = 0;
        load(it, wave, lane, a0, b0);
        for (; k + 1 < nit; k += 2) {
            load(it + G, wave, lane, a1, b1);
            __builtin_amdgcn_sched_barrier(0);
            finish(it, wave, lane, a0, b0, lm, ww);
            __builtin_amdgcn_sched_barrier(0);
            load(it + 2 * G < last ? it + 2 * G : last, wave, lane, a0, b0);
            __builtin_amdgcn_sched_barrier(0);
            finish(it + G, wave, lane, a1, b1, lm, ww);
            it += 2 * G;
        }
        if (k < nit) finish(it, wave, lane, a0, b0, lm, ww);
    }
};
struct CumBF {
    const float* flog; const float* fb; float* bz;
    __device__ __forceinline__ void operator()(int vb) const {
        float* tot = (float*)g_lds;
        const int b = vb >> 4, h = vb & 15, tid = otid();
        float v[8]; float run = 0.f;
#pragma unroll
        for (int j = 0; j < 8; ++j) { const float x = flog[((size_t)b * S + tid * 8 + j) * 16 + h] + fb[h];
            const float ls = fminf(x, 0.f) - log1pf(expf(-fabsf(x))); run += ls; v[j] = run; }
        __syncthreads();
        tot[tid] = run;
        __syncthreads();
        if (tid < 64) { float t8[8]; float a = 0.f;
#pragma unroll
            for (int j = 0; j < 8; ++j) { t8[j] = tot[tid * 8 + j]; a += t8[j]; }
            float inc = a;
#pragma unroll
            for (int o = 1; o < 64; o <<= 1) { const float v = __shfl_up(inc, o); if (tid >= o) inc += v; }
            float ex = inc - a;
#pragma unroll
            for (int j = 0; j < 8; ++j) { tot[tid * 8 + j] = ex; ex += t8[j]; } }
        __syncthreads();
        const float off = tot[tid];
#pragma unroll
        for (int j = 0; j < 8; ++j) bz[((size_t)b * 16 + h) * S + tid * 8 + j] = -(v[j] + off) * 11.313708498984761f;
        __syncthreads();
    }
};
struct AttnArgs { const bf16_t* q; const bf16_t* k; const bf16_t* v; bf16_t* o0; bf16_t* o1; const float* bz; const unsigned* nrm2; };
typedef swa::BlockRef<__hip_bfloat16, __hip_bfloat16> ARef;
template <int LAYER> __device__ __forceinline__ ARef attn_ref(const AttnArgs& a, int prob, int qb) {
    ARef r; r.P0 = qb * 256; r.Bz = nullptr; r.JLO = 0;
    if (LAYER == 0) {
        const int vh = prob & 1, c = (prob >> 1) & 1, h = (prob >> 2) & 7, b = prob >> 5, qh = 2 * h + c, vv = 2 * h + vh;
        r.Q = (const __hip_bfloat16*)a.q + ((size_t)(b * 16 + qh) * S + qb * 256) * 128;
        r.K = (const __hip_bfloat16*)a.k + (size_t)(b * 16 + qh) * S * 128;
        r.V = (const __hip_bfloat16*)a.v + (size_t)(b * 16 + vv) * S * 128;
        r.O = (__hip_bfloat16*)(c ? a.o1 : a.o0) + ((size_t)b * S + qb * 256) * D + h * 256 + vh * 128;
    } else {
        r.Q = (const __hip_bfloat16*)a.q + ((size_t)prob * S + qb * 256) * 128;
        r.K = (const __hip_bfloat16*)a.k + (size_t)prob * S * 128;
        r.V = (const __hip_bfloat16*)a.v + (size_t)prob * S * 128;
        r.O = (__hip_bfloat16*)a.o0 + ((size_t)(prob >> 4) * S + qb * 256) * D + (prob & 15) * 128;
        r.Bz = a.bz + (size_t)prob * S;
    }
    return r;
}
template <int NPROB> __device__ __forceinline__ void attn_item(int L, int& prob, int& x) { const int xc = L & 7, j = L >> 3; prob = xc * (NPROB / 8) + (j >> 3); x = j & 7; }
__device__ __forceinline__ float fox_R(const AttnArgs& a, int prob) {
    const float q2 = __uint_as_float(__hip_atomic_load(a.nrm2 + prob, __ATOMIC_RELAXED, __HIP_MEMORY_SCOPE_AGENT)), k2 = __uint_as_float(__hip_atomic_load(a.nrm2 + 64 + prob, __ATOMIC_RELAXED, __HIP_MEMORY_SCOPE_AGENT));
    return 2.f * sqrtf(q2 * k2) * 1.02f + 339.5f;
}
__device__ __forceinline__ int fox_jlo2(const AttnArgs& a, int prob, int x) {
    const float* bzp = a.bz + (size_t)prob * S; const int lane = otid() & 63;
    const float v = bzp[64 * lane + 63], f = bzp[256 * (lane & 15)], R = fox_R(a, prob);
    const float f0 = __shfl(f, x), f1 = __shfl(f, 15 - x);
    return __popcll(__ballot(f0 - v >= R)) | (__popcll(__ballot(f1 - v >= R)) << 8);
}
struct FoxPair { int probA, probB, x; bool paired; };
__device__ __forceinline__ FoxPair fox_pairing(const AttnArgs& a) {
    FoxPair fp; fp.probA = fp.probB = fp.x = 0; fp.paired = gridDim.x == 256;
    if (!fp.paired) return fp;
    const int bid = obid(), c = bid & 7, b = c >> 1, g = c & 1, j = bid >> 3, slot = j >> 3;
    LAS int* cost = (LAS int*)(g_lds + 100 * 1024); LAS int* order = cost + 16;
    const int tid = otid(), wave = __builtin_amdgcn_readfirstlane(tid >> 6), lane = tid & 63;
    __syncthreads();
#pragma unroll 1
    for (int hh = 0; hh < 2; ++hh) { const int h = wave * 2 + hh, prob = b * 16 + h;
        const float* bzp = a.bz + (size_t)prob * S;
        const float v = bzp[64 * lane + 63], f = bzp[256 * (lane & 15)], R = fox_R(a, prob);
        int cst = 0;
#pragma unroll
        for (int q = 0; q < 16; ++q) cst += 4 * (q + 1) + 1 - __popcll(__ballot(__shfl(f, q) - v >= R));
        if (lane == 0) cost[h] = cst; }
    __syncthreads();
    if (tid < 16) { const int ch = cost[tid]; int rk = 0;
        for (int h2 = 0; h2 < 16; ++h2) { const int c2 = cost[h2]; rk += (c2 > ch || (c2 == ch && h2 < tid)) ? 1 : 0; }
        order[rk] = tid; }
    __syncthreads();
    const int p = g == 0 ? (slot == 0 ? 0 : slot == 1 ? 3 : slot == 2 ? 4 : 7) : (slot == 0 ? 1 : slot == 1 ? 2 : slot == 2 ? 5 : 6);
    fp.probA = b * 16 + order[p]; fp.probB = b * 16 + order[15 - p]; fp.x = j & 7;
    __syncthreads();
    return fp;
}
template <int LAYER> __device__ __forceinline__ void attn_item_of(const FoxPair& fp, int i, int L, int& prob, int& x) {
    if (LAYER == 1 && fp.paired) { prob = (i & 1) ? fp.probB : fp.probA; x = (i & 1) ? 7 - fp.x : fp.x; }
    else { attn_item<LAYER == 0 ? 128 : 64>(L, prob, x); if (LAYER == 1 && (i & 1)) x = 7 - x; }
}
template <int LAYER> __device__ __forceinline__ void attn_stream(const AttnArgs& a, const FoxPair& fp, int i0, int i1) {
    constexpr int NPROB = LAYER == 0 ? 128 : 64, NX = 8, TOTAL = NPROB * NX;
    char* lds = (char*)g_lds;
    const int stride = gridDim.x;
    int i = i0, L = obid() + i0 * stride; if (i0 >= i1 || L >= TOTAL) return;
    int pass = 0, prob, x, jp = 0;
    if (LAYER == 1) {
        attn_item_of<LAYER>(fp, i0, L, prob, x); jp = fox_jlo2(a, prob, x);
        if (i0 + 1 < i1 && L + stride < TOTAL) { attn_item_of<LAYER>(fp, i0 + 1, L + stride, prob, x); jp |= fox_jlo2(a, prob, x) << 16; } }
#define JLO_OF(ii, ps) ((LAYER == 1 && (ii) - i0 < 2) ? ((jp >> (16 * ((ii) - i0) + 8 * (ps))) & 255) : 0)
    attn_item_of<LAYER>(fp, i, L, prob, x);
    ARef cur = attn_ref<LAYER>(a, prob, x); cur.JLO = JLO_OF(i, 0);
    swa::Seam<__hip_bfloat16> Sm;
    swa::causal_swa_prime<__hip_bfloat16, __hip_bfloat16>(cur, S, lds, Sm);
    for (;;) {
        const bool more_pass = pass == 0, more_item = (i + 1 < i1) && (L + stride < TOTAL), last = !more_pass && !more_item;
        int passn = pass + 1, Ln = L, in = i;
        if (!more_pass) { passn = 0; if (more_item) { Ln = L + stride; in = i + 1; } }
        attn_item_of<LAYER>(fp, in, Ln, prob, x);
        ARef nxt = last ? cur : attn_ref<LAYER>(a, prob, passn ? 15 - x : x);
        if (!last) nxt.JLO = JLO_OF(in, passn);
        swa::causal_swa_block<__hip_bfloat16, __hip_bfloat16, D, LAYER == 1>(cur, nxt, S, S, lds, Sm);
        if (last) break;
        cur = nxt; pass = passn; L = Ln; i = in;
    }
#undef JLO_OF
}
struct Params {
    const float* x; const float* c;
    const float* mix_mod_w; const float* mix_mod_b; const float* mix_ln_g; const float* mix_ln_b;
    const float* a_w_in; const float* a_lq1; const float* a_lk1; const float* a_lq2; const float* a_lk2; const float* a_subln; const float* a_w_out;
    const float* b_w_in; const float* b_fb; const float* b_w_out;
    const float* ffn_mod_w; const float* ffn_mod_b; const float* ffn_ln_g; const float* ffn_ln_b;
    const float* moe_wg; const float* moe_bg; const float* moe_wr; const float* moe_br; const float* moe_gate; const float* moe_up; const float* moe_down;
    float* out; unsigned* bar;
    float* modv; float* ropet; float* lam; float* cum; int* cnt; int* tok_e; int* tok_pos; float* tok_w; int* tok_slot; int* slot_token; float* slot_w; int* panel_e;
    float* xA; float* xB; float* hbuf; float* abuf; float* ubuf; float* obuf; float* projb; float* sc1; float* sc2; float* y2;
    bf16_t* hb; bf16_t* ob; bf16_t* wt_in[2]; bf16_t* wt_out[2];
    bf16_t* qh; bf16_t* kh; bf16_t* vh; bf16_t* o1; bf16_t* o2; float* flog; float* bz;
    bf16_t* wgu; bf16_t* wdn; bf16_t* wgu1; bf16_t* wdn1; bf16_t* Hs; bf16_t* hid; bf16_t* y2b; int* npan; float* modp; bf16_t* yb16;
    bf16_t* rhi; bf16_t* rlo; bf16_t* fhi; bf16_t* flo; int* wgcnt; bf16_t* xAb; bf16_t* xBb; unsigned* nrm2;
};

template <class F> __device__ __forceinline__ void phase(const F& f, int nvb, const XcdBarrier& bar) {
    for (int vb = obid(); vb < nvb; vb += gridDim.x) f(vb);
    xcd_barrier(bar);
}
template <class F> __device__ __forceinline__ void run_nb(const F& f, int nvb) { for (int vb = obid(); vb < nvb; vb += gridDim.x) f(vb); }
__device__ __forceinline__ void gemm(const XcdBarrier& bar, const float* A, int lda, const float* B, int ldb, float* C, int ldc, int M, int N, int K, int transB, int causal,
          const int* rowidx = nullptr, const int* panel_e = nullptr, long long strideBe = 0, bool sync = true) {
    GemmF g; g.A = A; g.B = B; g.C = C; g.rowidx = rowidx; g.panel_e = panel_e; g.strideBe = strideBe; g.lda = lda; g.ldb = ldb; g.ldc = ldc; g.M = M; g.N = N; g.K = K;
    g.transB = transB; g.causal = causal; g.tilesN = (N + 127) / 128; g.pad0 = 0;
    run_nb(g, ((M + 127) / 128) * g.tilesN);
    if (sync) xcd_barrier(bar);
}
__device__ __forceinline__ void mgemm_f32(const bf16_t* A, const bf16_t* Bt, float* C, int ldc, int M, int N, int K) {
    pg8::Gemm g{A, Bt, M, N, K}; pg8::StaticOrder S; S.init(M, N, (int)gridDim.x, obid());
    pg8::EpiF32 E{C, ldc};
    pg8::gemm_phase<pg8::EpiF32, pg8::StaticOrder, true, true>((PG8_LAS unsigned char*)g_lds, g, S, E);
}

__device__ __forceinline__ void mgemm_b16(const bf16_t* A, const bf16_t* Bt, bf16_t* C, int ldc, int M, int N, int K) {
    pg8::Gemm g{A, Bt, M, N, K}; pg8::StaticOrder So; So.init(M, N, (int)gridDim.x, obid());
    pg8::EpiB16 E{C, ldc};
    pg8::gemm_phase<pg8::EpiB16, pg8::StaticOrder, true, true>((PG8_LAS unsigned char*)g_lds, g, So, E);
}
__device__ __forceinline__ void mgemm_qkv(const bf16_t* A, const bf16_t* Bt, bf16_t* q, const float* rope, unsigned* nrm2) {
    pg8::Gemm g{A, Bt, NTOK, 6144, D}; pg8::StaticOrder So; So.init(NTOK, 6144, (int)gridDim.x, obid());
    PG8_LAS float* rowsq = (PG8_LAS float*)(g_lds + 131072);
    pg8::EpiQKV E{q, nrm2, rowsq, rope};
    pg8::gemm_phase<pg8::EpiQKV, pg8::StaticOrder, true, true>((PG8_LAS unsigned char*)g_lds, g, So, E);
}

__device__ __forceinline__ void moe_weights(const float* gate, const float* up, const float* down, bf16_t* wgu, bf16_t* wdn) {
    const int tid = otid(), wave = __builtin_amdgcn_readfirstlane(tid >> 6), lane = tid & 63;
    constexpr int IPE = 256;
#define MW_DESC(it_) const int which = (it_) / (32 * IPE), r = (it_) - which * (32 * IPE), e = r / IPE, ii = r - e * IPE; TransF t; \
        if (which == 0) { t.W = gate + (size_t)e * D * 512; t.WT = wgu + (size_t)e * 1024 * D; t.K = D; t.ldw = 512; t.ncols = 512; t.ileave = 1; } \
        else if (which == 1) { t.W = up + (size_t)e * D * 512; t.WT = wgu + (size_t)e * 1024 * D; t.K = D; t.ldw = 512; t.ncols = 512; t.ileave = 2; } \
        else { t.W = down + (size_t)e * 512 * D; t.WT = wdn + (size_t)e * D * 512; t.K = 512; t.ldw = D; t.ncols = D; t.ileave = 0; }
    const int step = gridDim.x * 8, total = 3 * 32 * IPE, it0 = obid() * 8 + wave;
    const int nit = it0 < total ? (total - it0 + step - 1) / step : 0;
    if (nit > 0) {
        const int last = it0 + (nit - 1) * step;
        int it = it0, k = 0;
        float4 va[16], vb[16];
        { MW_DESC(it); t.load(ii, lane, va); }
        for (; k + 1 < nit; k += 2) {
            { MW_DESC(it + step); t.load(ii, lane, vb); }
            __builtin_amdgcn_sched_barrier(0);
            { MW_DESC(it); t.finish(ii, wave, lane, va); }
            __builtin_amdgcn_sched_barrier(0);
            { const int itn = it + 2 * step < last ? it + 2 * step : last; MW_DESC(itn); t.load(ii, lane, va); }
            __builtin_amdgcn_sched_barrier(0);
            { MW_DESC(it + step); t.finish(ii, wave, lane, vb); }
            it += 2 * step;
        }
        if (k < nit) { MW_DESC(it); t.finish(ii, wave, lane, va); }
    }
#undef MW_DESC
}
__device__ __forceinline__ void moe_gemm1(const bf16_t* Hs, const int* rowmap, const bf16_t* wgu, bf16_t* hid, const float* slot_w, const int* panel_e, const int* npan) {
    pg8::Gemm g{Hs, wgu, MAXSLOT, 1024, D}; pg8::MoeOrder So{panel_e, npan[0], 4, (int)gridDim.x, obid()};
    pg8::EpiSwiGLU E{hid, slot_w};
    pg8::gemm_phase_gather<pg8::EpiSwiGLU, pg8::MoeOrder>((PG8_LAS unsigned char*)g_lds, g, rowmap, So, E);
}
__device__ __forceinline__ void moe_gemm2(const bf16_t* hid, const bf16_t* wdn, bf16_t* y2, const int* slot_dst, const int* panel_e, const int* npan) {
    pg8::Gemm g{hid, wdn, MAXSLOT, D, 512}; pg8::MoeOrder So{panel_e, npan[0], 8, (int)gridDim.x, obid()};
    pg8::EpiScatter E{y2, slot_dst};
    pg8::gemm_phase<pg8::EpiScatter, pg8::MoeOrder, true, true>((PG8_LAS unsigned char*)g_lds, g, So, E);
}

template <int LAYER> __device__ __forceinline__ void attn_conv_phase(const AttnArgs& a, const float* gate, const float* up, const float* down, bf16_t* wgu, bf16_t* wdn) {
    constexpr int TOTAL = (LAYER == 0 ? 128 : 64) * 8;
    const int bid = obid(), G = gridDim.x, n = bid < TOTAL ? (TOTAL - bid + G - 1) / G : 0, cls = bid % 3, split = cls == 0 ? 0 : (cls == 1 ? n / 2 : n);
    FoxPair fp; fp.probA = fp.probB = fp.x = 0; fp.paired = false;
    if (LAYER == 1) fp = fox_pairing(a);
    attn_stream<LAYER>(a, fp, 0, split);
    __syncthreads();
    moe_weights(gate, up, down, wgu, wdn);
    __syncthreads();
    attn_stream<LAYER>(a, fp, split, n);
}

typedef const __attribute__((address_space(4))) Params* KParamsPtr;
__device__ __forceinline__ KParamsPtr kp() { KParamsPtr q = (KParamsPtr)__builtin_amdgcn_kernarg_segment_ptr(); asm volatile("" : "+s"(q)); return q; }
__global__ void __launch_bounds__(NTHR, 2) fwd_kernel(Params p_arg) {
#define p (*kp())
    for (int u = threadIdx.x; u < (LDS_BYTES - LDSCTL_OFF) / 4; u += NTHR) ((LAS unsigned*)(g_lds + LDSCTL_OFF))[u] = 0u;
    __syncthreads();
    const XcdBarrier bar = xcd_barrier_post(p.bar, (volatile LAS unsigned*)(g_lds + LDSCTL_OFF + 64));

    { ModF f; f.c = p.c; f.w0 = p.mix_mod_w; f.w1 = p.ffn_mod_w; f.modp = p.modp; run_nb(f, 768); }
    __syncthreads();
    { RopeTableF f; f.tab = p.ropet; run_nb(f, S * 64 / NTHR); }
    { SmallWF f; f.wg = p.moe_wg; f.wr = p.moe_wr; f.bwin = p.b_w_in; f.rhi = p.rhi; f.rlo = p.rlo; f.fhi = p.fhi; f.flo = p.flo; run_nb(f, (2 * 48 * D + 16 * D) / NTHR); }
    { LamF f; f.q1 = p.a_lq1; f.k1 = p.a_lk1; f.q2 = p.a_lq2; f.k2 = p.a_lk2; f.lam = p.lam; if (obid() == gridDim.x - 1) f(0); }
    { TransF t; t.W = p.a_w_in; t.WT = p.wt_in[0]; t.K = D; t.ldw = 6144; t.ncols = 6144; t.ileave = 3; t.run(); }
    { TransF t; t.W = p.b_w_in; t.WT = p.wt_in[1]; t.K = D; t.ldw = 6160; t.ncols = 6144; t.ileave = 0; t.run(); }
    { TransF t; t.W = p.a_w_out; t.WT = p.wt_out[0]; t.K = D; t.ldw = D; t.ncols = D; t.ileave = 0; t.run(); }
    { TransF t; t.W = p.b_w_out; t.WT = p.wt_out[1]; t.K = D; t.ldw = D; t.ncols = D; t.ileave = 0; t.run(); }
    xcd_barrier(bar);
    { ModRedF f; f.modp = p.modp; f.b0 = p.mix_mod_b; f.b1 = p.ffn_mod_b; f.out = p.modv; run_nb(f, 4 * NB * 3 * D / NTHR); }
    { Mod0F f; f.x = p.x; f.modp = p.modp; f.bias = p.mix_mod_b; f.hb = p.hb; f.run(); }
    xcd_barrier(bar);
    const float scale = 0.08838834764831845f;

    const float* xin = p.x;
#pragma unroll 1
    for (int layer = 0; layer < 2; ++layer) {
        const float* modm = p.modv + (size_t)(2 * layer) * NB * 3 * D; const float* modf = p.modv + (size_t)(2 * layer + 1) * NB * 3 * D;
        if (layer == 1) { CumBF f; f.flog = p.flog; f.fb = p.b_fb; f.bz = p.bz; run_nb(f, NB * 16); __syncthreads(); }
        mgemm_qkv(p.hb, p.wt_in[layer], p.qh, layer == 0 ? p.ropet : nullptr, layer == 1 ? p.nrm2 : nullptr);
        xcd_barrier(bar);
        AttnArgs aa; aa.q = p.qh; aa.k = p.kh; aa.v = p.vh; aa.o0 = layer == 0 ? p.o1 : p.ob; aa.o1 = p.o2; aa.bz = p.bz; aa.nrm2 = p.nrm2;
        if (layer == 0) {
            attn_conv_phase<0>(aa, p.moe_gate, p.moe_up, p.moe_down, p.wgu, p.wdn);
            xcd_barrier(bar);
            { CombineF f; f.o1 = p.o1; f.o2 = p.o2; f.lam = p.lam; f.w = p.a_subln; f.ob = p.ob; f.run(NTOK * 8 / 8 / 4); xcd_barrier(bar); }
        } else {
            attn_conv_phase<1>(aa, p.moe_gate + (size_t)32 * D * 512, p.moe_up + (size_t)32 * D * 512, p.moe_down + (size_t)32 * 512 * D, p.wgu1, p.wdn1);
            xcd_barrier(bar);
        }
        { InitF f; f.cnt = p.cnt; f.slot_token = p.slot_token; f.panel_e = p.panel_e; f.nrm2 = layer == 0 ? p.nrm2 : nullptr; run_nb(f, MAXSLOT / NTHR); }
        mgemm_b16(p.ob, p.wt_out[layer], p.yb16, D, NTOK, D, D);
        xcd_barrier(bar);
#define ROWF0_ARGS f.y = p.yb16; f.yb = nullptr; f.modg = modm; f.g = p.mix_ln_g + (size_t)layer * D; f.bta = p.mix_ln_b + (size_t)layer * D; f.out = nullptr; f.outb = p.xAb; \
          f.modn = modf; f.hb = p.hb; f.whi = p.rhi + (size_t)layer * 48 * D; f.wlo = p.rlo + (size_t)layer * 48 * D; \
          f.bg = p.moe_bg + layer * 4; f.br = p.moe_br + layer * 32; f.wgcnt = p.wgcnt; f.tok_e = p.tok_e; f.tok_pos = p.tok_pos; f.tok_w = p.tok_w; f.flog = nullptr
        if (layer == 0) { RowF<0, false> f; f.x = p.x; f.xb = nullptr; ROWF0_ARGS; f.run(NTOK / 16); }
        else { RowF<0, true> f; f.x = nullptr; f.xb = p.xBb; ROWF0_ARGS; f.run(NTOK / 16); }
#undef ROWF0_ARGS
        xcd_barrier(bar);
        { ScatF f; f.wgcnt = p.wgcnt; f.tok_e = p.tok_e; f.tok_pos = p.tok_pos; f.tok_w = p.tok_w; f.slot_token = p.slot_token; f.slot_w = p.slot_w; f.panel_e = p.panel_e; f.npan = p.npan;
          phase(f, (2 * NTOK + 32 * 256) / NTHR, bar); }
        moe_gemm1(p.hb, p.slot_token, layer == 0 ? p.wgu : p.wgu1, p.hid, p.slot_w, p.panel_e, p.npan);
        xcd_barrier(bar);
        moe_gemm2(p.hid, layer == 0 ? p.wdn : p.wdn1, p.y2b, p.slot_token, p.panel_e, p.npan);
        xcd_barrier(bar);
        if (layer == 0) {
            RowF<1, true> f; f.x = nullptr; f.xb = p.xAb; f.y = nullptr; f.yb = p.y2b; f.modg = modf; f.g = p.ffn_ln_g; f.bta = p.ffn_ln_b; f.out = nullptr; f.outb = p.xBb;
            f.modn = p.modv + (size_t)2 * NB * 3 * D; f.hb = p.hb; f.whi = p.fhi; f.wlo = p.flo;
            f.bg = nullptr; f.br = nullptr; f.wgcnt = nullptr; f.tok_e = nullptr; f.tok_pos = nullptr; f.tok_w = nullptr; f.flog = p.flog;
            f.run(NTOK / 16);
        } else {
            RowF<2, true> f; f.x = nullptr; f.xb = p.xAb; f.outb = nullptr; f.y = nullptr; f.yb = p.y2b; f.modg = modf; f.g = p.ffn_ln_g + (size_t)layer * D; f.bta = p.ffn_ln_b + (size_t)layer * D; f.out = p.out;
            f.modn = nullptr; f.hb = nullptr; f.whi = nullptr; f.wlo = nullptr; f.bg = nullptr; f.br = nullptr; f.wgcnt = nullptr; f.tok_e = nullptr; f.tok_pos = nullptr; f.tok_w = nullptr; f.flog = nullptr;
            f.run(NTOK / 16);
        }
        if (layer == 0) xcd_barrier(bar);
        xin = p.xB;
    }
#undef p
}
}

extern "C" void kernel_launch(void* const* d_in, const int* in_sizes, int n_in, void* d_out, int out_size, void* d_ws, size_t ws_size, hipStream_t stream) {
    (void)in_sizes; (void)out_size;
    if (n_in != 27) { fprintf(stderr, "kernel_launch: expected 27 inputs, got %d\n", n_in); return; }
    Params p; memset(&p, 0, sizeof(p));
    p.x = (const float*)d_in[0]; p.c = (const float*)d_in[1];
    p.mix_mod_w = (const float*)d_in[2]; p.mix_mod_b = (const float*)d_in[3]; p.mix_ln_g = (const float*)d_in[4]; p.mix_ln_b = (const float*)d_in[5];
    p.a_w_in = (const float*)d_in[6]; p.a_lq1 = (const float*)d_in[7]; p.a_lk1 = (const float*)d_in[8]; p.a_lq2 = (const float*)d_in[9]; p.a_lk2 = (const float*)d_in[10];
    p.a_subln = (const float*)d_in[11]; p.a_w_out = (const float*)d_in[12];
    p.b_w_in = (const float*)d_in[13]; p.b_fb = (const float*)d_in[14]; p.b_w_out = (const float*)d_in[15];
    p.ffn_mod_w = (const float*)d_in[16]; p.ffn_mod_b = (const float*)d_in[17]; p.ffn_ln_g = (const float*)d_in[18]; p.ffn_ln_b = (const float*)d_in[19];
    p.moe_wg = (const float*)d_in[20]; p.moe_bg = (const float*)d_in[21]; p.moe_wr = (const float*)d_in[22]; p.moe_br = (const float*)d_in[23];
    p.moe_gate = (const float*)d_in[24]; p.moe_up = (const float*)d_in[25]; p.moe_down = (const float*)d_in[26];
    p.out = (float*)d_out;

    size_t off = 0; float* ws = (float*)d_ws;
    auto take = [&](size_t n) { float* q = ws + off; off += (n + 63) & ~(size_t)63; return q; };
    p.bar = (unsigned*)take(XCD_BAR_WORDS);
    p.modv = take((size_t)4 * NB * 3 * D); p.modp = take((size_t)16 * 4 * NB * 3 * D);
    p.ropet = take((size_t)S * 64 * 2);
    p.lam = take(64);
    p.cum = take((size_t)16 * S); p.flog = take((size_t)NTOK * 16); p.bz = take((size_t)NB * 16 * S);
    p.cnt = (int*)take(64); p.wgcnt = (int*)take(256 * 32); p.nrm2 = (unsigned*)take(512);
    p.tok_e = (int*)take(2 * NTOK); p.tok_pos = (int*)take(2 * NTOK); p.tok_w = take(2 * NTOK); p.tok_slot = (int*)take(2 * NTOK);
    p.slot_token = (int*)take(MAXSLOT); p.slot_w = take(MAXSLOT); p.panel_e = (int*)take(256);
    p.wt_in[0] = (bf16_t*)take((size_t)6144 * D / 2); p.wt_in[1] = (bf16_t*)take((size_t)6144 * D / 2);
    p.wt_out[0] = (bf16_t*)take((size_t)D * D / 2); p.wt_out[1] = (bf16_t*)take((size_t)D * D / 2);
    p.hb = (bf16_t*)take((size_t)NTOK * D / 2); p.ob = (bf16_t*)take((size_t)NTOK * D / 2);
    p.xA = nullptr; p.xB = nullptr; p.xAb = (bf16_t*)take((size_t)NTOK * D / 2); p.xBb = (bf16_t*)take((size_t)NTOK * D / 2); p.yb16 = (bf16_t*)take((size_t)NTOK * D / 2);
    p.rhi = (bf16_t*)take((size_t)2 * 48 * D / 2); p.rlo = (bf16_t*)take((size_t)2 * 48 * D / 2); p.fhi = (bf16_t*)take((size_t)16 * D / 2); p.flo = (bf16_t*)take((size_t)16 * D / 2);
    p.wgu = (bf16_t*)take((size_t)32 * 1024 * D / 2); p.wdn = (bf16_t*)take((size_t)32 * D * 512 / 2);
    p.wgu1 = (bf16_t*)take((size_t)32 * 1024 * D / 2); p.wdn1 = (bf16_t*)take((size_t)32 * D * 512 / 2); p.npan = (int*)take(64);
    float* region = ws + off;
    p.qh = (bf16_t*)take((size_t)NTOK * D / 2); p.kh = (bf16_t*)take((size_t)NTOK * D / 2); p.vh = (bf16_t*)take((size_t)NTOK * D / 2);
    p.o1 = (bf16_t*)take((size_t)NTOK * D / 2); p.o2 = (bf16_t*)take((size_t)NTOK * D / 2);
    take((size_t)3 << 20);
    p.Hs = (bf16_t*)region; p.hid = p.Hs + (size_t)MAXSLOT * D; p.y2b = p.hid + (size_t)MAXSLOT * 512;
    if (off * sizeof(float) > ws_size) { fprintf(stderr, "kernel_launch: workspace too small (%zu > %zu)\n", off * sizeof(float), ws_size); return; }

    static int grid = 0;
    if (!grid) { int dev = 0, cus = 0; (void)hipGetDevice(&dev);
        if (hipDeviceGetAttribute(&cus, hipDeviceAttributeMultiprocessorCount, dev) != hipSuccess || cus <= 0) cus = 256;
        if (hipFuncSetAttribute((const void*)fwd_kernel, hipFuncAttributeMaxDynamicSharedMemorySize, LDS_BYTES) != hipSuccess) fprintf(stderr, "kernel_launch: hipFuncSetAttribute failed\n");
        grid = cus; }
    (void)hipMemsetAsync(p.bar, 0, XCD_BAR_WORDS * sizeof(unsigned), stream);
    hipLaunchKernelGGL(fwd_kernel, dim3(grid), dim3(NTHR), LDS_BYTES, stream, p);
}
```

```cpp
#include <hip/hip_runtime.h>
#include <cstdio>
#include <cstdint>
#include <cmath>
#include <cstring>

namespace pg8 {
#define PG8_LAS __attribute__((address_space(3)))
typedef unsigned short bf16_t;
typedef short bf16x8 __attribute__((ext_vector_type(8)));
typedef float f32x4 __attribute__((ext_vector_type(4)));
typedef unsigned u32x4 __attribute__((ext_vector_type(4)));
constexpr int BM = 256, BK = 64, HALF = 128, HTB = HALF * BK * 2  , STAGE_BYTES = 8 * HTB, NXCD = 8, WGM = 8;

__host__ __device__ __forceinline__ int lds_byte(int r, int c) { const int st = (r >> 4) * 2 + (c >> 5), rr = r & 15, cc = c & 31, ob = rr * 64 + cc * 2; return st * 1024 + (ob ^ (((ob >> 9) & 1) << 5)); }
__host__ __device__ __forceinline__ void stage_rc(int b, int& R, int& C) { const int st = b / 1024, sb = b % 1024, swz = sb ^ (((sb >> 9) & 1) << 5); R = (st >> 1) * 16 + swz / 64; C = (st & 1) * 32 + (swz % 64) / 2; }
__host__ __device__ __forceinline__ int perm32(int rho) { const int n = rho >> 4, i = rho & 15; return 8 * (i >> 2) + 4 * n + (i & 3); }

struct Unit { int pm, pn; };
struct Gemm { const bf16_t* A; const bf16_t* Bt; int M, N, K; };

struct StaticOrder {
    int nM, nN, nwg, G, c;
    __host__ __device__ void init(int M, int N, int G_, int c_) { nM = M / BM; nN = N / BM; nwg = nM * nN; G = G_; c = c_; }
    __host__ __device__ bool next(int i, Unit& u) const {
        const long L = (long)i * G + c; if (L >= nwg) return false;
        int wgid = (int)L; { const int q = nwg / NXCD, r = nwg % NXCD, xcd = wgid % NXCD, off = wgid / NXCD; wgid = (xcd < r ? xcd * (q + 1) : r * (q + 1) + (xcd - r) * q) + off; }
        const int nig = WGM * nN, gid = wgid / nig, fm = gid * WGM, gsz = (nM - fm) < WGM ? (nM - fm) : WGM;
        u.pm = fm + ((wgid % nig) % gsz); u.pn = (wgid % nig) / gsz; return true;
    }
    __device__ __forceinline__ void a_ready(const Unit&) const {}
    __device__ __forceinline__ void done(const Unit&) const {}
};

__device__ __forceinline__ unsigned cvt_pk_bf16(float lo, float hi) { unsigned r; asm volatile("v_cvt_pk_bf16_f32 %0, %1, %2" : "=v"(r) : "v"(lo), "v"(hi)); return r; }
typedef float f32x2 __attribute__((ext_vector_type(2)));

struct EpiF32 {
    static constexpr bool PERM = false, AFTER_DRAIN = false;
    float* C; int ldc;
    __device__ __forceinline__ void operator()(const f32x4 (&acc)[2][2][4][2], const Unit& u, int wr, int wc, int fr, int fq) const {
        const int col0 = u.pn * BM + wc * 32 + 4 * fq;
#pragma unroll
        for (int ai = 0; ai < 2; ++ai)
#pragma unroll
            for (int m = 0; m < 4; ++m) { float* rowp = C + (size_t)(u.pm * BM + ai * HALF + wr * 64 + m * 16 + fr) * ldc + col0;
#pragma unroll
                for (int bj = 0; bj < 2; ++bj)
#pragma unroll
                    for (int n = 0; n < 2; ++n) *(f32x4*)(rowp + bj * HALF + n * 16) = acc[ai][bj][m][n]; }
    }
};


struct EpiB16 {
    static constexpr bool PERM = true, AFTER_DRAIN = false;
    bf16_t* C; int ldc;
    __device__ __forceinline__ void operator()(const f32x4 (&acc)[2][2][4][2], const Unit& u, int wr, int wc, int fr, int fq) const {
        const int col0 = u.pn * BM + wc * 32 + 8 * fq;
#pragma unroll
        for (int ai = 0; ai < 2; ++ai)
#pragma unroll
            for (int m = 0; m < 4; ++m) { bf16_t* rowp = C + (size_t)(u.pm * BM + ai * HALF + wr * 64 + m * 16 + fr) * ldc + col0;
#pragma unroll
                for (int bj = 0; bj < 2; ++bj) { const f32x4 v0 = acc[ai][bj][m][0], v1 = acc[ai][bj][m][1];
                    u32x4 w; w.x = cvt_pk_bf16(v0[0], v0[1]); w.y = cvt_pk_bf16(v0[2], v0[3]); w.z = cvt_pk_bf16(v1[0], v1[1]); w.w = cvt_pk_bf16(v1[2], v1[3]);
                    *(u32x4*)(rowp + bj * HALF) = w; } }
    }
};

struct EpiQKV {
    static constexpr bool PERM = true, AFTER_DRAIN = false;
    bf16_t* qkv;
    unsigned* nrm2;
    PG8_LAS float* rowsq;
    const float* rope;
    __device__ __forceinline__ void operator()(const f32x4 (&acc)[2][2][4][2], const Unit& u, int wr, int wc, int fr, int fq) const {
        if (rope && u.pn < 16) {
            const int slot = 2 * u.pn + (wc >> 1), type = slot >> 4, head = slot & 15, i0 = (wc & 1) * 32 + 8 * fq;
            bf16_t* base = qkv + (size_t)type * ((size_t)16384 * 2048);
            f32x4 cn[4];
            { const int row0 = u.pm * BM + wr * 64 + fr, sq0 = row0 & 4095; const f32x4* cs0 = (const f32x4*)(rope + ((size_t)sq0 * 64 + i0) * 2);
#pragma unroll
              for (int q = 0; q < 4; ++q) cn[q] = cs0[q]; }
#pragma unroll
            for (int r = 0; r < 8; ++r) { const int ai = r >> 2, m = r & 3;
                const int row = u.pm * BM + ai * HALF + wr * 64 + m * 16 + fr, b = row >> 12, sq = row & 4095;
                const f32x4 c0 = cn[0], c1 = cn[1], c2 = cn[2], c3 = cn[3];
                if (r + 1 < 8) { const int rn = r + 1, rown = u.pm * BM + (rn >> 2) * HALF + wr * 64 + (rn & 3) * 16 + fr, sqn = rown & 4095; const f32x4* csn = (const f32x4*)(rope + ((size_t)sqn * 64 + i0) * 2);
#pragma unroll
                    for (int q = 0; q < 4; ++q) cn[q] = csn[q]; }
                __builtin_amdgcn_sched_barrier(0);
                float o1[8], o2[8];
#pragma unroll
                for (int n = 0; n < 2; ++n) { const f32x4 x1 = acc[ai][0][m][n], x2 = acc[ai][1][m][n], ca = n == 0 ? c0 : c2, cb = n == 0 ? c1 : c3;
                    o1[4 * n + 0] = x1[0] * ca[0] - x2[0] * ca[1]; o2[4 * n + 0] = x2[0] * ca[0] + x1[0] * ca[1];
                    o1[4 * n + 1] = x1[1] * ca[2] - x2[1] * ca[3]; o2[4 * n + 1] = x2[1] * ca[2] + x1[1] * ca[3];
                    o1[4 * n + 2] = x1[2] * cb[0] - x2[2] * cb[1]; o2[4 * n + 2] = x2[2] * cb[0] + x1[2] * cb[1];
                    o1[4 * n + 3] = x1[3] * cb[2] - x2[3] * cb[3]; o2[4 * n + 3] = x2[3] * cb[2] + x1[3] * cb[3]; }
                bf16_t* dst = base + ((size_t)(b * 16 + head) * 4096 + sq) * 128 + i0;
                u32x4 w; w.x = cvt_pk_bf16(o1[0], o1[1]); w.y = cvt_pk_bf16(o1[2], o1[3]); w.z = cvt_pk_bf16(o1[4], o1[5]); w.w = cvt_pk_bf16(o1[6], o1[7]);
                *(u32x4*)dst = w;
                w.x = cvt_pk_bf16(o2[0], o2[1]); w.y = cvt_pk_bf16(o2[2], o2[3]); w.z = cvt_pk_bf16(o2[4], o2[5]); w.w = cvt_pk_bf16(o2[6], o2[7]);
                *(u32x4*)(dst + 64) = w;
                __builtin_amdgcn_sched_barrier(0); }
            return;
        }
        const int d = wc * 32 + 8 * fq;
        if (nrm2 && u.pn < 16) {
#pragma unroll
            for (int bj = 0; bj < 2; ++bj)
#pragma unroll
                for (int ai = 0; ai < 2; ++ai)
#pragma unroll
                    for (int m = 0; m < 4; ++m) { const f32x4 v0 = acc[ai][bj][m][0], v1 = acc[ai][bj][m][1];
                        float sq = (v0[0] * v0[0] + v0[1] * v0[1]) + (v0[2] * v0[2] + v0[3] * v0[3]) + (v1[0] * v1[0] + v1[1] * v1[1]) + (v1[2] * v1[2] + v1[3] * v1[3]);
                        { const auto r = __builtin_amdgcn_permlane16_swap(__float_as_uint(sq), __float_as_uint(sq), false, false); sq = __uint_as_float(r[0]) + __uint_as_float(r[1]); }
                        { const auto r = __builtin_amdgcn_permlane32_swap(__float_as_uint(sq), __float_as_uint(sq), false, false); sq = __uint_as_float(r[0]) + __uint_as_float(r[1]); }
                        if (fq == 0) rowsq[(wc * 2 + bj) * 256 + ai * HALF + wr * 64 + m * 16 + fr] = sq; }
            asm volatile("s_waitcnt lgkmcnt(0)" ::: "memory"); __builtin_amdgcn_s_barrier();
            { const int t = (wr * 4 + wc) * 64 + fq * 16 + fr;
              float mx = (rowsq[t] + rowsq[512 + t]) + (rowsq[1024 + t] + rowsq[1536 + t]);
              mx = fmaxf(mx, __shfl_xor(mx, 1)); mx = fmaxf(mx, __shfl_xor(mx, 2)); mx = fmaxf(mx, __shfl_xor(mx, 4)); mx = fmaxf(mx, __shfl_xor(mx, 8)); mx = fmaxf(mx, __shfl_xor(mx, 16)); mx = fmaxf(mx, __shfl_xor(mx, 32));
              const int slot = 2 * u.pn + (wr), type = slot >> 4, head = slot & 15, b = (u.pm * BM) >> 12;
              if (fr == 0 && fq == 0) atomicMax(nrm2 + type * 64 + b * 16 + head, __float_as_uint(mx)); }
        }
#pragma unroll
        for (int bj = 0; bj < 2; ++bj) { const int slot = 2 * u.pn + bj, type = slot >> 4, head = slot & 15; bf16_t* base = qkv + (size_t)type * ((size_t)16384 * 2048);
#pragma unroll
            for (int ai = 0; ai < 2; ++ai)
#pragma unroll
                for (int m = 0; m < 4; ++m) { const int row = u.pm * BM + ai * HALF + wr * 64 + m * 16 + fr, b = row >> 12, sq = row & 4095;
                    const f32x4 v0 = acc[ai][bj][m][0], v1 = acc[ai][bj][m][1];
                    u32x4 w; w.x = cvt_pk_bf16(v0[0], v0[1]); w.y = cvt_pk_bf16(v0[2], v0[3]); w.z = cvt_pk_bf16(v1[0], v1[1]); w.w = cvt_pk_bf16(v1[2], v1[3]);
                    *(u32x4*)(base + ((size_t)(b * 16 + head) * 4096 + sq) * 128 + d) = w; } }
    }
};

struct EpiSwiGLU {
    static constexpr bool PERM = true, AFTER_DRAIN = false;
    bf16_t* hid; const float* slot_w;
    __device__ __forceinline__ void operator()(const f32x4 (&acc)[2][2][4][2], const Unit& u, int wr, int wc, int fr, int fq) const {
        const int col = (u.pn & 3) * 128 + wc * 32 + 8 * fq;
        float wv[2][4];
#pragma unroll
        for (int ai = 0; ai < 2; ++ai)
#pragma unroll
            for (int m = 0; m < 4; ++m) wv[ai][m] = slot_w[u.pm * BM + ai * HALF + wr * 64 + m * 16 + fr];
        __builtin_amdgcn_sched_barrier(0);
#pragma unroll
        for (int ai = 0; ai < 2; ++ai)
#pragma unroll
            for (int m = 0; m < 4; ++m) { const int row = u.pm * BM + ai * HALF + wr * 64 + m * 16 + fr; const float w = wv[ai][m];
                float o[8];
#pragma unroll
                for (int n = 0; n < 2; ++n)
#pragma unroll
                    for (int i = 0; i < 4; ++i) { const float g = acc[ai][0][m][n][i], up = acc[ai][1][m][n][i];
                        o[4 * n + i] = g * __builtin_amdgcn_rcpf(1.f + __expf(-g)) * up * w; }
                u32x4 q; q.x = cvt_pk_bf16(o[0], o[1]); q.y = cvt_pk_bf16(o[2], o[3]); q.z = cvt_pk_bf16(o[4], o[5]); q.w = cvt_pk_bf16(o[6], o[7]);
                *(u32x4*)(hid + (size_t)row * 512 + col) = q; }
    }
};
struct EpiScatter {
    static constexpr bool PERM = true, AFTER_DRAIN = false;
    bf16_t* y2; const int* slot_dst;
    __device__ __forceinline__ void operator()(const f32x4 (&acc)[2][2][4][2], const Unit& u, int wr, int wc, int fr, int fq) const {
        const int col = (u.pn & 7) * 256 + wc * 32 + 8 * fq;
        int dv[2][4];
#pragma unroll
        for (int ai = 0; ai < 2; ++ai)
#pragma unroll
            for (int m = 0; m < 4; ++m) dv[ai][m] = slot_dst[u.pm * BM + ai * HALF + wr * 64 + m * 16 + fr];
        __builtin_amdgcn_sched_barrier(0);
#pragma unroll
        for (int ai = 0; ai < 2; ++ai)
#pragma unroll
            for (int m = 0; m < 4; ++m) { const int dst = dv[ai][m];
                if (dst >= 0) {
#pragma unroll
                    for (int bj = 0; bj < 2; ++bj) { const f32x4 v0 = acc[ai][bj][m][0], v1 = acc[ai][bj][m][1];
                        u32x4 q; q.x = cvt_pk_bf16(v0[0], v0[1]); q.y = cvt_pk_bf16(v0[2], v0[3]); q.z = cvt_pk_bf16(v1[0], v1[1]); q.w = cvt_pk_bf16(v1[2], v1[3]);
                        *(u32x4*)(y2 + (size_t)dst * 2048 + col + bj * HALF) = q; } } }
    }
};
struct MoeOrder {
    const int* panel_e; int npan, NJ, G, c;
    __device__ __forceinline__ bool next(int i, Unit& u) const {
        int pm, j;
        if ((G & 7) == 0) { const int xc = c & 7, p0 = (xc * npan) >> 3, p1 = ((xc + 1) * npan) >> 3, idx = (c >> 3) + (G >> 3) * i; if (idx >= (p1 - p0) * NJ) return false; pm = p0 + idx / NJ; j = idx - (idx / NJ) * NJ; }
        else { const int L = i * G + c; if (L >= npan * NJ) return false; pm = L / NJ; j = L - pm * NJ; }
        u.pm = pm; u.pn = panel_e[pm] * NJ + j; return true; }
    __device__ __forceinline__ void a_ready(const Unit&) const {}
    __device__ __forceinline__ void done(const Unit&) const {}
};

template <class Epi, class Sched, bool ALIGN_EPI = false, bool SP2 = false>
__device__ __forceinline__ void gemm_phase(PG8_LAS unsigned char* lds, const Gemm g, const Sched& S, const Epi& E) {
    int tid_ = threadIdx.x; asm volatile("" : "+v"(tid_));
    const int tid = tid_, wid = __builtin_amdgcn_readfirstlane(tid >> 6), lane = tid & 63, wr = wid >> 2, wc = wid & 3, fr = lane & 15, fq = lane >> 4;
    const int K = g.K, nt = K / BK;
    unsigned voffA[2], voffB[2];
#pragma unroll
    for (int i = 0; i < 2; ++i) { int R, C; stage_rc(tid * 16 + i * 8192, R, C); const int Rb = Epi::PERM ? ((R & ~31) + perm32(R & 31)) : R;
        voffA[i] = (unsigned)(R * K + C) * 2u; voffB[i] = (unsigned)(Rb * K + C) * 2u; }
    const size_t kstep = (size_t)(BK * 2);
    const size_t hstep = (size_t)HALF * K * 2;
    const size_t tstep = 2 * hstep;
    const unsigned ldsw = (unsigned)wid * 1024u;
    const int aoff = lds_byte(wr * 64 + fr, fq * 8), boff = lds_byte(wc * 32 + fr, fq * 8);
#define PG8_SA(b, h) (((b) * 2 + (h)) * HTB)
#define PG8_SB(b, h) ((4 + (b) * 2 + (h)) * HTB)
#define PG8_STAGE(bufoff, gbase, voff) do { _Pragma("unroll") for (int _i = 0; _i < 2; ++_i) \
        __builtin_amdgcn_global_load_lds((const unsigned*)((const char*)(gbase) + (voff)[_i]), (PG8_LAS unsigned*)(lds + (bufoff) + ldsw + _i * 8192), 16, 0, 0); } while (0)
#define PG8_LDA(dst, b, h) do { _Pragma("unroll") for (int m = 0; m < 4; ++m) _Pragma("unroll") for (int k = 0; k < 2; ++k) dst[m][k] = *(const PG8_LAS bf16x8*)(lds + PG8_SA(b, h) + aoff + m * 2048 + k * 1024); } while (0)
#define PG8_LDB(dst, b, h) do { _Pragma("unroll") for (int n = 0; n < 2; ++n) _Pragma("unroll") for (int k = 0; k < 2; ++k) dst[n][k] = *(const PG8_LAS bf16x8*)(lds + PG8_SB(b, h) + boff + n * 2048 + k * 1024); } while (0)
#define PG8_MMA(ai, bj, At, Bt) do { __builtin_amdgcn_s_setprio(1); _Pragma("unroll") for (int m = 0; m < 4; ++m) _Pragma("unroll") for (int n = 0; n < 2; ++n) _Pragma("unroll") for (int k = 0; k < 2; ++k) \
        acc[ai][bj][m][n] = __builtin_amdgcn_mfma_f32_16x16x32_bf16(Bt[n][k], At[m][k], acc[ai][bj][m][n], 0, 0, 0); __builtin_amdgcn_s_setprio(0); } while (0)
#define PG8_WAIT_V(n) asm volatile("s_waitcnt vmcnt(" #n ")" ::: "memory")
#define PG8_WAIT_L(n) asm volatile("s_waitcnt lgkmcnt(" #n ")" ::: "memory")
#define PG8_BAR __builtin_amdgcn_s_barrier()
#define PG8_SCHED __builtin_amdgcn_sched_barrier(0)
    Unit cur, nxt; int ui = 0;
    if (!S.next(0, cur)) return;
    f32x4 acc[2][2][4][2];
#pragma unroll
    for (int a = 0; a < 2; ++a)
#pragma unroll
        for (int b = 0; b < 2; ++b)
#pragma unroll
            for (int m = 0; m < 4; ++m)
#pragma unroll
                for (int n = 0; n < 2; ++n) acc[a][b][m][n] = (f32x4){0.f, 0.f, 0.f, 0.f};
    bf16x8 At[4][2], B0[2][2], B1[2][2];
    const char* cA = (const char*)g.A + (size_t)cur.pm * tstep; const char* cB = (const char*)g.Bt + (size_t)cur.pn * tstep;
    S.a_ready(cur);
    if constexpr (SP2) {
        PG8_STAGE(PG8_SB(0, 0), cB, voffB); PG8_STAGE(PG8_SB(0, 1), cB + hstep, voffB); PG8_STAGE(PG8_SA(0, 0), cA, voffA); PG8_STAGE(PG8_SA(0, 1), cA + hstep, voffA);
        if (wr == 1) PG8_BAR;
        PG8_WAIT_V(2); PG8_BAR;
        PG8_STAGE(PG8_SB(1, 0), cB + kstep, voffB); PG8_STAGE(PG8_SA(1, 0), cA + kstep, voffA); PG8_STAGE(PG8_SB(1, 1), cB + hstep + kstep, voffB);
        PG8_WAIT_V(6); PG8_BAR;
    } else {
        PG8_STAGE(PG8_SB(0, 0), cB, voffB); PG8_STAGE(PG8_SA(0, 0), cA, voffA); PG8_STAGE(PG8_SB(0, 1), cB + hstep, voffB); PG8_STAGE(PG8_SA(0, 1), cA + hstep, voffA);
        if (wr == 1) PG8_BAR;
        PG8_WAIT_V(4); PG8_BAR;
        PG8_STAGE(PG8_SB(1, 0), cB + kstep, voffB); PG8_STAGE(PG8_SA(1, 0), cA + kstep, voffA); PG8_STAGE(PG8_SB(1, 1), cB + hstep + kstep, voffB);
        PG8_WAIT_V(6); PG8_BAR;
    }
    for (;;) {
        const bool has_next = S.next(ui + 1, nxt);
        const char* nA = has_next ? (const char*)g.A + (size_t)nxt.pm * tstep : cA; const char* nB = has_next ? (const char*)g.Bt + (size_t)nxt.pn * tstep : cB;
        for (int t = 0; t < nt; t += 2) {
            const bool last = (t == nt - 2);
            const char* a1 = cA + (size_t)(t + 1) * kstep;
            const char* a2 = last ? nA : cA + (size_t)(t + 2) * kstep; const char* b2 = last ? nB : cB + (size_t)(t + 2) * kstep;
            const char* a3 = a2 + kstep; const char* b3 = b2 + kstep;
            if (last && has_next) S.a_ready(nxt);
            if constexpr (SP2) {
            PG8_LDB(B0, 0, 0); PG8_LDB(B1, 0, 1); PG8_SCHED; PG8_LDA(At, 0, 0); PG8_STAGE(PG8_SA(1, 1), a1 + hstep, voffA);
            PG8_WAIT_V(8); PG8_WAIT_L(0); PG8_BAR; PG8_MMA(0, 0, At, B0); PG8_MMA(0, 1, At, B1); PG8_BAR; PG8_SCHED;
            PG8_LDA(At, 0, 1); PG8_STAGE(PG8_SB(0, 0), b2, voffB); PG8_STAGE(PG8_SB(0, 1), b2 + hstep, voffB); PG8_STAGE(PG8_SA(0, 0), a2, voffA);
            PG8_WAIT_V(8); PG8_WAIT_L(0); PG8_BAR; PG8_MMA(1, 0, At, B0); PG8_MMA(1, 1, At, B1); PG8_BAR; PG8_SCHED;
            PG8_LDB(B0, 1, 0); PG8_LDB(B1, 1, 1); PG8_SCHED; PG8_LDA(At, 1, 0); PG8_STAGE(PG8_SA(0, 1), a2 + hstep, voffA);
            PG8_WAIT_V(8); PG8_WAIT_L(0); PG8_BAR; PG8_MMA(0, 0, At, B0); PG8_MMA(0, 1, At, B1); PG8_BAR; PG8_SCHED;
            PG8_LDA(At, 1, 1); PG8_STAGE(PG8_SB(1, 0), b3, voffB); PG8_STAGE(PG8_SB(1, 1), b3 + hstep, voffB); PG8_STAGE(PG8_SA(1, 0), a3, voffA);
            PG8_WAIT_V(8); PG8_WAIT_L(0); PG8_BAR; PG8_MMA(1, 0, At, B0); PG8_MMA(1, 1, At, B1); PG8_BAR; PG8_SCHED;
            } else {
            PG8_LDB(B0, 0, 0); PG8_SCHED; PG8_LDA(At, 0, 0); PG8_STAGE(PG8_SA(1, 1), a1 + hstep, voffA);
            PG8_WAIT_L(8); PG8_BAR; PG8_WAIT_L(0); PG8_MMA(0, 0, At, B0); PG8_BAR; PG8_SCHED;
            PG8_LDB(B1, 0, 1); PG8_STAGE(PG8_SB(0, 0), b2, voffB);
            PG8_BAR; PG8_WAIT_L(0); PG8_MMA(0, 1, At, B1); PG8_BAR;
            PG8_LDA(At, 0, 1); PG8_STAGE(PG8_SA(0, 0), a2, voffA);
            PG8_BAR; PG8_WAIT_L(0); PG8_MMA(1, 0, At, B0); PG8_BAR; PG8_SCHED;
            PG8_STAGE(PG8_SB(0, 1), b2 + hstep, voffB);
            PG8_WAIT_V(6); PG8_BAR; PG8_MMA(1, 1, At, B1); PG8_BAR;
            PG8_LDB(B0, 1, 0); PG8_SCHED; PG8_LDA(At, 1, 0); PG8_STAGE(PG8_SA(0, 1), a2 + hstep, voffA);
            PG8_WAIT_L(8); PG8_BAR; PG8_WAIT_L(0); PG8_MMA(0, 0, At, B0); PG8_BAR; PG8_SCHED;
            PG8_LDB(B1, 1, 1); PG8_STAGE(PG8_SB(1, 0), b3, voffB);
            PG8_BAR; PG8_WAIT_L(0); PG8_MMA(0, 1, At, B1); PG8_BAR;
            PG8_LDA(At, 1, 1); PG8_STAGE(PG8_SA(1, 0), a3, voffA);
            PG8_BAR; PG8_WAIT_L(0); PG8_MMA(1, 0, At, B0); PG8_BAR; PG8_SCHED;
            PG8_STAGE(PG8_SB(1, 1), b3 + hstep, voffB);
            PG8_WAIT_V(6); PG8_BAR; PG8_MMA(1, 1, At, B1); PG8_BAR;
            }
        }
        if constexpr (ALIGN_EPI) { if (wr == 0) PG8_BAR; }
        if constexpr (!Epi::AFTER_DRAIN) { E(acc, cur, wr, wc, fr, fq); S.done(cur); }
        if (!has_next) break;
#pragma unroll
        for (int a = 0; a < 2; ++a)
#pragma unroll
            for (int b = 0; b < 2; ++b)
#pragma unroll
                for (int m = 0; m < 4; ++m)
#pragma unroll
                    for (int n = 0; n < 2; ++n) acc[a][b][m][n] = (f32x4){0.f, 0.f, 0.f, 0.f};
        cur = nxt; cA = nA; cB = nB; ++ui;
        if constexpr (ALIGN_EPI) { if (wr == 1) PG8_BAR; }
    }
    PG8_WAIT_V(0);
    if constexpr (!ALIGN_EPI) { if (wr == 0) PG8_BAR; }
    PG8_BAR;
    if constexpr (Epi::AFTER_DRAIN) { E.fused(acc, cur, wr, wc, fr, fq, lds, wid, lane); S.done(cur); }
#undef PG8_SA
#undef PG8_SB
#undef PG8_STAGE
#undef PG8_LDA
#undef PG8_LDB
#undef PG8_MMA
#undef PG8_WAIT_V
#undef PG8_WAIT_L
#undef PG8_BAR
#undef PG8_SCHED
}
template <class Epi, class Sched>
__device__ __forceinline__ void gemm_phase_gather(PG8_LAS unsigned char* lds, const Gemm g, const int* rowmap, const Sched& S, const Epi& E) {
    constexpr bool ALIGN_EPI = true, SP2 = true;
    int tid_ = threadIdx.x; asm volatile("" : "+v"(tid_));
    const int tid = tid_, wid = __builtin_amdgcn_readfirstlane(tid >> 6), lane = tid & 63, wr = wid >> 2, wc = wid & 3, fr = lane & 15, fq = lane >> 4;
    const int K = g.K, nt = K / BK;
    unsigned voffA[2], voffB[2]; int rowA[2];
#pragma unroll
    for (int i = 0; i < 2; ++i) { int R, C; stage_rc(tid * 16 + i * 8192, R, C); const int Rb = Epi::PERM ? ((R & ~31) + perm32(R & 31)) : R;
        voffA[i] = (unsigned)C * 2u; voffB[i] = (unsigned)(Rb * K + C) * 2u; rowA[i] = R; }
    const size_t kstep = (size_t)(BK * 2);
    const size_t hstep = (size_t)HALF * K * 2;
    const size_t tstep = 2 * hstep;
    const unsigned ldsw = (unsigned)wid * 1024u;
    const int aoff = lds_byte(wr * 64 + fr, fq * 8), boff = lds_byte(wc * 32 + fr, fq * 8);
#define PG8_SA(b, h) (((b) * 2 + (h)) * HTB)
#define PG8_SB(b, h) ((4 + (b) * 2 + (h)) * HTB)
#define PG8_STAGE(bufoff, gbase, voff) do { _Pragma("unroll") for (int _i = 0; _i < 2; ++_i) \
        __builtin_amdgcn_global_load_lds((const unsigned*)((const char*)(gbase) + (voff)[_i]), (PG8_LAS unsigned*)(lds + (bufoff) + ldsw + _i * 8192), 16, 0, 0); } while (0)
#define PG8_LDA(dst, b, h) do { _Pragma("unroll") for (int m = 0; m < 4; ++m) _Pragma("unroll") for (int k = 0; k < 2; ++k) dst[m][k] = *(const PG8_LAS bf16x8*)(lds + PG8_SA(b, h) + aoff + m * 2048 + k * 1024); } while (0)
#define PG8_LDB(dst, b, h) do { _Pragma("unroll") for (int n = 0; n < 2; ++n) _Pragma("unroll") for (int k = 0; k < 2; ++k) dst[n][k] = *(const PG8_LAS bf16x8*)(lds + PG8_SB(b, h) + boff + n * 2048 + k * 1024); } while (0)
#define PG8_MMA(ai, bj, At, Bt) do { __builtin_amdgcn_s_setprio(1); _Pragma("unroll") for (int m = 0; m < 4; ++m) _Pragma("unroll") for (int n = 0; n < 2; ++n) _Pragma("unroll") for (int k = 0; k < 2; ++k) \
        acc[ai][bj][m][n] = __builtin_amdgcn_mfma_f32_16x16x32_bf16(Bt[n][k], At[m][k], acc[ai][bj][m][n], 0, 0, 0); __builtin_amdgcn_s_setprio(0); } while (0)
#define PG8_WAIT_V(n) asm volatile("s_waitcnt vmcnt(" #n ")" ::: "memory")
#define PG8_WAIT_L(n) asm volatile("s_waitcnt lgkmcnt(" #n ")" ::: "memory")
#define PG8_BAR __builtin_amdgcn_s_barrier()
#define PG8_SCHED __builtin_amdgcn_sched_barrier(0)
    Unit cur, nxt; int ui = 0;
    if (!S.next(0, cur)) return;
    unsigned cA0[2], cA1[2], nA0[2], nA1[2];
#define PG8_ROWS(pm_, o0, o1) do { _Pragma("unroll") for (int _i = 0; _i < 2; ++_i) { const int s0_ = rowmap[(pm_) * BM + rowA[_i]], s1_ = rowmap[(pm_) * BM + HALF + rowA[_i]]; \
        o0[_i] = (unsigned)((s0_ < 0 ? 0 : (s0_ >> 1)) * K) * 2u + voffA[_i]; o1[_i] = (unsigned)((s1_ < 0 ? 0 : (s1_ >> 1)) * K) * 2u + voffA[_i]; } } while (0)
    PG8_ROWS(cur.pm, cA0, cA1);
    f32x4 acc[2][2][4][2];
#pragma unroll
    for (int a = 0; a < 2; ++a)
#pragma unroll
        for (int b = 0; b < 2; ++b)
#pragma unroll
            for (int m = 0; m < 4; ++m)
#pragma unroll
                for (int n = 0; n < 2; ++n) acc[a][b][m][n] = (f32x4){0.f, 0.f, 0.f, 0.f};
    bf16x8 At[4][2], B0[2][2], B1[2][2];
    const char* const Ab = (const char*)g.A; const char* cB = (const char*)g.Bt + (size_t)cur.pn * tstep;
    S.a_ready(cur);
    if constexpr (SP2) {
        PG8_STAGE(PG8_SB(0, 0), cB, voffB); PG8_STAGE(PG8_SB(0, 1), cB + hstep, voffB); PG8_STAGE(PG8_SA(0, 0), Ab, cA0); PG8_STAGE(PG8_SA(0, 1), Ab, cA1);
        if (wr == 1) PG8_BAR;
        PG8_WAIT_V(2); PG8_BAR;
        PG8_STAGE(PG8_SB(1, 0), cB + kstep, voffB); PG8_STAGE(PG8_SA(1, 0), Ab + kstep, cA0); PG8_STAGE(PG8_SB(1, 1), cB + hstep + kstep, voffB);
        PG8_WAIT_V(6); PG8_BAR;
    } else {
        static_assert(SP2, "gather variant: SP2 schedule only");
    }
    for (;;) {
        const bool has_next = S.next(ui + 1, nxt);
        const char* nB = has_next ? (const char*)g.Bt + (size_t)nxt.pn * tstep : cB;
        if (has_next) PG8_ROWS(nxt.pm, nA0, nA1); else { nA0[0] = cA0[0]; nA0[1] = cA0[1]; nA1[0] = cA1[0]; nA1[1] = cA1[1]; }
        for (int t = 0; t < nt; t += 2) {
            const bool last = (t == nt - 2);
            const char* a1 = Ab + (size_t)(t + 1) * kstep;
            const char* a2 = last ? Ab : Ab + (size_t)(t + 2) * kstep; const char* b2 = last ? nB : cB + (size_t)(t + 2) * kstep;
            const char* a3 = a2 + kstep; const char* b3 = b2 + kstep;
            unsigned x0[2], x1[2];
            x0[0] = last ? nA0[0] : cA0[0]; x0[1] = last ? nA0[1] : cA0[1]; x1[0] = last ? nA1[0] : cA1[0]; x1[1] = last ? nA1[1] : cA1[1];
            if (last && has_next) S.a_ready(nxt);
            if constexpr (SP2) {
            PG8_LDB(B0, 0, 0); PG8_LDB(B1, 0, 1); PG8_SCHED; PG8_LDA(At, 0, 0); PG8_STAGE(PG8_SA(1, 1), a1, cA1);
            PG8_WAIT_V(8); PG8_WAIT_L(0); PG8_BAR; PG8_MMA(0, 0, At, B0); PG8_MMA(0, 1, At, B1); PG8_BAR; PG8_SCHED;
            PG8_LDA(At, 0, 1); PG8_STAGE(PG8_SB(0, 0), b2, voffB); PG8_STAGE(PG8_SB(0, 1), b2 + hstep, voffB); PG8_STAGE(PG8_SA(0, 0), a2, x0);
            PG8_WAIT_V(8); PG8_WAIT_L(0); PG8_BAR; PG8_MMA(1, 0, At, B0); PG8_MMA(1, 1, At, B1); PG8_BAR; PG8_SCHED;
            PG8_LDB(B0, 1, 0); PG8_LDB(B1, 1, 1); PG8_SCHED; PG8_LDA(At, 1, 0); PG8_STAGE(PG8_SA(0, 1), a2, x1);
            PG8_WAIT_V(8); PG8_WAIT_L(0); PG8_BAR; PG8_MMA(0, 0, At, B0); PG8_MMA(0, 1, At, B1); PG8_BAR; PG8_SCHED;
            PG8_LDA(At, 1, 1); PG8_STAGE(PG8_SB(1, 0), b3, voffB); PG8_STAGE(PG8_SB(1, 1), b3 + hstep, voffB); PG8_STAGE(PG8_SA(1, 0), a3, x0);
            PG8_WAIT_V(8); PG8_WAIT_L(0); PG8_BAR; PG8_MMA(1, 0, At, B0); PG8_MMA(1, 1, At, B1); PG8_BAR; PG8_SCHED;
            }
        }
        if constexpr (ALIGN_EPI) { if (wr == 0) PG8_BAR; }
        if constexpr (!Epi::AFTER_DRAIN) { E(acc, cur, wr, wc, fr, fq); S.done(cur); }
        if (!has_next) break;
#pragma unroll
        for (int a = 0; a < 2; ++a)
#pragma unroll
            for (int b = 0; b < 2; ++b)
#pragma unroll
                for (int m = 0; m < 4; ++m)
#pragma unroll
                    for (int n = 0; n < 2; ++n) acc[a][b][m][n] = (f32x4){0.f, 0.f, 0.f, 0.f};
        cur = nxt; cB = nB; ++ui; cA0[0] = nA0[0]; cA0[1] = nA0[1]; cA1[0] = nA1[0]; cA1[1] = nA1[1];
        if constexpr (ALIGN_EPI) { if (wr == 1) PG8_BAR; }
    }
    PG8_WAIT_V(0);
    if constexpr (!ALIGN_EPI) { if (wr == 0) PG8_BAR; }
    PG8_BAR;
    if constexpr (Epi::AFTER_DRAIN) { E.fused(acc, cur, wr, wc, fr, fq, lds, wid, lane); S.done(cur); }
#undef PG8_SA
#undef PG8_SB
#undef PG8_STAGE
#undef PG8_LDA
#undef PG8_LDB
#undef PG8_MMA
#undef PG8_WAIT_V
#undef PG8_WAIT_L
#undef PG8_BAR
#undef PG8_SCHED
#undef PG8_ROWS
}
}

#include <hip/hip_bf16.h>
namespace swa {
constexpr int D = 128; constexpr float THR = 8.f; constexpr bool WSKIP = false;
constexpr float SCALE = 0.08838834764831845f;
constexpr int NW = 8, QBLK = 32, KVBLK = 64, QB = NW * QBLK;
constexpr int SHM_V = KVBLK * D * 2, SHM_K = KVBLK * D * 2;
constexpr int SWA_LDS_BYTES = 2 * SHM_V + 2 * SHM_K + NW * 64 * 4;
constexpr int BZ_OFF = 69632;

using bf16 = __hip_bfloat16;
typedef short bf16x8 __attribute__((ext_vector_type(8)));
typedef short s16x4 __attribute__((ext_vector_type(4)));
typedef float f32x16 __attribute__((ext_vector_type(16)));
typedef float f32x4 __attribute__((ext_vector_type(4)));
typedef unsigned u32x4 __attribute__((ext_vector_type(4)));
template <class A, class Bt> struct same_t { static constexpr bool v = false; };
template <class A> struct same_t<A, A> { static constexpr bool v = true; };

#define KSWZ(row, colB) ((row) * 256 + ((colB) ^ (((row) & 7) << 4)))
#define SBAR() __builtin_amdgcn_sched_barrier(0)
__device__ __forceinline__ int v_st(int k, int c) { const int kk = (k & ~0xC) | ((k & 4) << 1) | ((k & 8) >> 1); return ((kk >> 3) * 4 + (c >> 5)) * 512 + ((kk & 7) * 32 + (c & 31)) * 2; }
__device__ __forceinline__ int v_rd_base(int lane) { return ((lane & 3) << 3) | (((lane >> 2) & 3) << 6) | (((lane >> 4) & 1) << 5) | (((lane >> 5) & 1) << 8); }
constexpr int v_rd_off(int d0, int ks, int half) { return d0 * 512 + ks * 4096 + half * 2048; }
__device__ __forceinline__ int crow(int r, int hi) { return (r & 3) + 8 * (r >> 2) + 4 * hi; }
__device__ __forceinline__ unsigned cvtpk(float lo, float hi) {
    unsigned r; asm volatile("v_cvt_pk_bf16_f32 %0, %1, %2" : "=v"(r) : "v"(lo), "v"(hi)); return r;
}
__device__ __forceinline__ bf16x8 pack8(f32x4 a, f32x4 b) {
    u32x4 w = {cvtpk(a[0], a[1]), cvtpk(a[2], a[3]), cvtpk(b[0], b[1]), cvtpk(b[2], b[3])};
    return *reinterpret_cast<bf16x8*>(&w);
}
template <class T> __device__ __forceinline__ bf16x8 load8(const T* p) {
    if constexpr (same_t<T, float>::v) { return pack8(*(const f32x4*)p, *(const f32x4*)(p + 4)); }
    else { return *reinterpret_cast<const bf16x8*>(p); }
}
__device__ __forceinline__ void mask_tile(f32x16& p0, f32x16& p1, int dq, unsigned W) {
    const float NEG = -__builtin_inff();
#pragma unroll
    for (int r = 0; r < 16; ++r) {
        const int c = (r & 3) + 8 * (r >> 2);
        if ((unsigned)(dq - c) >= W) p0[r] = NEG;
        if ((unsigned)(dq - c - 32) >= W) p1[r] = NEG;
    }
}
__device__ __forceinline__ void partialSM(f32x16& p0, f32x16& p1, float& m_reg, float& mn, float& alpha) {
    float pmax = p0[0]; for (int r = 1; r < 16; ++r) pmax = fmaxf(pmax, p0[r]); for (int r = 0; r < 16; ++r) pmax = fmaxf(pmax, p1[r]);
    { auto rr = __builtin_amdgcn_permlane32_swap(__float_as_uint(pmax), __float_as_uint(pmax), false, false);
      pmax = fmaxf(__uint_as_float(rr[0]), __uint_as_float(rr[1])); }
    constexpr float C2 = 1.4426950408889634f * SCALE;
    if (__builtin_expect(__all((pmax - m_reg) * SCALE <= THR), 1)) { mn = m_reg; alpha = 1.f; }
    else { mn = fmaxf(m_reg, pmax); alpha = __builtin_amdgcn_exp2f((m_reg - mn) * C2); m_reg = mn; }
    const float mnL = -mn * C2;
    for (int r = 0; r < 16; ++r) p0[r] = fmaf(p0[r], C2, mnL); for (int r = 0; r < 16; ++r) p1[r] = fmaf(p1[r], C2, mnL);
    for (int r = 0; r < 16; ++r) p0[r] = __builtin_amdgcn_exp2f(p0[r]);
}
__device__ __forceinline__ void finishSM(f32x16& p0, f32x16& p1, float alpha, float& l_reg, bf16x8& pa0, bf16x8& pa1, bf16x8& pa2, bf16x8& pa3) {
    for (int r = 0; r < 16; ++r) p1[r] = __builtin_amdgcn_exp2f(p1[r]);
    float ps = 0; for (int r = 0; r < 16; ++r) ps += p0[r]; for (int r = 0; r < 16; ++r) ps += p1[r];
    { auto rr = __builtin_amdgcn_permlane32_swap(__float_as_uint(ps), __float_as_uint(ps), false, false);
      ps = __uint_as_float(rr[0]) + __uint_as_float(rr[1]); }
    l_reg = l_reg * alpha + ps;
#define PK4(P, B_, OUT) do { unsigned a0 = cvtpk(P[B_+0], P[B_+1]), a1 = cvtpk(P[B_+2], P[B_+3]);                          \
        unsigned b0 = cvtpk(P[B_+4], P[B_+5]), b1 = cvtpk(P[B_+6], P[B_+7]);                                             \
        auto r0 = __builtin_amdgcn_permlane32_swap(a0, b0, false, false); auto r1 = __builtin_amdgcn_permlane32_swap(a1, b1, false, false); \
        u32x4 w = {r0[0], r1[0], r0[1], r1[1]}; OUT = *reinterpret_cast<bf16x8*>(&w); } while (0)
    PK4(p0, 0, pa0); PK4(p0, 8, pa1); PK4(p1, 0, pa2); PK4(p1, 8, pa3);
#undef PK4
}
template <int KB, bool SK, bool BIAS>
__device__ __forceinline__ void qkt(f32x16& p0, f32x16& p1, const char* K_lds, int r32, int hi, const bf16x8* qr, bool act, const float* bz) {
    if (SK && !act) { const float NEG = -__builtin_inff();
#pragma unroll
        for (int r = 0; r < 16; ++r) { p0[r] = NEG; p1[r] = NEG; } return; }
    if constexpr (BIAS) {
#pragma unroll
        for (int g = 0; g < 4; ++g) { const f32x4 b0 = *(const f32x4*)(bz + 8 * g + 4 * hi), b1 = *(const f32x4*)(bz + 32 + 8 * g + 4 * hi);
#pragma unroll
            for (int i = 0; i < 4; ++i) { p0[4 * g + i] = b0[i]; p1[4 * g + i] = b1[i]; } }
    } else { p0 = f32x16{}; p1 = f32x16{}; }
    const char* kb[4];
#pragma unroll
    for (int dd = 0; dd < 4; ++dd) kb[dd] = K_lds + KB * SHM_K + KSWZ(r32, (dd * 16 + hi * 8) * 2);
#pragma unroll
    for (int d0 = 0; d0 < 8; ++d0) { const char* a = kb[d0 & 3] + (d0 >> 2) * 128;
        bf16x8 b0 = *reinterpret_cast<const bf16x8*>(a);
        bf16x8 b1 = *reinterpret_cast<const bf16x8*>(a + 32 * 256);
        p0 = __builtin_amdgcn_mfma_f32_32x32x16_bf16(b0, qr[d0], p0, 0, 0, 0);
        p1 = __builtin_amdgcn_mfma_f32_32x32x16_bf16(b1, qr[d0], p1, 0, 0, 0); }
}
template <int VB, bool SK>
__device__ __forceinline__ void pv_tile(f32x16* o, int vb0, bf16x8 pa0, bf16x8 pa1, bf16x8 pa2, bf16x8 pa3, bool act) {
    if (SK && !act) return;
#define TRRD(dst, off) asm volatile("ds_read_b64_tr_b16 %0, %1 offset:%2" : "=&v"(dst) : "v"(vb0), "i"(off) : "memory")
#define PV_D0(d0) do { s16x4 l0, l1, l2, l3, h0, h1, h2, h3; constexpr int b_ = VB * SHM_V + v_rd_off(d0, 0, 0);     \
        TRRD(l0, b_); TRRD(h0, b_ + 2048); TRRD(l1, b_ + 4096); TRRD(h1, b_ + 6144); TRRD(l2, b_ + 8192); TRRD(h2, b_ + 10240); TRRD(l3, b_ + 12288); TRRD(h3, b_ + 14336); \
        asm volatile("s_waitcnt lgkmcnt(0)" ::: "memory"); SBAR();                 \
        o[d0] = __builtin_amdgcn_mfma_f32_32x32x16_bf16(pa0, (bf16x8){l0[0], l0[1], l0[2], l0[3], h0[0], h0[1], h0[2], h0[3]}, o[d0], 0, 0, 0);   \
        o[d0] = __builtin_amdgcn_mfma_f32_32x32x16_bf16(pa1, (bf16x8){l1[0], l1[1], l1[2], l1[3], h1[0], h1[1], h1[2], h1[3]}, o[d0], 0, 0, 0);   \
        o[d0] = __builtin_amdgcn_mfma_f32_32x32x16_bf16(pa2, (bf16x8){l2[0], l2[1], l2[2], l2[3], h2[0], h2[1], h2[2], h2[3]}, o[d0], 0, 0, 0);   \
        o[d0] = __builtin_amdgcn_mfma_f32_32x32x16_bf16(pa3, (bf16x8){l3[0], l3[1], l3[2], l3[3], h3[0], h3[1], h3[2], h3[3]}, o[d0], 0, 0, 0); } while (0)
    PV_D0(0); PV_D0(1); PV_D0(2); PV_D0(3);
#undef PV_D0
#undef TRRD
}

template <class TIn, class TOut> struct BlockRef { const TIn* Q; const TIn* K; const TIn* V; TOut* O; const float* Bz; int P0; int JLO; };
template <class TIn> struct Seam {
    bf16x8 qr[8];
    bf16x8 st_v0, st_v1, st_k0, st_k1; f32x4 sf0, sf1, sf2, sf3;
    f32x4 tq[16];
};
__device__ __forceinline__ int swa_jlo(int P0, int W) { const int lowk = P0 - W + 1; return lowk > 0 ? lowk / KVBLK : 0; }
__device__ __forceinline__ int swa_jlo2(int P0, int W, int jlo) { const int j = swa_jlo(P0, W); return j > jlo ? j : jlo; }
#define ROW(p, k0, rr) ((p) + (size_t)((k0) + (rr)) * D + sc)
#define VMW() asm volatile("s_waitcnt vmcnt(0)" ::: "memory")
#define VMWN(n) asm volatile("s_waitcnt vmcnt(%0)" :: "i"(n) : "memory")
#define SLOAD_H(Kp, Vp, k0) do { S.st_v0 = load8<TIn>(ROW(Vp, k0, sr)); S.st_v1 = load8<TIn>(ROW(Vp, k0, 32 + sr));              \
                         S.st_k0 = load8<TIn>(ROW(Kp, k0, sr)); S.st_k1 = load8<TIn>(ROW(Kp, k0, 32 + sr)); } while (0)
#define SWRITE_HK(bf) do { *(bf16x8*)(K_lds + (bf) * SHM_K + kws) = S.st_k0; *(bf16x8*)(K_lds + (bf) * SHM_K + kws + 32 * 256) = S.st_k1; } while (0)
#define SWRITE_HV(bf) do { *(bf16x8*)(V_lds + (bf) * SHM_V + vst0) = S.st_v0; *(bf16x8*)(V_lds + (bf) * SHM_V + vst1) = S.st_v1; } while (0)
#define SWRITE_H(bf) do { SWRITE_HV(bf); SWRITE_HK(bf); } while (0)
#define SLOAD_F(p, k0) do { S.sf0 = *(const f32x4*)ROW(p, k0, sr); S.sf1 = *(const f32x4*)(ROW(p, k0, sr) + 4);                \
                            S.sf2 = *(const f32x4*)ROW(p, k0, 32 + sr); S.sf3 = *(const f32x4*)(ROW(p, k0, 32 + sr) + 4); } while (0)
#define SWRITE_KF(bf) do { *(bf16x8*)(K_lds + (bf) * SHM_K + kws) = pack8(S.sf0, S.sf1); *(bf16x8*)(K_lds + (bf) * SHM_K + kws + 32 * 256) = pack8(S.sf2, S.sf3); } while (0)
#define SWRITE_VF(bf) do { *(bf16x8*)(V_lds + (bf) * SHM_V + vst0) = pack8(S.sf0, S.sf1); *(bf16x8*)(V_lds + (bf) * SHM_V + vst1) = pack8(S.sf2, S.sf3); } while (0)
template <class TIn, class TOut>
__device__ __forceinline__ void causal_swa_prime(const BlockRef<TIn, TOut>& cur, int W, char* lds, Seam<TIn>& S) {
    constexpr bool F32 = same_t<TIn, float>::v;
    int tid_ = threadIdx.x; asm volatile("" : "+v"(tid_)); const int tid = tid_, wid = __builtin_amdgcn_readfirstlane(tid >> 6), lane = tid & 63, r32 = lane & 31, hi = lane >> 5;
    const int sr = tid >> 4, sc = (tid & 15) * 8, kws = KSWZ(sr, sc * 2); char* K_lds = lds + 2 * SHM_V;
    const int kb0 = swa_jlo2(cur.P0, W, cur.JLO) * KVBLK;
    for (int d0 = 0; d0 < 8; ++d0) S.qr[d0] = load8<TIn>(cur.Q + (size_t)(wid * QBLK + r32) * D + d0 * 16 + hi * 8);
    if constexpr (F32) { SLOAD_F((const float*)cur.K, kb0); VMW(); SWRITE_KF(0); SBAR(); SLOAD_F((const float*)cur.V, kb0); }
    else { SLOAD_H(cur.K, cur.V, kb0); VMW(); SWRITE_HK(0); }
    __syncthreads();
}
template <class TIn, class TOut, int OLD, bool BIAS>
__device__ __forceinline__ void causal_swa_block(const BlockRef<TIn, TOut>& cur, const BlockRef<TIn, TOut>& nxt, int skv, int W, char* lds, Seam<TIn>& S) {
    constexpr bool F32 = same_t<TIn, float>::v;
    int tid_ = threadIdx.x; asm volatile("" : "+v"(tid_)); const int tid = tid_, wid = __builtin_amdgcn_readfirstlane(tid >> 6), lane = tid & 63, r32 = lane & 31, hi = lane >> 5;
    const int j_lo = swa_jlo2(cur.P0, W, cur.JLO);
    int j_hi = (cur.P0 + QB - 1) / KVBLK + 1; if (j_hi > skv / KVBLK) j_hi = skv / KVBLK;
    const int NT = j_hi - j_lo;
    const float* bzl = (const float*)(lds + BZ_OFF);
    if constexpr (BIAS) {
        float* bzw = (float*)(lds + BZ_OFF); const int nk = j_hi * KVBLK;
        for (int i = j_lo * KVBLK + tid * 4; i < nk; i += 64 * NW * 4) *(f32x4*)(bzw + i) = *(const f32x4*)(cur.Bz + i);
        __syncthreads();
    }
#define BZP(t) (bzl + KBASE(t))
    const int kbn = swa_jlo2(nxt.P0, W, nxt.JLO) * KVBLK;
    const int qlo = cur.P0 + wid * QBLK, qm = qlo + r32 - 4 * hi;
    char* V_lds = lds; char* K_lds = lds + 2 * SHM_V;
    float* ws = (float*)(lds + 2 * SHM_V + 2 * SHM_K) + wid * 64; float* li_l = ws, * al_l = ws + 32;
    float m_reg = -1e30f, l_reg = 0; f32x16 o[4] = {};
    const int sr = tid >> 4, sc = (tid & 15) * 8, vst0 = v_st(sr, sc), vst1 = v_st(32 + sr, sc), kws = KSWZ(sr, sc * 2);
    const int vb0 = (int)(uintptr_t)V_lds + v_rd_base(lane);
    const TIn* Kh = cur.K; const TIn* Vh = cur.V;
#define RESC(a) do { if (__any((a) < 1.f)) { if (hi == 0) al_l[r32] = (a); asm volatile("s_waitcnt lgkmcnt(0)" ::: "memory");              \
                     for (int d_ = 0; d_ < 4; ++d_) for (int r = 0; r < 16; ++r) o[d_][r] *= al_l[crow(r, hi)]; } } while (0)
#define KBASE(t) ((j_lo + (t)) * KVBLK)
#define ACT(t) (KBASE(t) <= qlo + QBLK - 1 && KBASE(t) + KVBLK - 1 >= qlo - W + 1)
#define MASKT(P0_, P1_, t) do { const int kb_ = KBASE(t); if ((!SK || ACT(t)) && (kb_ + KVBLK - 1 > qlo || kb_ <= qlo + QBLK - 1 - W)) mask_tile(P0_, P1_, qm - kb_, (unsigned)W); } while (0)
    constexpr int NQL = F32 ? 16 : 8;
    constexpr bool SK = WSKIP && !F32;
#define SEAM_K0() do { VMWN(NQL); if constexpr (F32) { SWRITE_KF(0); SBAR(); SLOAD_F((const float*)nxt.V, kbn); } else { SWRITE_HK(0); } SBAR(); } while (0)
    f32x16 pA0, pA1, pB0, pB1; float mnA, mnB, alA, alB; bf16x8 pa0, pa1, pa2, pa3;
    if constexpr (F32) { VMW(); SWRITE_VF(0); SBAR(); } else { SWRITE_HV(0); SBAR(); }
    if (NT > 1) { if constexpr (F32) SLOAD_F((const float*)Kh, KBASE(1)); else SLOAD_H(Kh, Vh, KBASE(1)); }
    SBAR(); qkt<0, SK, BIAS>(pA0, pA1, K_lds, r32, hi, S.qr, ACT(0), BZP(0));
    if constexpr (F32) { if (NT > 1) { VMW(); SWRITE_KF(1); SBAR(); SLOAD_F((const float*)Vh, KBASE(1)); } }
    MASKT(pA0, pA1, 0); partialSM(pA0, pA1, m_reg, mnA, alA);
    if (NT > 1) { VMW(); if constexpr (F32) { SWRITE_VF(1); SBAR(); if (NT > 2) SLOAD_F((const float*)Kh, KBASE(2)); } else SWRITE_H(1); }
    __syncthreads();
#define HALF_STEP(PX0, PX1, mnX, alX, PY0, PY1, alY, t, KB, VB, SB) do {                                                      \
        SBAR(); qkt<KB, SK, BIAS>(PX0, PX1, K_lds, r32, hi, S.qr, ACT(t), BZP(t));                                             \
        finishSM(PY0, PY1, alY, l_reg, pa0, pa1, pa2, pa3); SBAR();                                                           \
        if ((t) + 1 < NT) { if constexpr (F32) { VMW(); SWRITE_KF(SB); SBAR(); SLOAD_F((const float*)Vh, KBASE((t) + 1)); }  \
                            else { SLOAD_H(Kh, Vh, KBASE((t) + 1)); } SBAR(); }                                               \
        pv_tile<VB, SK>(o, vb0, pa0, pa1, pa2, pa3, ACT((t) - 1)); MASKT(PX0, PX1, (t)); partialSM(PX0, PX1, m_reg, mnX, alX);                                        \
        __syncthreads();                                                                                                      \
        if ((t) + 1 < NT) { VMW(); if constexpr (F32) { SWRITE_VF(SB); SBAR(); if ((t) + 2 < NT) SLOAD_F((const float*)Kh, KBASE((t) + 2)); } \
                            else { SWRITE_H(SB); } }                                                                          \
        RESC(alX); __syncthreads(); } while (0)
    for (int t = 1; t + 1 < NT; t += 2) {
        HALF_STEP(pB0, pB1, mnB, alB, pA0, pA1, alA, t, 1, 0, 0);
        HALF_STEP(pA0, pA1, mnA, alA, pB0, pB1, alB, t + 1, 0, 1, 1);
    }
    const bool even = (NT & 1) == 0;
    if (even) { SBAR(); qkt<1, SK, BIAS>(pB0, pB1, K_lds, r32, hi, S.qr, ACT(NT - 1), BZP(NT - 1)); SBAR(); }
#define QROW(e) (nxt.Q + (size_t)(wid * QBLK + r32) * D + ((e) >> 1) * 16 + hi * 8 + ((e) & 1) * 4)
    if constexpr (F32) { SLOAD_F((const float*)nxt.K, kbn); SBAR();
#pragma unroll
        for (int e = 0; e < 8; ++e) S.tq[e] = *(const f32x4*)QROW(e); }
    else { SLOAD_H(nxt.K, nxt.V, kbn); SBAR();
#pragma unroll
        for (int d0 = 0; d0 < 8; ++d0) S.qr[d0] = load8<TIn>(nxt.Q + (size_t)(wid * QBLK + r32) * D + d0 * 16 + hi * 8); }
    SBAR();
    finishSM(pA0, pA1, alA, l_reg, pa0, pa1, pa2, pa3); SBAR();
    if constexpr (F32) {
#pragma unroll
        for (int e = 8; e < 16; ++e) S.tq[e] = *(const f32x4*)QROW(e); SBAR(); }
#undef QROW
    pv_tile<0, SK>(o, vb0, pa0, pa1, pa2, pa3, ACT(even ? NT - 2 : NT - 1));
    if (even) { MASKT(pB0, pB1, NT - 1); partialSM(pB0, pB1, m_reg, mnB, alB); __syncthreads(); RESC(alB);
        finishSM(pB0, pB1, alB, l_reg, pa0, pa1, pa2, pa3); SBAR(); pv_tile<1, SK>(o, vb0, pa0, pa1, pa2, pa3, ACT(NT - 1)); }
    SBAR(); SEAM_K0();
    if (hi == 0) li_l[r32] = l_reg; asm volatile("s_waitcnt lgkmcnt(0)" ::: "memory");
    float rli[16];
#pragma unroll
    for (int r = 0; r < 16; ++r) rli[r] = __builtin_amdgcn_rcpf(li_l[crow(r, hi)]);
    TOut* Ow = cur.O + (size_t)(wid * QBLK) * OLD;
#pragma unroll
    for (int r = 0; r < 16; ++r) { const int orow = crow(r, hi);
#pragma unroll
        for (int d0 = 0; d0 < 4; ++d0) { const float v = o[d0][r] * rli[r];
            if constexpr (same_t<TOut, float>::v) { Ow[(size_t)orow * OLD + d0 * 32 + r32] = v; }
            else { const float vn = __shfl_xor(v, 1);
                   if ((r32 & 1) == 0) *(unsigned*)(Ow + (size_t)orow * OLD + d0 * 32 + r32) = cvtpk(v, vn); } } }
    if constexpr (F32) {
#pragma unroll
        for (int d0 = 0; d0 < 8; ++d0) S.qr[d0] = pack8(S.tq[2 * d0], S.tq[2 * d0 + 1]); }
    __syncthreads();
#undef RESC
#undef KBASE
#undef BZP
#undef ACT
#undef MASKT
#undef SEAM_K0
#undef HALF_STEP
}
#undef ROW
#undef VMW
#undef VMWN
#undef SLOAD_H
#undef SWRITE_HK
#undef SWRITE_HV
#undef SWRITE_H
#undef SLOAD_F
#undef SWRITE_KF
#undef SWRITE_VF
}

namespace {
constexpr int D = 2048, NB = 4, S = 4096, NTOK = NB * S;
constexpr int NTHR = 512;
constexpr int MAXSLOT = 40960;
constexpr int NPANEL = MAXSLOT / 256;
constexpr float LN_EPS = 1e-5f, RMS_EPS = 1e-5f;
constexpr float ALPHA = 1.41421356237309515f;
constexpr float LAM_INIT0 = 0.2f;


#define XB_TMO      128
#define XB_XCNT(j)  (256  + 64 * (j))
#define XB_XSUB(j)  (1280 + 64 * (j))
#define XB_XGEN(j)  (2304 + 64 * (j))
#define XB_TOP      3328
#define XB_TOPGEN   3392
#define XCD_BAR_WORDS 3456
#define XB_SPIN_CAP (1u << 18)
#define LAS __attribute__((address_space(3)))
__device__ __forceinline__ unsigned xb_ld(unsigned* p)              { return __hip_atomic_load(p, __ATOMIC_RELAXED, __HIP_MEMORY_SCOPE_AGENT); }
__device__ __forceinline__ unsigned xb_add(unsigned* p, unsigned v) { return __hip_atomic_fetch_add(p, v, __ATOMIC_RELAXED, __HIP_MEMORY_SCOPE_AGENT); }
__device__ __forceinline__ unsigned xb_xcc_id() { return (unsigned)__builtin_amdgcn_s_getreg((3 << 11) | 20) & 0xFu; }
#define XB_SPIN(cond, bar) do { unsigned _sp = 0; while (cond) { __builtin_amdgcn_s_sleep(1); \
    if ((++_sp & 255u) == 0u) { if (xb_ld(&(bar)[XB_TMO])) break; if (_sp > XB_SPIN_CAP) { atomicAdd(&(bar)[XB_TMO], 1u); break; } } } } while (0)
struct XcdBarrier { unsigned* bar; unsigned x; volatile LAS unsigned* st; };
__device__ __forceinline__ XcdBarrier xcd_barrier_post(unsigned* bar, volatile LAS unsigned* st) {
    XcdBarrier b; b.bar = bar; b.x = (unsigned)__builtin_amdgcn_readfirstlane((int)xb_xcc_id()); b.st = st;
    if (threadIdx.x == 0) (void)xb_add(&bar[XB_XCNT(b.x)], 1u);
    return b;
}
__device__ __forceinline__ void xcd_barrier_complete(unsigned* bar, unsigned x, unsigned& nloc, unsigned& nx) {
    const unsigned G = gridDim.x * gridDim.y * gridDim.z;
    unsigned sum, cnt, mine, sp = 0u;
    for (;;) {
        sum = 0u; cnt = 0u; mine = 0u;
#pragma unroll
        for (unsigned j = 0; j < 16; ++j) { const unsigned c = xb_ld(&bar[XB_XCNT(j)]); sum += c; cnt += (c > 0u) ? 1u : 0u; mine = (j == x) ? c : mine; }
        if (sum == G) break;
        __builtin_amdgcn_s_sleep(1);
        if ((++sp & 255u) == 0u) { if (xb_ld(&bar[XB_TMO])) break; if (sp > XB_SPIN_CAP) { atomicAdd(&bar[XB_TMO], 1u); break; } }
    }
    nloc = mine > 0u ? mine : 1u; nx = cnt > 0u ? cnt : 1u;
}
__device__ __forceinline__ void xcd_barrier(const XcdBarrier& b) {
    asm volatile("s_waitcnt vmcnt(0)" ::: "memory");
    __syncthreads();
    int t0_ = threadIdx.x; asm volatile("" : "+v"(t0_));
    if (t0_ == 0) {
        unsigned* bar = b.bar;
        unsigned bx = b.x; asm volatile("" : "+s"(bx));
        __builtin_amdgcn_s_waitcnt(0);
        unsigned nloc = b.st[0], nx = b.st[1];
        if (nloc == 0u) { xcd_barrier_complete(bar, bx, nloc, nx); b.st[0] = nloc; b.st[1] = nx; }
        const unsigned old = xb_add(&bar[XB_XSUB(bx)], 1u);
        const unsigned gen = old / nloc;
        if (old + 1u == (gen + 1u) * nloc) {
            __builtin_amdgcn_fence(__ATOMIC_RELEASE, "agent");
            asm volatile("s_waitcnt vmcnt(0)" ::: "memory");
            const unsigned og = xb_add(&bar[XB_TOP], 1u);
            const unsigned tg = og / nx;
            if (og + 1u == (tg + 1u) * nx) xb_add(&bar[XB_TOPGEN], 1u);
            else XB_SPIN(xb_ld(&bar[XB_TOPGEN]) == tg, bar);
            __builtin_amdgcn_fence(__ATOMIC_ACQUIRE, "agent");
            xb_add(&bar[XB_XGEN(bx)], 1u);
            asm volatile("s_waitcnt vmcnt(0)" ::: "memory");
        } else {
            XB_SPIN(xb_ld(&bar[XB_XGEN(bx)]) == gen, bar);
            __builtin_amdgcn_fence(__ATOMIC_ACQUIRE, "agent");
            asm volatile("s_waitcnt vmcnt(0)" ::: "memory");
        }
    }
    __syncthreads();
}

__device__ __forceinline__ float wave_sum(float v) {
#pragma unroll
    for (int o = 32; o >= 1; o >>= 1) v += __shfl_xor(v, o);
    return v;
}
__device__ __forceinline__ float wave_max(float v) {
#pragma unroll
    for (int o = 32; o >= 1; o >>= 1) v = fmaxf(v, __shfl_xor(v, o));
    return v;
}

extern __shared__ __attribute__((aligned(16))) unsigned char g_lds[];
constexpr int RING_BYTES = 131072, LDS_BYTES = 147456, LDSCTL_OFF = LDS_BYTES - 256;
__device__ __forceinline__ int obid() { int b = blockIdx.x; asm volatile("" : "+s"(b)); return b; }
__device__ __forceinline__ int otid() { int t = threadIdx.x; asm volatile("" : "+v"(t)); return t; }

struct ModF {
    const float* c; const float* w0; const float* w1; float* modp;
    __device__ __forceinline__ void operator()(int vb) const {
        float (*sc)[128] = (float (*)[128])g_lds;
        const int tid = otid();
        const int kc = vb & 15, nb = (vb >> 4) % 12, set = vb / 192, n = nb * NTHR + tid, k0 = kc * 128;
        const float* W = ((set & 1) ? w1 : w0) + (size_t)(set >> 1) * D * 3 * D + (size_t)k0 * (3 * D) + n;
        __syncthreads();
        { const float v = c[(tid >> 7) * D + k0 + (tid & 127)]; sc[tid >> 7][tid & 127] = v / (1.f + expf(-v)); }
        __syncthreads();
        float a0 = 0.f, a1 = 0.f, a2 = 0.f, a3 = 0.f;
#pragma unroll 16
        for (int k = 0; k < 128; ++k) { const float w = W[(size_t)k * (3 * D)]; a0 += sc[0][k] * w; a1 += sc[1][k] * w; a2 += sc[2][k] * w; a3 += sc[3][k] * w; }
        float* o = modp + ((size_t)(kc * 4 + set) * NB) * 3 * D + n;
        o[0 * 3 * D] = a0; o[1 * 3 * D] = a1; o[2 * 3 * D] = a2; o[3 * 3 * D] = a3;
    }
};
struct ModRedF {
    const float* modp; const float* b0; const float* b1; float* out;
    __device__ __forceinline__ void operator()(int vb) const {
        const int i = vb * NTHR + otid();
        const int n = i % (3 * D), set = i / (NB * 3 * D);
        float a = ((set & 1) ? b1 : b0)[(size_t)(set >> 1) * 3 * D + n];
#pragma unroll
        for (int kc = 0; kc < 16; ++kc) a += modp[(size_t)kc * 4 * NB * 3 * D + i];
        out[i] = a;
    }
};

typedef unsigned short bf16_t;
__device__ __forceinline__ unsigned pkbf(float lo, float hi) { unsigned r; asm volatile("v_cvt_pk_bf16_f32 %0, %1, %2" : "=v"(r) : "v"(lo), "v"(hi)); return r; }
struct ModulateF {
    const float* x; const float* mod; float* h; bf16_t* hb;
    __device__ __forceinline__ void operator()(int vb) const {
        const size_t i4 = (size_t)vb * NTHR + otid();
        const size_t e = i4 * 4; const int t = (int)(e / D), d = (int)(e % D), b = t / S;
        const float4 xv = *(const float4*)(x + e);
        const float4 sh = *(const float4*)(mod + (size_t)b * 3 * D + d);
        const float4 sc = *(const float4*)(mod + (size_t)b * 3 * D + D + d);
        float4 o; o.x = xv.x * (1.f + sc.x) + sh.x; o.y = xv.y * (1.f + sc.y) + sh.y; o.z = xv.z * (1.f + sc.z) + sh.z; o.w = xv.w * (1.f + sc.w) + sh.w;
        if (h) *(float4*)(h + e) = o;
        if (hb) { uint2 w; w.x = pkbf(o.x, o.y); w.y = pkbf(o.z, o.w); *(uint2*)(hb + e) = w; }
    }
};
struct Mod0F {
    const float* x; const float* modp; const float* bias; bf16_t* hb;
    __device__ __forceinline__ void run() const {
        float* sv = (float*)g_lds;
        const int tid = otid(), wave = tid >> 6, lane = tid & 63;
        const int G = gridDim.x, per = G >> 2, bid = obid();
        if (per == 0 || bid >= 4 * per) return;
        const int b = bid / per, r = bid - b * per;
        __syncthreads();
        for (int i = tid; i < 2 * D; i += NTHR) { float a = bias[i];
#pragma unroll
            for (int kc = 0; kc < 16; ++kc) a += modp[((size_t)(kc * 4 + 0) * NB + b) * 3 * D + i];
            sv[i] = a; }
        __syncthreads();
        for (int row = r * 8 + wave; row < S; row += per * 8) { const size_t t = (size_t)b * S + row;
            float4 xv[8];
#pragma unroll
            for (int i = 0; i < 8; ++i) xv[i] = *(const float4*)(x + t * D + (i * 64 + lane) * 4);
#pragma unroll
            for (int i = 0; i < 8; ++i) { const int d = (i * 64 + lane) * 4; const float4 s4 = *(const float4*)(sv + d), c4 = *(const float4*)(sv + D + d);
                uint2 w; w.x = pkbf(xv[i].x * (1.f + c4.x) + s4.x, xv[i].y * (1.f + c4.y) + s4.y); w.y = pkbf(xv[i].z * (1.f + c4.z) + s4.z, xv[i].w * (1.f + c4.w) + s4.w);
                *(uint2*)(hb + t * D + d) = w; } }
        __syncthreads();
    }
};
struct ConvF {
    const float* src; bf16_t* dst;
    __device__ __forceinline__ void operator()(int vb) const {
        const size_t e = ((size_t)vb * NTHR + otid()) * 4;
        const float4 v = *(const float4*)(src + e); uint2 w; w.x = pkbf(v.x, v.y); w.y = pkbf(v.z, v.w); *(uint2*)(dst + e) = w;
    }
};
struct TransF {
    const float* W; bf16_t* WT; int K, ldw, ncols, ileave;
    __device__ __forceinline__ int nitems() const { return (K / 64) * (ncols / 64); }
    __device__ __forceinline__ void load(int it, int lane, float4 (&v)[16]) const {
        const int nblk = ncols / 64, kb = it / nblk, nb = it - kb * nblk, k0 = 64 * kb, n0 = 64 * nb;
        const int n4 = lane & 15, kr = lane >> 4;
        const float* src = W + (size_t)(k0 + kr * 16) * ldw + n0 + 4 * n4;
#pragma unroll
        for (int i = 0; i < 16; ++i) v[i] = *(const float4*)(src + (size_t)i * ldw);
    }
    __device__ __forceinline__ void item(int it, int wave, int lane) const { float4 v[16]; load(it, lane, v); finish(it, wave, lane, v); }
    __device__ __forceinline__ void finish(int it, int wave, int lane, const float4 (&v)[16]) const {
        unsigned char* scr = g_lds + wave * 16384;
        const int nblk = ncols / 64, kb = it / nblk, nb = it - kb * nblk, k0 = 64 * kb, n0 = 64 * nb;
        const int n4 = lane & 15, kr = lane >> 4;
#pragma unroll
        for (int j = 0; j < 4; ++j) { uint4 lo4, hi4;
            const float e0 = j == 0 ? v[0].x : j == 1 ? v[0].y : j == 2 ? v[0].z : v[0].w; (void)e0;
#define TF_EL(i) (j == 0 ? v[i].x : j == 1 ? v[i].y : j == 2 ? v[i].z : v[i].w)
            lo4.x = pkbf(TF_EL(0), TF_EL(1)); lo4.y = pkbf(TF_EL(2), TF_EL(3)); lo4.z = pkbf(TF_EL(4), TF_EL(5)); lo4.w = pkbf(TF_EL(6), TF_EL(7));
            hi4.x = pkbf(TF_EL(8), TF_EL(9)); hi4.y = pkbf(TF_EL(10), TF_EL(11)); hi4.z = pkbf(TF_EL(12), TF_EL(13)); hi4.w = pkbf(TF_EL(14), TF_EL(15));
#undef TF_EL
            unsigned char* d = scr + (4 * n4 + j) * 144 + kr * 32;
            *(uint4*)d = lo4; *(uint4*)(d + 16) = hi4; }
        asm volatile("s_waitcnt lgkmcnt(0)" ::: "memory");
        const int c = lane & 7;
#pragma unroll
        for (int j = 0; j < 8; ++j) { const int n = (lane >> 3) + 8 * j; const uint4 o = *(const uint4*)(scr + n * 144 + c * 16);
            const int nn = n0 + n;
            const int dr = ileave == 0 ? nn : (ileave == 3 ? (nn < 4096 ? ((nn >> 8) * 256 + ((nn >> 6) & 1) * 128 + ((nn >> 7) & 1) * 64 + (nn & 63)) : nn)
                                                         : ((nn >> 7) * 256 + (ileave - 1) * 128 + (nn & 127)));
            *(uint4*)(WT + (size_t)dr * K + k0 + 8 * c) = o; }
        asm volatile("s_waitcnt lgkmcnt(0)" ::: "memory");
    }
    __device__ __forceinline__ void run() const {
        const int tid = otid(), wave = tid >> 6, lane = tid & 63;
        for (int it = obid() * 8 + wave; it < nitems(); it += gridDim.x * 8) item(it, wave, lane);
    }
};

struct GemmF {
    const float* A; const float* B; float* C;
    const int* rowidx;
    const int* panel_e;
    long long strideBe;
    int lda, ldb, ldc, M, N, K;
    int transB, causal;
    int tilesN, pad0;
    __device__ __forceinline__ void operator()(int vb) const {
        float (*As)[132] = (float (*)[132])g_lds; float (*Bs)[132] = (float (*)[132])(g_lds + 16 * 132 * 4);
        const int tm = vb / tilesN, tn = vb % tilesN, m0 = tm * 128, n0 = tn * 128;
        const float* Bp = B;
        if (panel_e) { const int e = panel_e[m0 >> 8]; if (e < 0) return; Bp += (size_t)e * strideBe; }
        if (causal == 1 && n0 > m0 + 127) return;
        int Kend = K; if (causal == 2 && m0 + 128 < K) Kend = m0 + 128;
        const int tid = otid(), tx = tid & 31, ty = tid >> 5;
        float acc[8][4];
#pragma unroll
        for (int i = 0; i < 8; ++i)
#pragma unroll
            for (int j = 0; j < 4; ++j) acc[i][j] = 0.f;
        const int ar = tid >> 2, ak = (tid & 3) * 4;
        long long arow = m0 + ar; bool aval = arow < M;
        if (rowidx && aval) { const int ri = rowidx[arow]; aval = ri >= 0; arow = ri; }
        const float* Ap = A + (aval ? arow : 0) * (long long)lda + ak;
        int bk, bn; if (!transB) { bk = tid >> 5; bn = (tid & 31) * 4; } else { bn = tid >> 2; bk = (tid & 3) * 4; }
        const bool bval = (n0 + bn) < N;
        for (int k0 = 0; k0 < Kend; k0 += 16) {
            float4 av = make_float4(0.f, 0.f, 0.f, 0.f), bv = make_float4(0.f, 0.f, 0.f, 0.f);
            if (aval) av = *(const float4*)(Ap + k0);
            if (bval) { if (!transB) bv = *(const float4*)(Bp + (size_t)(k0 + bk) * ldb + n0 + bn); else bv = *(const float4*)(Bp + (size_t)(n0 + bn) * ldb + k0 + bk); }
            __syncthreads();
            As[ak + 0][ar] = av.x; As[ak + 1][ar] = av.y; As[ak + 2][ar] = av.z; As[ak + 3][ar] = av.w;
            if (!transB) { *(float4*)&Bs[bk][bn] = bv; } else { Bs[bk + 0][bn] = bv.x; Bs[bk + 1][bn] = bv.y; Bs[bk + 2][bn] = bv.z; Bs[bk + 3][bn] = bv.w; }
            __syncthreads();
#pragma unroll
            for (int kk = 0; kk < 16; ++kk) {
                const float4 a0 = *(const float4*)&As[kk][ty * 8], a1 = *(const float4*)&As[kk][ty * 8 + 4], b = *(const float4*)&Bs[kk][tx * 4];
                const float a[8] = {a0.x, a0.y, a0.z, a0.w, a1.x, a1.y, a1.z, a1.w};
#pragma unroll
                for (int i = 0; i < 8; ++i) { acc[i][0] += a[i] * b.x; acc[i][1] += a[i] * b.y; acc[i][2] += a[i] * b.z; acc[i][3] += a[i] * b.w; }
            }
        }
        const int col = n0 + tx * 4;
        if (col < N) {
#pragma unroll
            for (int i = 0; i < 8; ++i) { const int row = m0 + ty * 8 + i; if (row < M) *(float4*)(C + (size_t)row * ldc + col) = make_float4(acc[i][0], acc[i][1], acc[i][2], acc[i][3]); }
        }
        __syncthreads();
    }
};

struct RopeTab { float inv_freq[64]; };
struct RopeTableF {
    float* tab;
    __device__ __forceinline__ void operator()(int vb) const {
        const int idx = vb * NTHR + otid(); const int s = idx >> 6, i = idx & 63;
        const float inv_freq = (float)exp2(-(double)i * (13.287712379549449 / 64.0));
        const float angf = (float)s * inv_freq;
        double r = (double)angf;
        const double k = rint(r * 0.63661977236758134308);
        r = fma(-k, 1.57079632679489655800e+00, r); r = fma(-k, 6.12323399573676603587e-17, r);
        const int q = ((int)k) & 3;
        const double r2 = r * r;
        double sn = -1.0 / 6227020800.0 * -1.0;
        sn = 1.0 / 6227020800.0;
        sn = sn * r2 - 1.0 / 39916800.0; sn = sn * r2 + 1.0 / 362880.0; sn = sn * r2 - 1.0 / 5040.0; sn = sn * r2 + 1.0 / 120.0; sn = sn * r2 - 1.0 / 6.0; sn = sn * r2 + 1.0; sn = sn * r;
        double cs = -1.0 / 87178291200.0;
        cs = cs * r2 + 1.0 / 479001600.0; cs = cs * r2 - 1.0 / 3628800.0; cs = cs * r2 + 1.0 / 40320.0; cs = cs * r2 - 1.0 / 720.0; cs = cs * r2 + 1.0 / 24.0; cs = cs * r2 - 0.5; cs = cs * r2 + 1.0;
        double c, sv;
        if (q == 0) { c = cs; sv = sn; } else if (q == 1) { c = -sn; sv = cs; } else if (q == 2) { c = -cs; sv = -sn; } else { c = sn; sv = -cs; }
        tab[(size_t)idx * 2] = (float)c; tab[(size_t)idx * 2 + 1] = (float)sv;
    }
};
struct RopeF {
    float* p; const float* tab; int ld, pad0;
    __device__ __forceinline__ void operator()(int vb) const {
        const int idx = vb * NTHR + otid();
        const int i = idx & 63, head = (idx >> 6) & 31, s = idx >> 11;
        float* q = p + (size_t)s * ld + head * 128 + i;
        const float c = tab[((size_t)s * 64 + i) * 2], sn = tab[((size_t)s * 64 + i) * 2 + 1];
        const float x1 = q[0], x2 = q[64];
        q[0] = x1 * c - x2 * sn; q[64] = x2 * c + x1 * sn;
    }
};

struct LamF {
    const float* q1; const float* k1; const float* q2; const float* k2; float* lam;
    __device__ __forceinline__ void operator()(int vb) const {
        const int tid = otid();
        if (tid < 64) {
            float a = q1[tid] * k1[tid] + q1[tid + 64] * k1[tid + 64], b = q2[tid] * k2[tid] + q2[tid + 64] * k2[tid + 64];
            a = wave_sum(a); b = wave_sum(b);
            if (tid == 0) lam[0] = expf(a) - expf(b) + LAM_INIT0;
        }
    }
};

struct SoftmaxF {
    float* S1; float* S2;
    const float* lam; const float* cum;
    float scale; int pad0;
    __device__ __forceinline__ void operator()(int vb) const {
        const int tid = otid(), wave = tid >> 6, lane = tid & 63;
        const int i = vb * 8 + wave;
        float* r1 = S1 + (size_t)i * S; float* r2 = S2 ? S2 + (size_t)i * S : nullptr;
        const float ci = cum ? cum[i] : 0.f;
        float m1 = -INFINITY, m2 = -INFINITY;
        for (int j = lane; j <= i; j += 64) {
            float s = r1[j] * scale; if (cum) s += ci - cum[j]; m1 = fmaxf(m1, s);
            if (r2) m2 = fmaxf(m2, r2[j] * scale);
        }
        m1 = wave_max(m1); m2 = wave_max(m2);
        float l1 = 0.f, l2 = 0.f;
        for (int j = lane; j <= i; j += 64) {
            float s = r1[j] * scale; if (cum) s += ci - cum[j]; l1 += expf(s - m1);
            if (r2) l2 += expf(r2[j] * scale - m2);
        }
        l1 = wave_sum(l1); l2 = wave_sum(l2);
        const float lm = r2 ? lam[0] : 0.f;
        const int jend = ((i >> 7) + 1) << 7;
        for (int j = lane; j < jend; j += 64) {
            float o = 0.f;
            if (j <= i) {
                float s = r1[j] * scale; if (cum) s += ci - cum[j];
                o = expf(s - m1) / l1;
                if (r2) o -= lm * (expf(r2[j] * scale - m2) / l2);
            }
            r1[j] = o;
        }
    }
};

struct RmsF {
    float* o; const float* w; bf16_t* ob;
    __device__ __forceinline__ void operator()(int vb) const {
        const int tid = otid(), wave = tid >> 6, lane = tid & 63;
        const size_t g = (size_t)vb * 8 + wave;
        float4 v = *(float4*)(o + g * 256 + lane * 4);
        float ss = v.x * v.x + v.y * v.y + v.z * v.z + v.w * v.w; ss = wave_sum(ss);
        const float r = 1.0f / sqrtf(ss * (1.f / 256.f) + RMS_EPS) * (1.f - LAM_INIT0);
        const float4 ww = *(const float4*)(w + lane * 4);
        v.x = v.x * r * ww.x; v.y = v.y * r * ww.y; v.z = v.z * r * ww.z; v.w = v.w * r * ww.w;
        *(float4*)(o + g * 256 + lane * 4) = v;
        if (ob) { uint2 q; q.x = pkbf(v.x, v.y); q.y = pkbf(v.z, v.w); *(uint2*)(ob + g * 256 + lane * 4) = q; }
    }
};

struct CumF {
    const float* proj; const float* fb; float* cum; int ld, pad0;
    __device__ __forceinline__ void operator()(int vb) const {
        float* tot = (float*)g_lds;
        const int h = vb, tid = otid();
        float v[8]; float run = 0.f;
#pragma unroll
        for (int j = 0; j < 8; ++j) { const float x = proj[(size_t)(tid * 8 + j) * ld + 6144 + h] + fb[h];
            const float ls = fminf(x, 0.f) - log1pf(expf(-fabsf(x))); run += ls; v[j] = run; }
        __syncthreads();
        tot[tid] = run;
        __syncthreads();
        if (tid == 0) { float a = 0.f; for (int i = 0; i < NTHR; ++i) { const float t = tot[i]; tot[i] = a; a += t; } }
        __syncthreads();
        const float off = tot[tid];
#pragma unroll
        for (int j = 0; j < 8; ++j) cum[(size_t)h * S + tid * 8 + j] = v[j] + off;
        __syncthreads();
    }
};

struct LnF {
    const float* x; const float* ya; const int* tok_slot;
    const bf16_t* yb;
    const float* mod; const float* g; const float* bta; float* out;
    __device__ __forceinline__ void operator()(int vb) const {
        const int tid = otid(), wave = tid >> 6, lane = tid & 63;
        const int t = vb * 8 + wave, b = t / S;
        const float* xr = x + (size_t)t * D; const float* gt = mod + (size_t)b * 3 * D + 2 * D;
        const float* y0; const float* y1 = nullptr;
        if (tok_slot) { y0 = ya + (size_t)tok_slot[2 * t] * D; y1 = ya + (size_t)tok_slot[2 * t + 1] * D; } else y0 = ya + (size_t)t * D;
        if (yb) { y0 = xr; y1 = nullptr; }
        float4 z[8]; float sum = 0.f;
#pragma unroll
        for (int i = 0; i < 8; ++i) { const int d = (i * 64 + lane) * 4;
            const float4 xv = *(const float4*)(xr + d), gv = *(const float4*)(gt + d); float4 yv;
            if (yb) { const uint2 a = *(const uint2*)(yb + (size_t)(2 * t) * D + d), bq = *(const uint2*)(yb + (size_t)(2 * t + 1) * D + d);
                yv.x = __uint_as_float(a.x << 16) + __uint_as_float(bq.x << 16); yv.y = __uint_as_float(a.x & 0xffff0000u) + __uint_as_float(bq.x & 0xffff0000u);
                yv.z = __uint_as_float(a.y << 16) + __uint_as_float(bq.y << 16); yv.w = __uint_as_float(a.y & 0xffff0000u) + __uint_as_float(bq.y & 0xffff0000u); }
            else yv = *(const float4*)(y0 + d);
            if (y1) { const float4 y2 = *(const float4*)(y1 + d); yv.x += y2.x; yv.y += y2.y; yv.z += y2.z; yv.w += y2.w; }
            z[i].x = ALPHA * xv.x + (1.f + gv.x) * yv.x; z[i].y = ALPHA * xv.y + (1.f + gv.y) * yv.y; z[i].z = ALPHA * xv.z + (1.f + gv.z) * yv.z; z[i].w = ALPHA * xv.w + (1.f + gv.w) * yv.w;
            sum += (z[i].x + z[i].y) + (z[i].z + z[i].w); }
        sum = wave_sum(sum); const float mu = sum * (1.f / D);
        float var = 0.f;
#pragma unroll
        for (int i = 0; i < 8; ++i) { const float a = z[i].x - mu, bq = z[i].y - mu, c = z[i].z - mu, dd = z[i].w - mu; var += (a * a + bq * bq) + (c * c + dd * dd); }
        var = wave_sum(var) * (1.f / D);
        const float rs = 1.0f / sqrtf(var + LN_EPS);
#pragma unroll
        for (int i = 0; i < 8; ++i) { const int d = (i * 64 + lane) * 4; const float4 gg = *(const float4*)(g + d), bb = *(const float4*)(bta + d);
            float4 o; o.x = (z[i].x - mu) * rs * gg.x + bb.x; o.y = (z[i].y - mu) * rs * gg.y + bb.y; o.z = (z[i].z - mu) * rs * gg.z + bb.z; o.w = (z[i].w - mu) * rs * gg.w + bb.w;
            *(float4*)(out + (size_t)t * D + d) = o; }
    }
};

__device__ __forceinline__ int rowf_vb(int w, int i, int G, int nvb) { return (G == 256 && nvb == 1024) ? ((w >> 6) * 256 + (w & 63) + 64 * i) : (w + i * G); }
__device__ __forceinline__ int rowf_wg(int vb, int G, int nvb) { return (G == 256 && nvb == 1024) ? ((vb >> 8) * 64 + (vb & 63)) : (vb % G); }
typedef short bf16x8_t __attribute__((ext_vector_type(8)));
typedef _Float16 f16x8_t __attribute__((ext_vector_type(8)));
typedef float f32x4_t __attribute__((ext_vector_type(4)));
template <int MODE, bool XBF> struct RowF {
    const bf16_t* xb; bf16_t* outb;
    const float* x; const bf16_t* y; const bf16_t* yb; const float* modg; const float* g; const float* bta; float* out;
    const float* modn; bf16_t* hb; const bf16_t* whi; const bf16_t* wlo;
    const float* bg; const float* br; int* wgcnt; int* tok_e; int* tok_pos; float* tok_w; float* flog;
    __device__ __forceinline__ void run(int nvb) const {
        constexpr int NCB = MODE == 0 ? 3 : 1, NC = NCB * 16, HS = 2056, LOGIT_BATCHES = MODE == 0 ? 2 : 1;
        _Float16* H = (_Float16*)g_lds; float* P = (float*)(g_lds + 66048); float* Lg = (float*)(g_lds + 90624);
        LAS int* lc = (LAS int*)(g_lds + 93696);
        float* Vg = (float*)(g_lds + 93952); float* Vb = Vg + D; float* Vgate = Vb + D; float* Vsh = Vgate + D; float* Vsc = Vsh + D;
        const int tid = otid(), wave = tid >> 6, lane = tid & 63, G = gridDim.x;
        __syncthreads();
        float* Bs = (float*)(g_lds + 134912);
        if (MODE == 0) { if (tid < 32) lc[tid] = 0; if (tid < 36) Bs[tid] = tid < 4 ? bg[tid] : br[tid - 4]; }
        { const float4 a = *(const float4*)(g + tid * 4), c = *(const float4*)(bta + tid * 4); *(float4*)(Vg + tid * 4) = a; *(float4*)(Vb + tid * 4) = c; }
        int bcur = -1;
        float4 xv[8]; uint2 xq[8], ya[8], yc[8];
#define ROWF_LOAD(t_) do { _Pragma("unroll") for (int i_ = 0; i_ < 8; ++i_) { const int d_ = (i_ * 64 + lane) * 4; \
                    if (XBF) { xq[i_] = *(const uint2*)(xb + (size_t)(t_) * D + d_); xv[i_] = make_float4(0.f, 0.f, 0.f, 0.f); } else { xv[i_] = *(const float4*)(x + (size_t)(t_) * D + d_); xq[i_] = make_uint2(0u, 0u); } \
                    if (MODE != 0) { ya[i_] = *(const uint2*)(yb + (size_t)(2 * (t_)) * D + d_); yc[i_] = *(const uint2*)(yb + (size_t)(2 * (t_) + 1) * D + d_); } \
                    else { ya[i_] = *(const uint2*)(y + (size_t)(t_) * D + d_); yc[i_] = make_uint2(0u, 0u); } } } while (0)
        const bool bmap = G == 256 && nvb == 1024; const int vstep = bmap ? 64 : G, vb0 = rowf_vb(obid(), 0, G, nvb), vend = bmap ? vb0 + 256 : nvb;
        if (vb0 < vend) ROWF_LOAD(vb0 * 16 + wave * 2);
        for (int vb = vb0; vb < vend; vb += vstep) {
            const int b = (vb * 16) / S;
            if (b != bcur) {
                __syncthreads();
                const int tq = otid() * 4;
                { float4 a = *(const float4*)(modg + (size_t)b * 3 * D + 2 * D + tq); a.x += 1.f; a.y += 1.f; a.z += 1.f; a.w += 1.f; *(float4*)(Vgate + tq) = a; }
                if (MODE != 2) { const float4 sh4 = *(const float4*)(modn + (size_t)b * 3 * D + tq); float4 c = *(const float4*)(modn + (size_t)b * 3 * D + D + tq); c.x += 1.f; c.y += 1.f; c.z += 1.f; c.w += 1.f;
                    *(float4*)(Vsh + tq) = sh4; *(float4*)(Vsc + tq) = c; }
                __syncthreads(); bcur = b; }
            const int t0 = vb * 16 + wave * 2;
#pragma unroll
            for (int r = 0; r < 2; ++r) { const int t = t0 + r;
                float4 z[8]; float sum = 0.f;
#pragma unroll
                for (int i = 0; i < 8; ++i) { const int d = (i * 64 + lane) * 4;
                    const float4 gv = *(const float4*)(Vgate + d); float4 yv;
                    yv.x = __uint_as_float(ya[i].x << 16); yv.y = __uint_as_float(ya[i].x & 0xffff0000u); yv.z = __uint_as_float(ya[i].y << 16); yv.w = __uint_as_float(ya[i].y & 0xffff0000u);
                    if (MODE != 0) { yv.x += __uint_as_float(yc[i].x << 16); yv.y += __uint_as_float(yc[i].x & 0xffff0000u); yv.z += __uint_as_float(yc[i].y << 16); yv.w += __uint_as_float(yc[i].y & 0xffff0000u); }
                    float4 xf = xv[i]; if (XBF) { xf.x = __uint_as_float(xq[i].x << 16); xf.y = __uint_as_float(xq[i].x & 0xffff0000u); xf.z = __uint_as_float(xq[i].y << 16); xf.w = __uint_as_float(xq[i].y & 0xffff0000u); }
                    z[i].x = ALPHA * xf.x + gv.x * yv.x; z[i].y = ALPHA * xf.y + gv.y * yv.y; z[i].z = ALPHA * xf.z + gv.z * yv.z; z[i].w = ALPHA * xf.w + gv.w * yv.w;
                    sum += (z[i].x + z[i].y) + (z[i].z + z[i].w); }
                if (r == 0) { __builtin_amdgcn_sched_barrier(0); ROWF_LOAD(t0 + 1); __builtin_amdgcn_sched_barrier(0); }
                else if (vb + vstep < vend) { __builtin_amdgcn_sched_barrier(0); ROWF_LOAD((vb + vstep) * 16 + wave * 2); __builtin_amdgcn_sched_barrier(0); }
                sum = wave_sum(sum); const float mu = sum * (1.f / D);
                float var = 0.f;
#pragma unroll
                for (int i = 0; i < 8; ++i) { const float a = z[i].x - mu, bq = z[i].y - mu, c = z[i].z - mu, dd = z[i].w - mu; var += (a * a + bq * bq) + (c * c + dd * dd); }
                var = wave_sum(var) * (1.f / D);
                const float rs = 1.0f / sqrtf(var + LN_EPS);
#pragma unroll
                for (int i = 0; i < 8; ++i) { const int d = (i * 64 + lane) * 4; const float4 gg = *(const float4*)(Vg + d), bb = *(const float4*)(Vb + d);
                    float4 o; o.x = (z[i].x - mu) * rs * gg.x + bb.x; o.y = (z[i].y - mu) * rs * gg.y + bb.y; o.z = (z[i].z - mu) * rs * gg.z + bb.z; o.w = (z[i].w - mu) * rs * gg.w + bb.w;
                    if (MODE == 2) { *(float4*)(out + (size_t)t * D + d) = o; continue; }
                    { uint2 ow; ow.x = pkbf(o.x, o.y); ow.y = pkbf(o.z, o.w); *(uint2*)(outb + (size_t)t * D + d) = ow; }
                    const float4 s4 = *(const float4*)(Vsh + d), c4 = *(const float4*)(Vsc + d);
                    float4 h; h.x = o.x * c4.x + s4.x; h.y = o.y * c4.y + s4.y; h.z = o.z * c4.z + s4.z; h.w = o.w * c4.w + s4.w;
                    uint2 w; w.x = pkbf(h.x, h.y); w.y = pkbf(h.z, h.w); *(uint2*)(hb + (size_t)t * D + d) = w;
                    typedef _Float16 f16x4_t __attribute__((ext_vector_type(4)));
                    f16x4_t hq; hq[0] = (_Float16)h.x; hq[1] = (_Float16)h.y; hq[2] = (_Float16)h.z; hq[3] = (_Float16)h.w;
                    *(f16x4_t*)(H + (wave * 2 + r) * HS + d) = hq; } }
            if (MODE == 2) continue;
            __syncthreads();
            f32x4_t acc[NCB];
#pragma unroll
            for (int cb = 0; cb < NCB; ++cb) acc[cb] = (f32x4_t){0.f, 0.f, 0.f, 0.f};
            const int row = lane & 15, kg = lane >> 4, col = lane & 15;
            constexpr int KBATCH = 8 / LOGIT_BATCHES;
#pragma unroll
            for (int kq = 0; kq < LOGIT_BATCHES; ++kq) {
                f16x8_t Bw[KBATCH][NCB];
#pragma unroll
                for (int k2 = 0; k2 < KBATCH; ++k2)
#pragma unroll
                    for (int cb = 0; cb < NCB; ++cb) Bw[k2][cb] = *(const f16x8_t*)((const _Float16*)whi + ((size_t)((wave * 8 + kq * KBATCH + k2) * NCB + cb) * 64 + lane) * 8);
                __builtin_amdgcn_sched_barrier(0);
#pragma unroll
                for (int k2 = 0; k2 < KBATCH; ++k2) { const int kb = wave * 256 + (kq * KBATCH + k2) * 32 + kg * 8;
                    const f16x8_t A = *(const f16x8_t*)(H + row * HS + kb);
#pragma unroll
                    for (int cb = 0; cb < NCB; ++cb) acc[cb] = __builtin_amdgcn_mfma_f32_16x16x32_f16(A, Bw[k2][cb], acc[cb], 0, 0, 0); }
                __builtin_amdgcn_sched_barrier(0); }
#pragma unroll
            for (int cb = 0; cb < NCB; ++cb)
#pragma unroll
                for (int i = 0; i < 4; ++i) P[(wave * 16 + 4 * (lane >> 4) + i) * 48 + cb * 16 + col] = acc[cb][i];
            __syncthreads();
            for (int idx = tid; idx < 16 * NC; idx += NTHR) { const int r = idx / NC, c = idx - r * NC; float a = 0.f;
#pragma unroll
                for (int w = 0; w < 8; ++w) a += P[(w * 16 + r) * 48 + c];
                Lg[r * 48 + c] = a; }
            __syncthreads();
#pragma unroll
            for (int r = 0; r < 2; ++r) { const int t = t0 + r; const float* lr = Lg + (wave * 2 + r) * 48;
                if (MODE == 1) { if (lane < 16) flog[(size_t)t * 16 + lane] = lr[lane]; }
                else {
                    float gl[4] = {lr[0] + Bs[0], lr[1] + Bs[1], lr[2] + Bs[2], lr[3] + Bs[3]};
                    int gi = 0; float gm = gl[0];
#pragma unroll
                    for (int c = 1; c < 4; ++c) if (gl[c] > gm) { gm = gl[c]; gi = c; }
                    float gs = 0.f;
#pragma unroll
                    for (int c = 0; c < 4; ++c) gs += expf(gl[c] - gm);
                    const float gw = 1.f / gs;
                    float e[8];
#pragma unroll
                    for (int c = 0; c < 8; ++c) e[c] = lr[4 + gi * 8 + c] + Bs[4 + gi * 8 + c];
                    int i0 = 0; float v0 = e[0];
#pragma unroll
                    for (int c = 1; c < 8; ++c) if (e[c] > v0) { v0 = e[c]; i0 = c; }
                    int i1 = -1; float v1 = -INFINITY;
#pragma unroll
                    for (int c = 0; c < 8; ++c) if (c != i0 && e[c] > v1) { v1 = e[c]; i1 = c; }
                    const float ex = expf(v1 - v0), pa = 1.f / (1.f + ex), pb = ex / (1.f + ex);
                    if (lane == 0) {
                        const int e0 = gi * 8 + i0, e1 = gi * 8 + i1;
                        tok_e[2 * t] = e0; tok_e[2 * t + 1] = e1;
                        tok_w[2 * t] = gw * pa; tok_w[2 * t + 1] = gw * pb;
                        tok_pos[2 * t] = __hip_atomic_fetch_add(lc + e0, 1, __ATOMIC_RELAXED, __HIP_MEMORY_SCOPE_WORKGROUP); tok_pos[2 * t + 1] = __hip_atomic_fetch_add(lc + e1, 1, __ATOMIC_RELAXED, __HIP_MEMORY_SCOPE_WORKGROUP);
                    }
                }
            }
        }
#undef ROWF_LOAD
        if (MODE == 0) { __syncthreads(); const int t2 = otid(); if (t2 < 32) wgcnt[obid() * 32 + t2] = lc[t2]; }
    }
};
struct SmallWF {
    const float* wg; const float* wr; const float* bwin; bf16_t* rhi; bf16_t* rlo; bf16_t* fhi; bf16_t* flo;
    __device__ __forceinline__ void operator()(int vb) const {
        const int i = vb * NTHR + otid();
        float w; bf16_t* ph; bf16_t* pl; int k, col, ncb;
        if (i < 2 * 48 * D) { const int layer = i / (48 * D); k = i % D; col = (i / D) % 48; ncb = 3;
            if (col < 4) w = wg[((size_t)layer * D + k) * 4 + col];
            else if (col < 36) { const int gq = (col - 4) >> 3, e = (col - 4) & 7; w = wr[(((size_t)layer * 4 + gq) * D + k) * 8 + e]; }
            else w = 0.f;
            ph = rhi + (size_t)layer * 48 * D; pl = rlo + (size_t)layer * 48 * D; }
        else { const int j = i - 2 * 48 * D; k = j % D; col = j / D; ncb = 1; w = bwin[(size_t)k * 6160 + 6144 + col]; ph = fhi; pl = flo; }
        const size_t o = ((size_t)((((k >> 8) * 8 + ((k >> 5) & 7)) * ncb + (col >> 4)) * 64 + ((k >> 3) & 3) * 16 + (col & 15))) * 8 + (k & 7);
        (void)pl; ((_Float16*)ph)[o] = (_Float16)w;
    }
};

struct InitF {
    int* cnt; int* slot_token; int* panel_e; unsigned* nrm2;
    __device__ __forceinline__ void operator()(int vb) const {
        const int i = vb * NTHR + otid();
        if (i < 32) cnt[i] = 0;
        if (nrm2 && i < 512) nrm2[i] = 0u;
        if (i < NPANEL) panel_e[i] = -1;
        if (i < MAXSLOT) slot_token[i] = -1;
    }
};
struct RouteF {
    const float* h; const float* wg; const float* bg; const float* wr; const float* br;
    int* cnt; int* tok_e; int* tok_pos; float* tok_w;
    __device__ __forceinline__ void operator()(int vb) const {
        const int tid = otid(), wave = tid >> 6, lane = tid & 63;
        const int t = vb * 8 + wave;
        const float* hr = h + (size_t)t * D;
        float hv[32];
#pragma unroll
        for (int i = 0; i < 32; ++i) hv[i] = hr[lane + 64 * i];
        float p0 = 0.f, p1 = 0.f, p2 = 0.f, p3 = 0.f;
#pragma unroll
        for (int i = 0; i < 32; ++i) { const float4 w = *(const float4*)(wg + (size_t)(lane + 64 * i) * 4); p0 += hv[i] * w.x; p1 += hv[i] * w.y; p2 += hv[i] * w.z; p3 += hv[i] * w.w; }
        float gl[4] = {wave_sum(p0) + bg[0], wave_sum(p1) + bg[1], wave_sum(p2) + bg[2], wave_sum(p3) + bg[3]};
        int gi = 0; float gm = gl[0];
#pragma unroll
        for (int c = 1; c < 4; ++c) if (gl[c] > gm) { gm = gl[c]; gi = c; }
        float gs = 0.f;
#pragma unroll
        for (int c = 0; c < 4; ++c) gs += expf(gl[c] - gm);
        const float gw = 1.f / gs;
        const float* wrg = wr + (size_t)gi * D * 8;
        float e[8];
#pragma unroll
        for (int c = 0; c < 8; ++c) e[c] = 0.f;
#pragma unroll
        for (int i = 0; i < 32; ++i) { const float4 wa = *(const float4*)(wrg + (size_t)(lane + 64 * i) * 8), wb = *(const float4*)(wrg + (size_t)(lane + 64 * i) * 8 + 4);
            e[0] += hv[i] * wa.x; e[1] += hv[i] * wa.y; e[2] += hv[i] * wa.z; e[3] += hv[i] * wa.w; e[4] += hv[i] * wb.x; e[5] += hv[i] * wb.y; e[6] += hv[i] * wb.z; e[7] += hv[i] * wb.w; }
#pragma unroll
        for (int c = 0; c < 8; ++c) e[c] = wave_sum(e[c]) + br[gi * 8 + c];
        int i0 = 0; float v0 = e[0];
#pragma unroll
        for (int c = 1; c < 8; ++c) if (e[c] > v0) { v0 = e[c]; i0 = c; }
        int i1 = -1; float v1 = -INFINITY;
#pragma unroll
        for (int c = 0; c < 8; ++c) if (c != i0 && e[c] > v1) { v1 = e[c]; i1 = c; }
        const float ex = expf(v1 - v0), pa = 1.f / (1.f + ex), pb = ex / (1.f + ex);
        if (lane == 0) {
            const int e0 = gi * 8 + i0, e1 = gi * 8 + i1;
            tok_e[2 * t] = e0; tok_e[2 * t + 1] = e1;
            tok_w[2 * t] = gw * pa; tok_w[2 * t + 1] = gw * pb;
            tok_pos[2 * t] = atomicAdd(cnt + e0, 1); tok_pos[2 * t + 1] = atomicAdd(cnt + e1, 1);
        }
    }
};
struct ScatterF {
    const int* cnt; const int* tok_e; const int* tok_pos; const float* tok_w;
    int* tok_slot; int* slot_token; float* slot_w; int* panel_e; int* npan;
    __device__ __forceinline__ void operator()(int vb) const {
        const int i = vb * NTHR + otid();
        if (i < 2 * NTOK) {
            const int e = tok_e[i]; int off = 0;
            for (int q = 0; q < e; ++q) off += (cnt[q] + 255) & ~255;
            const int slot = off + tok_pos[i];
            tok_slot[i] = slot; slot_token[slot] = i; slot_w[slot] = tok_w[i];
        }
        if (vb == 0 && otid() < 32) {
            const int e = otid(); int off = 0;
            for (int q = 0; q < e; ++q) off += (cnt[q] + 255) & ~255;
            const int np = (cnt[e] + 255) >> 8;
            for (int p = 0; p < np; ++p) panel_e[(off >> 8) + p] = e;
            if (e == 31) npan[0] = (off >> 8) + np;
        }
    }
};
struct GatherF {
    const bf16_t* hb; bf16_t* Hs; const int* slot_token; float* slot_w; const int* npan;
    __device__ __forceinline__ void operator()(int vb) const {
        const int tid = otid(), wave = tid >> 6, lane = tid & 63;
        const int slot = vb * 8 + wave;
        if (slot >= npan[0] * 256) return;
        const int st = slot_token[slot];
        uint4* dst = (uint4*)(Hs + (size_t)slot * D) + lane;
        if (st >= 0) { const uint4* src = (const uint4*)(hb + (size_t)(st >> 1) * D) + lane;
#pragma unroll
            for (int j = 0; j < 4; ++j) dst[64 * j] = src[64 * j]; }
        else { const uint4 z = make_uint4(0u, 0u, 0u, 0u);
#pragma unroll
            for (int j = 0; j < 4; ++j) dst[64 * j] = z;
            if (lane == 0) slot_w[slot] = 0.f; }
    }
};
struct ScatF {
    const int* wgcnt; const int* tok_e; const int* tok_pos; const float* tok_w;
    int* slot_token; float* slot_w; int* panel_e; int* npan;
    __device__ __forceinline__ void operator()(int vb) const {
        int* base = (int*)g_lds;
        int* sego = base + 256 * 32;
        int* tot = sego + 16 * 32;
        int* off = tot + 32;
        const int tid = otid(), G = gridDim.x;
        __syncthreads();
        { const int e = tid & 31, seg = tid >> 5; int run = 0;
#pragma unroll
          for (int j = 0; j < 16; ++j) { const int w = seg * 16 + j; const int c = w < G ? wgcnt[w * 32 + e] : 0; base[w * 32 + e] = run; run += c; }
          sego[seg * 32 + e] = run; }
        __syncthreads();
        if (tid < 32) { int run = 0;
#pragma unroll
            for (int sgi = 0; sgi < 16; ++sgi) { const int c = sego[sgi * 32 + tid]; sego[sgi * 32 + tid] = run; run += c; }
            tot[tid] = run; }
        __syncthreads();
        if (tid == 0) { int run = 0; for (int e = 0; e < 32; ++e) { off[e] = run; run += (tot[e] + 255) & ~255; } }
        __syncthreads();
        const int i = vb * NTHR + tid;
        if (i < 2 * NTOK) {
            const int e = tok_e[i], w = rowf_wg((i >> 1) >> 4, G, NTOK / 16);
            const int slot = off[e] + sego[(w >> 4) * 32 + e] + base[w * 32 + e] + tok_pos[i];
            slot_token[slot] = i; slot_w[slot] = tok_w[i];
        } else if (i < 2 * NTOK + 32 * 256) {
            const int idx = i - 2 * NTOK, e = idx >> 8, r = idx & 255, c = tot[e], npad = ((c + 255) & ~255) - c;
            if (r < npad) slot_w[off[e] + c + r] = 0.f;
        }
        if (vb == 0 && tid < 32) {
            const int e = tid, np = (tot[e] + 255) >> 8;
            for (int q = 0; q < np; ++q) panel_e[(off[e] >> 8) + q] = e;
            if (e == 31) npan[0] = (off[e] >> 8) + np;
        }
        __syncthreads();
    }
};
struct HidF {
    float* a; const float* u; const float* slot_w; const int* slot_token; const int* panel_e;
    __device__ __forceinline__ void operator()(int vb) const {
        const size_t i4 = (size_t)vb * NTHR + otid(); const size_t e = i4 * 4; const int slot = (int)(e / 512);
        if (panel_e[slot >> 8] < 0) return;
        float4 o = make_float4(0.f, 0.f, 0.f, 0.f);
        if (slot_token[slot] >= 0) { const float w = slot_w[slot]; const float4 av = *(const float4*)(a + e), uv = *(const float4*)(u + e);
            o.x = av.x / (1.f + expf(-av.x)) * uv.x * w; o.y = av.y / (1.f + expf(-av.y)) * uv.y * w; o.z = av.z / (1.f + expf(-av.z)) * uv.z * w; o.w = av.w / (1.f + expf(-av.w)) * uv.w * w; }
        *(float4*)(a + e) = o;
    }
};

struct RopeHF {
    bf16_t* q; bf16_t* k; const float* tab;
    __device__ __forceinline__ void operator()(int vb) const {
        const size_t idx = (size_t)vb * NTHR + otid();
        const int i = (int)(idx & 63), s = (int)((idx >> 6) & 4095), bh = (int)((idx >> 18) & 63), which = (int)(idx >> 24);
        bf16_t* pp = (which ? k : q) + ((size_t)bh * S + s) * 128 + i;
        const float c = tab[((size_t)s * 64 + i) * 2], sn = tab[((size_t)s * 64 + i) * 2 + 1];
        const float x1 = __uint_as_float((unsigned)pp[0] << 16), x2 = __uint_as_float((unsigned)pp[64] << 16);
        pp[0] = (bf16_t)(pkbf(x1 * c - x2 * sn, 0.f) & 0xffffu); pp[64] = (bf16_t)(pkbf(x2 * c + x1 * sn, 0.f) & 0xffffu);
    }
};
struct CombineF {
    const bf16_t* o1; const bf16_t* o2; const float* lam; const float* w; bf16_t* ob;
    __device__ __forceinline__ void load(int vb, int wave, int lane, uint2 (&a)[4], uint2 (&bq)[4]) const {
        const size_t g0 = ((size_t)vb * 8 + wave) * 4;
#pragma unroll
        for (int j = 0; j < 4; ++j) { a[j] = *(const uint2*)(o1 + (g0 + j) * 256 + lane * 4); bq[j] = *(const uint2*)(o2 + (g0 + j) * 256 + lane * 4); }
    }
    __device__ __forceinline__ void finish(int vb, int wave, int lane, const uint2 (&a)[4], const uint2 (&bq)[4], float lm, const float4 ww) const {
        const size_t g0 = ((size_t)vb * 8 + wave) * 4;
#pragma unroll
        for (int j = 0; j < 4; ++j) {
            const float v0 = __uint_as_float(a[j].x << 16) - lm * __uint_as_float(bq[j].x << 16), v1 = __uint_as_float(a[j].x & 0xffff0000u) - lm * __uint_as_float(bq[j].x & 0xffff0000u);
            const float v2 = __uint_as_float(a[j].y << 16) - lm * __uint_as_float(bq[j].y << 16), v3 = __uint_as_float(a[j].y & 0xffff0000u) - lm * __uint_as_float(bq[j].y & 0xffff0000u);
            float ss = v0 * v0 + v1 * v1 + v2 * v2 + v3 * v3; ss = wave_sum(ss);
            const float r = 1.0f / sqrtf(ss * (1.f / 256.f) + RMS_EPS) * (1.f - LAM_INIT0);
            uint2 q; q.x = pkbf(v0 * r * ww.x, v1 * r * ww.y); q.y = pkbf(v2 * r * ww.z, v3 * r * ww.w);
            *(uint2*)(ob + (g0 + j) * 256 + lane * 4) = q; }
    }
    __device__ __forceinline__ void run(int nvb) const {
        const int tid = otid(), wave = __builtin_amdgcn_readfirstlane(tid >> 6), lane = tid & 63, G = gridDim.x, it0 = obid();
        const int nit = it0 < nvb ? (nvb - it0 + G - 1) / G : 0;
        if (nit <= 0) return;
        const int last = it0 + (nit - 1) * G;
        const float lm = lam[0]; const float4 ww = *(const float4*)(w + lane * 4);
        uint2 a0[4], b0[4], a1[4], b1[4];
        int it = it0, k = 0;
        load(it, wave, lane, a0, b0);
        for (; k + 1 < nit; k += 2) {
            load(it + G, wave, lane, a1, b1);
            __builtin_amdgcn_sched_barrier(0);
            finish(it, wave, lane, a0, b0, lm, ww);
            __builtin_amdgcn_sched_barrier(0);
            load(it + 2 * G < last ? it + 2 * G : last, wave, lane, a0, b0);
            __builtin_amdgcn_sched_barrier(0);
            finish(it + G, wave, lane, a1, b1, lm, ww);
            it += 2 * G;
        }
        if (k < nit) finish(it, wave, lane, a0, b0, lm, ww);
    }
};
struct CumBF {
    const float* flog; const float* fb; float* bz;
    __device__ __forceinline__ void operator()(int vb) const {
        float* tot = (float*)g_lds;
        const int b = vb >> 4, h = vb & 15, tid = otid();
        float v[8]; float run = 0.f;
#pragma unroll
        for (int j = 0; j < 8; ++j) { const float x = flog[((size_t)b * S + tid * 8 + j) * 16 + h] + fb[h];
            const float ls = fminf(x, 0.f) - log1pf(expf(-fabsf(x))); run += ls; v[j] = run; }
        __syncthreads();
        tot[tid] = run;
        __syncthreads();
        if (tid < 64) { float t8[8]; float a = 0.f;
#pragma unroll
            for (int j = 0; j < 8; ++j) { t8[j] = tot[tid * 8 + j]; a += t8[j]; }
            float inc = a;
#pragma unroll
            for (int o = 1; o < 64; o <<= 1) { const float v = __shfl_up(inc, o); if (tid >= o) inc += v; }
            float ex = inc - a;
#pragma unroll
            for (int j = 0; j < 8; ++j) { tot[tid * 8 + j] = ex; ex += t8[j]; } }
        __syncthreads();
        const float off = tot[tid];
#pragma unroll
        for (int j = 0; j < 8; ++j) bz[((size_t)b * 16 + h) * S + tid * 8 + j] = -(v[j] + off) * 11.313708498984761f;
        __syncthreads();
    }
};
struct AttnArgs { const bf16_t* q; const bf16_t* k; const bf16_t* v; bf16_t* o0; bf16_t* o1; const float* bz; const unsigned* nrm2; };
typedef swa::BlockRef<__hip_bfloat16, __hip_bfloat16> ARef;
template <int LAYER> __device__ __forceinline__ ARef attn_ref(const AttnArgs& a, int prob, int qb) {
    ARef r; r.P0 = qb * 256; r.Bz = nullptr; r.JLO = 0;
    if (LAYER == 0) {
        const int vh = prob & 1, c = (prob >> 1) & 1, h = (prob >> 2) & 7, b = prob >> 5, qh = 2 * h + c, vv = 2 * h + vh;
        r.Q = (const __hip_bfloat16*)a.q + ((size_t)(b * 16 + qh) * S + qb * 256) * 128;
        r.K = (const __hip_bfloat16*)a.k + (size_t)(b * 16 + qh) * S * 128;
        r.V = (const __hip_bfloat16*)a.v + (size_t)(b * 16 + vv) * S * 128;
        r.O = (__hip_bfloat16*)(c ? a.o1 : a.o0) + ((size_t)b * S + qb * 256) * D + h * 256 + vh * 128;
    } else {
        r.Q = (const __hip_bfloat16*)a.q + ((size_t)prob * S + qb * 256) * 128;
        r.K = (const __hip_bfloat16*)a.k + (size_t)prob * S * 128;
        r.V = (const __hip_bfloat16*)a.v + (size_t)prob * S * 128;
        r.O = (__hip_bfloat16*)a.o0 + ((size_t)(prob >> 4) * S + qb * 256) * D + (prob & 15) * 128;
        r.Bz = a.bz + (size_t)prob * S;
    }
    return r;
}
template <int NPROB> __device__ __forceinline__ void attn_item(int L, int& prob, int& x) { const int xc = L & 7, j = L >> 3; prob = xc * (NPROB / 8) + (j >> 3); x = j & 7; }
__device__ __forceinline__ float fox_R(const AttnArgs& a, int prob) {
    const float q2 = __uint_as_float(__hip_atomic_load(a.nrm2 + prob, __ATOMIC_RELAXED, __HIP_MEMORY_SCOPE_AGENT)), k2 = __uint_as_float(__hip_atomic_load(a.nrm2 + 64 + prob, __ATOMIC_RELAXED, __HIP_MEMORY_SCOPE_AGENT));
    return 2.f * sqrtf(q2 * k2) * 1.02f + 339.5f;
}
__device__ __forceinline__ int fox_jlo2(const AttnArgs& a, int prob, int x) {
    const float* bzp = a.bz + (size_t)prob * S; const int lane = otid() & 63;
    const float v = bzp[64 * lane + 63], f = bzp[256 * (lane & 15)], R = fox_R(a, prob);
    const float f0 = __shfl(f, x), f1 = __shfl(f, 15 - x);
    return __popcll(__ballot(f0 - v >= R)) | (__popcll(__ballot(f1 - v >= R)) << 8);
}
struct FoxPair { int probA, probB, x; bool paired; };
__device__ __forceinline__ FoxPair fox_pairing(const AttnArgs& a) {
    FoxPair fp; fp.probA = fp.probB = fp.x = 0; fp.paired = gridDim.x == 256;
    if (!fp.paired) return fp;
    const int bid = obid(), c = bid & 7, b = c >> 1, g = c & 1, j = bid >> 3, slot = j >> 3;
    LAS int* cost = (LAS int*)(g_lds + 100 * 1024); LAS int* order = cost + 16;
    const int tid = otid(), wave = __builtin_amdgcn_readfirstlane(tid >> 6), lane = tid & 63;
    __syncthreads();
#pragma unroll 1
    for (int hh = 0; hh < 2; ++hh) { const int h = wave * 2 + hh, prob = b * 16 + h;
        const float* bzp = a.bz + (size_t)prob * S;
        const float v = bzp[64 * lane + 63], f = bzp[256 * (lane & 15)], R = fox_R(a, prob);
        int cst = 0;
#pragma unroll
        for (int q = 0; q < 16; ++q) cst += 4 * (q + 1) + 1 - __popcll(__ballot(__shfl(f, q) - v >= R));
        if (lane == 0) cost[h] = cst; }
    __syncthreads();
    if (tid < 16) { const int ch = cost[tid]; int rk = 0;
        for (int h2 = 0; h2 < 16; ++h2) { const int c2 = cost[h2]; rk += (c2 > ch || (c2 == ch && h2 < tid)) ? 1 : 0; }
        order[rk] = tid; }
    __syncthreads();
    const int p = g == 0 ? (slot == 0 ? 0 : slot == 1 ? 3 : slot == 2 ? 4 : 7) : (slot == 0 ? 1 : slot == 1 ? 2 : slot == 2 ? 5 : 6);
    fp.probA = b * 16 + order[p]; fp.probB = b * 16 + order[15 - p]; fp.x = j & 7;
    __syncthreads();
    return fp;
}
template <int LAYER> __device__ __forceinline__ void attn_item_of(const FoxPair& fp, int i, int L, int& prob, int& x) {
    if (LAYER == 1 && fp.paired) { prob = (i & 1) ? fp.probB : fp.probA; x = (i & 1) ? 7 - fp.x : fp.x; }
    else { attn_item<LAYER == 0 ? 128 : 64>(L, prob, x); if (LAYER == 1 && (i & 1)) x = 7 - x; }
}
template <int LAYER> __device__ __forceinline__ void attn_stream(const AttnArgs& a, const FoxPair& fp, int i0, int i1) {
    constexpr int NPROB = LAYER == 0 ? 128 : 64, NX = 8, TOTAL = NPROB * NX;
    char* lds = (char*)g_lds;
    const int stride = gridDim.x;
    int i = i0, L = obid() + i0 * stride; if (i0 >= i1 || L >= TOTAL) return;
    int pass = 0, prob, x, jp = 0;
    if (LAYER == 1) {
        attn_item_of<LAYER>(fp, i0, L, prob, x); jp = fox_jlo2(a, prob, x);
        if (i0 + 1 < i1 && L + stride < TOTAL) { attn_item_of<LAYER>(fp, i0 + 1, L + stride, prob, x); jp |= fox_jlo2(a, prob, x) << 16; } }
#define JLO_OF(ii, ps) ((LAYER == 1 && (ii) - i0 < 2) ? ((jp >> (16 * ((ii) - i0) + 8 * (ps))) & 255) : 0)
    attn_item_of<LAYER>(fp, i, L, prob, x);
    ARef cur = attn_ref<LAYER>(a, prob, x); cur.JLO = JLO_OF(i, 0);
    swa::Seam<__hip_bfloat16> Sm;
    swa::causal_swa_prime<__hip_bfloat16, __hip_bfloat16>(cur, S, lds, Sm);
    for (;;) {
        const bool more_pass = pass == 0, more_item = (i + 1 < i1) && (L + stride < TOTAL), last = !more_pass && !more_item;
        int passn = pass + 1, Ln = L, in = i;
        if (!more_pass) { passn = 0; if (more_item) { Ln = L + stride; in = i + 1; } }
        attn_item_of<LAYER>(fp, in, Ln, prob, x);
        ARef nxt = last ? cur : attn_ref<LAYER>(a, prob, passn ? 15 - x : x);
        if (!last) nxt.JLO = JLO_OF(in, passn);
        swa::causal_swa_block<__hip_bfloat16, __hip_bfloat16, D, LAYER == 1>(cur, nxt, S, S, lds, Sm);
        if (last) break;
        cur = nxt; pass = passn; L = Ln; i = in;
    }
#undef JLO_OF
}
struct Params {
    const float* x; const float* c;
    const float* mix_mod_w; const float* mix_mod_b; const float* mix_ln_g; const float* mix_ln_b;
    const float* a_w_in; const float* a_lq1; const float* a_lk1; const float* a_lq2; const float* a_lk2; const float* a_subln; const float* a_w_out;
    const float* b_w_in; const float* b_fb; const float* b_w_out;
    const float* ffn_mod_w; const float* ffn_mod_b; const float* ffn_ln_g; const float* ffn_ln_b;
    const float* moe_wg; const float* moe_bg; const float* moe_wr; const float* moe_br; const float* moe_gate; const float* moe_up; const float* moe_down;
    float* out; unsigned* bar;
    float* modv; float* ropet; float* lam; float* cum; int* cnt; int* tok_e; int* tok_pos; float* tok_w; int* tok_slot; int* slot_token; float* slot_w; int* panel_e;
    float* xA; float* xB; float* hbuf; float* abuf; float* ubuf; float* obuf; float* projb; float* sc1; float* sc2; float* y2;
    bf16_t* hb; bf16_t* ob; bf16_t* wt_in[2]; bf16_t* wt_out[2];
    bf16_t* qh; bf16_t* kh; bf16_t* vh; bf16_t* o1; bf16_t* o2; float* flog; float* bz;
    bf16_t* wgu; bf16_t* wdn; bf16_t* wgu1; bf16_t* wdn1; bf16_t* Hs; bf16_t* hid; bf16_t* y2b; int* npan; float* modp; bf16_t* yb16;
    bf16_t* rhi; bf16_t* rlo; bf16_t* fhi; bf16_t* flo; int* wgcnt; bf16_t* xAb; bf16_t* xBb; unsigned* nrm2;
};

template <class F> __device__ __forceinline__ void phase(const F& f, int nvb, const XcdBarrier& bar) {
    for (int vb = obid(); vb < nvb; vb += gridDim.x) f(vb);
    xcd_barrier(bar);
}
template <class F> __device__ __forceinline__ void run_nb(const F& f, int nvb) { for (int vb = obid(); vb < nvb; vb += gridDim.x) f(vb); }
__device__ __forceinline__ void gemm(const XcdBarrier& bar, const float* A, int lda, const float* B, int ldb, float* C, int ldc, int M, int N, int K, int transB, int causal,
          const int* rowidx = nullptr, const int* panel_e = nullptr, long long strideBe = 0, bool sync = true) {
    GemmF g; g.A = A; g.B = B; g.C = C; g.rowidx = rowidx; g.panel_e = panel_e; g.strideBe = strideBe; g.lda = lda; g.ldb = ldb; g.ldc = ldc; g.M = M; g.N = N; g.K = K;
    g.transB = transB; g.causal = causal; g.tilesN = (N + 127) / 128; g.pad0 = 0;
    run_nb(g, ((M + 127) / 128) * g.tilesN);
    if (sync) xcd_barrier(bar);
}
__device__ __forceinline__ void mgemm_f32(const bf16_t* A, const bf16_t* Bt, float* C, int ldc, int M, int N, int K) {
    pg8::Gemm g{A, Bt, M, N, K}; pg8::StaticOrder S; S.init(M, N, (int)gridDim.x, obid());
    pg8::EpiF32 E{C, ldc};
    pg8::gemm_phase<pg8::EpiF32, pg8::StaticOrder, true, true>((PG8_LAS unsigned char*)g_lds, g, S, E);
}

__device__ __forceinline__ void mgemm_b16(const bf16_t* A, const bf16_t* Bt, bf16_t* C, int ldc, int M, int N, int K) {
    pg8::Gemm g{A, Bt, M, N, K}; pg8::StaticOrder So; So.init(M, N, (int)gridDim.x, obid());
    pg8::EpiB16 E{C, ldc};
    pg8::gemm_phase<pg8::EpiB16, pg8::StaticOrder, true, true>((PG8_LAS unsigned char*)g_lds, g, So, E);
}
__device__ __forceinline__ void mgemm_qkv(const bf16_t* A, const bf16_t* Bt, bf16_t* q, const float* rope, unsigned* nrm2) {
    pg8::Gemm g{A, Bt, NTOK, 6144, D}; pg8::StaticOrder So; So.init(NTOK, 6144, (int)gridDim.x, obid());
    PG8_LAS float* rowsq = (PG8_LAS float*)(g_lds + 131072);
    pg8::EpiQKV E{q, nrm2, rowsq, rope};
    pg8::gemm_phase<pg8::EpiQKV, pg8::StaticOrder, true, true>((PG8_LAS unsigned char*)g_lds, g, So, E);
}

__device__ __forceinline__ void moe_weights(const float* gate, const float* up, const float* down, bf16_t* wgu, bf16_t* wdn) {
    const int tid = otid(), wave = __builtin_amdgcn_readfirstlane(tid >> 6), lane = tid & 63;
    constexpr int IPE = 256;
#define MW_DESC(it_) const int which = (it_) / (32 * IPE), r = (it_) - which * (32 * IPE), e = r / IPE, ii = r - e * IPE; TransF t; \
        if (which == 0) { t.W = gate + (size_t)e * D * 512; t.WT = wgu + (size_t)e * 1024 * D; t.K = D; t.ldw = 512; t.ncols = 512; t.ileave = 1; } \
        else if (which == 1) { t.W = up + (size_t)e * D * 512; t.WT = wgu + (size_t)e * 1024 * D; t.K = D; t.ldw = 512; t.ncols = 512; t.ileave = 2; } \
        else { t.W = down + (size_t)e * 512 * D; t.WT = wdn + (size_t)e * D * 512; t.K = 512; t.ldw = D; t.ncols = D; t.ileave = 0; }
    const int step = gridDim.x * 8, total = 3 * 32 * IPE, it0 = obid() * 8 + wave;
    const int nit = it0 < total ? (total - it0 + step - 1) / step : 0;
    if (nit > 0) {
        const int last = it0 + (nit - 1) * step;
        int it = it0, k = 0;
        float4 va[16], vb[16];
        { MW_DESC(it); t.load(ii, lane, va); }
        for (; k + 1 < nit; k += 2) {
            { MW_DESC(it + step); t.load(ii, lane, vb); }
            __builtin_amdgcn_sched_barrier(0);
            { MW_DESC(it); t.finish(ii, wave, lane, va); }
            __builtin_amdgcn_sched_barrier(0);
            { const int itn = it + 2 * step < last ? it + 2 * step : last; MW_DESC(itn); t.load(ii, lane, va); }
            __builtin_amdgcn_sched_barrier(0);
            { MW_DESC(it + step); t.finish(ii, wave, lane, vb); }
            it += 2 * step;
        }
        if (k < nit) { MW_DESC(it); t.finish(ii, wave, lane, va); }
    }
#undef MW_DESC
}
__device__ __forceinline__ void moe_gemm1(const bf16_t* Hs, const int* rowmap, const bf16_t* wgu, bf16_t* hid, const float* slot_w, const int* panel_e, const int* npan) {
    pg8::Gemm g{Hs, wgu, MAXSLOT, 1024, D}; pg8::MoeOrder So{panel_e, npan[0], 4, (int)gridDim.x, obid()};
    pg8::EpiSwiGLU E{hid, slot_w};
    pg8::gemm_phase_gather<pg8::EpiSwiGLU, pg8::MoeOrder>((PG8_LAS unsigned char*)g_lds, g, rowmap, So, E);
}
__device__ __forceinline__ void moe_gemm2(const bf16_t* hid, const bf16_t* wdn, bf16_t* y2, const int* slot_dst, const int* panel_e, const int* npan) {
    pg8::Gemm g{hid, wdn, MAXSLOT, D, 512}; pg8::MoeOrder So{panel_e, npan[0], 8, (int)gridDim.x, obid()};
    pg8::EpiScatter E{y2, slot_dst};
    pg8::gemm_phase<pg8::EpiScatter, pg8::MoeOrder, true, true>((PG8_LAS unsigned char*)g_lds, g, So, E);
}

template <int LAYER> __device__ __forceinline__ void attn_conv_phase(const AttnArgs& a, const float* gate, const float* up, const float* down, bf16_t* wgu, bf16_t* wdn) {
    constexpr int TOTAL = (LAYER == 0 ? 128 : 64) * 8;
    const int bid = obid(), G = gridDim.x, n = bid < TOTAL ? (TOTAL - bid + G - 1) / G : 0, cls = bid % 3, split = cls == 0 ? 0 : (cls == 1 ? n / 2 : n);
    FoxPair fp; fp.probA = fp.probB = fp.x = 0; fp.paired = false;
    if (LAYER == 1) fp = fox_pairing(a);
    attn_stream<LAYER>(a, fp, 0, split);
    __syncthreads();
    moe_weights(gate, up, down, wgu, wdn);
    __syncthreads();
    attn_stream<LAYER>(a, fp, split, n);
}

typedef const __attribute__((address_space(4))) Params* KParamsPtr;
__device__ __forceinline__ KParamsPtr kp() { KParamsPtr q = (KParamsPtr)__builtin_amdgcn_kernarg_segment_ptr(); asm volatile("" : "+s"(q)); return q; }
__global__ void __launch_bounds__(NTHR, 2) fwd_kernel(Params p_arg) {
#define p (*kp())
    for (int u = threadIdx.x; u < (LDS_BYTES - LDSCTL_OFF) / 4; u += NTHR) ((LAS unsigned*)(g_lds + LDSCTL_OFF))[u] = 0u;
    __syncthreads();
    const XcdBarrier bar = xcd_barrier_post(p.bar, (volatile LAS unsigned*)(g_lds + LDSCTL_OFF + 64));

    { ModF f; f.c = p.c; f.w0 = p.mix_mod_w; f.w1 = p.ffn_mod_w; f.modp = p.modp; run_nb(f, 768); }
    __syncthreads();
    { RopeTableF f; f.tab = p.ropet; run_nb(f, S * 64 / NTHR); }
    { SmallWF f; f.wg = p.moe_wg; f.wr = p.moe_wr; f.bwin = p.b_w_in; f.rhi = p.rhi; f.rlo = p.rlo; f.fhi = p.fhi; f.flo = p.flo; run_nb(f, (2 * 48 * D + 16 * D) / NTHR); }
    { LamF f; f.q1 = p.a_lq1; f.k1 = p.a_lk1; f.q2 = p.a_lq2; f.k2 = p.a_lk2; f.lam = p.lam; if (obid() == gridDim.x - 1) f(0); }
    { TransF t; t.W = p.a_w_in; t.WT = p.wt_in[0]; t.K = D; t.ldw = 6144; t.ncols = 6144; t.ileave = 3; t.run(); }
    { TransF t; t.W = p.b_w_in; t.WT = p.wt_in[1]; t.K = D; t.ldw = 6160; t.ncols = 6144; t.ileave = 0; t.run(); }
    { TransF t; t.W = p.a_w_out; t.WT = p.wt_out[0]; t.K = D; t.ldw = D; t.ncols = D; t.ileave = 0; t.run(); }
    { TransF t; t.W = p.b_w_out; t.WT = p.wt_out[1]; t.K = D; t.ldw = D; t.ncols = D; t.ileave = 0; t.run(); }
    xcd_barrier(bar);
    { ModRedF f; f.modp = p.modp; f.b0 = p.mix_mod_b; f.b1 = p.ffn_mod_b; f.out = p.modv; run_nb(f, 4 * NB * 3 * D / NTHR); }
    { Mod0F f; f.x = p.x; f.modp = p.modp; f.bias = p.mix_mod_b; f.hb = p.hb; f.run(); }
    xcd_barrier(bar);
    const float scale = 0.08838834764831845f;

    const float* xin = p.x;
#pragma unroll 1
    for (int layer = 0; layer < 2; ++layer) {
        const float* modm = p.modv + (size_t)(2 * layer) * NB * 3 * D; const float* modf = p.modv + (size_t)(2 * layer + 1) * NB * 3 * D;
        if (layer == 1) { CumBF f; f.flog = p.flog; f.fb = p.b_fb; f.bz = p.bz; run_nb(f, NB * 16); __syncthreads(); }
        mgemm_qkv(p.hb, p.wt_in[layer], p.qh, layer == 0 ? p.ropet : nullptr, layer == 1 ? p.nrm2 : nullptr);
        xcd_barrier(bar);
        AttnArgs aa; aa.q = p.qh; aa.k = p.kh; aa.v = p.vh; aa.o0 = layer == 0 ? p.o1 : p.ob; aa.o1 = p.o2; aa.bz = p.bz; aa.nrm2 = p.nrm2;
        if (layer == 0) {
            attn_conv_phase<0>(aa, p.moe_gate, p.moe_up, p.moe_down, p.wgu, p.wdn);
            xcd_barrier(bar);
            { CombineF f; f.o1 = p.o1; f.o2 = p.o2; f.lam = p.lam; f.w = p.a_subln; f.ob = p.ob; f.run(NTOK * 8 / 8 / 4); xcd_barrier(bar); }
        } else {
            attn_conv_phase<1>(aa, p.moe_gate + (size_t)32 * D * 512, p.moe_up + (size_t)32 * D * 512, p.moe_down + (size_t)32 * 512 * D, p.wgu1, p.wdn1);
            xcd_barrier(bar);
        }
        { InitF f; f.cnt = p.cnt; f.slot_token = p.slot_token; f.panel_e = p.panel_e; f.nrm2 = layer == 0 ? p.nrm2 : nullptr; run_nb(f, MAXSLOT / NTHR); }
        mgemm_b16(p.ob, p.wt_out[layer], p.yb16, D, NTOK, D, D);
        xcd_barrier(bar);
#define ROWF0_ARGS f.y = p.yb16; f.yb = nullptr; f.modg = modm; f.g = p.mix_ln_g + (size_t)layer * D; f.bta = p.mix_ln_b + (size_t)layer * D; f.out = nullptr; f.outb = p.xAb; \
          f.modn = modf; f.hb = p.hb; f.whi = p.rhi + (size_t)layer * 48 * D; f.wlo = p.rlo + (size_t)layer * 48 * D; \
          f.bg = p.moe_bg + layer * 4; f.br = p.moe_br + layer * 32; f.wgcnt = p.wgcnt; f.tok_e = p.tok_e; f.tok_pos = p.tok_pos; f.tok_w = p.tok_w; f.flog = nullptr
        if (layer == 0) { RowF<0, false> f; f.x = p.x; f.xb = nullptr; ROWF0_ARGS; f.run(NTOK / 16); }
        else { RowF<0, true> f; f.x = nullptr; f.xb = p.xBb; ROWF0_ARGS; f.run(NTOK / 16); }
#undef ROWF0_ARGS
        xcd_barrier(bar);
        { ScatF f; f.wgcnt = p.wgcnt; f.tok_e = p.tok_e; f.tok_pos = p.tok_pos; f.tok_w = p.tok_w; f.slot_token = p.slot_token; f.slot_w = p.slot_w; f.panel_e = p.panel_e; f.npan = p.npan;
          phase(f, (2 * NTOK + 32 * 256) / NTHR, bar); }
        moe_gemm1(p.hb, p.slot_token, layer == 0 ? p.wgu : p.wgu1, p.hid, p.slot_w, p.panel_e, p.npan);
        xcd_barrier(bar);
        moe_gemm2(p.hid, layer == 0 ? p.wdn : p.wdn1, p.y2b, p.slot_token, p.panel_e, p.npan);
        xcd_barrier(bar);
        if (layer == 0) {
            RowF<1, true> f; f.x = nullptr; f.xb = p.xAb; f.y = nullptr; f.yb = p.y2b; f.modg = modf; f.g = p.ffn_ln_g; f.bta = p.ffn_ln_b; f.out = nullptr; f.outb = p.xBb;
            f.modn = p.modv + (size_t)2 * NB * 3 * D; f.hb = p.hb; f.whi = p.fhi; f.wlo = p.flo;
            f.bg = nullptr; f.br = nullptr; f.wgcnt = nullptr; f.tok_e = nullptr; f.tok_pos = nullptr; f.tok_w = nullptr; f.flog = p.flog;
            f.run(NTOK / 16);
        } else {
            RowF<2, true> f; f.x = nullptr; f.xb = p.xAb; f.outb = nullptr; f.y = nullptr; f.yb = p.y2b; f.modg = modf; f.g = p.ffn_ln_g + (size_t)layer * D; f.bta = p.ffn_ln_b + (size_t)layer * D; f.out = p.out;
            f.modn = nullptr; f.hb = nullptr; f.whi = nullptr; f.wlo = nullptr; f.bg = nullptr; f.br = nullptr; f.wgcnt = nullptr; f.tok_e = nullptr; f.tok_pos = nullptr; f.tok_w = nullptr; f.flog = nullptr;
            f.run(NTOK / 16);
        }
        if (layer == 0) xcd_barrier(bar);
        xin = p.xB;
    }
#undef p
}
}

extern "C" void kernel_launch(void* const* d_in, const int* in_sizes, int n_in, void* d_out, int out_size, void* d_ws, size_t ws_size, hipStream_t stream) {
    (void)in_sizes; (void)out_size;
    if (n_in != 27) { fprintf(stderr, "kernel_launch: expected 27 inputs, got %d\n", n_in); return; }
    Params p; memset(&p, 0, sizeof(p));
    p.x = (const float*)d_in[0]; p.c = (const float*)d_in[1];
    p.mix_mod_w = (const float*)d_in[2]; p.mix_mod_b = (const float*)d_in[3]; p.mix_ln_g = (const float*)d_in[4]; p.mix_ln_b = (const float*)d_in[5];
    p.a_w_in = (const float*)d_in[6]; p.a_lq1 = (const float*)d_in[7]; p.a_lk1 = (const float*)d_in[8]; p.a_lq2 = (const float*)d_in[9]; p.a_lk2 = (const float*)d_in[10];
    p.a_subln = (const float*)d_in[11]; p.a_w_out = (const float*)d_in[12];
    p.b_w_in = (const float*)d_in[13]; p.b_fb = (const float*)d_in[14]; p.b_w_out = (const float*)d_in[15];
    p.ffn_mod_w = (const float*)d_in[16]; p.ffn_mod_b = (const float*)d_in[17]; p.ffn_ln_g = (const float*)d_in[18]; p.ffn_ln_b = (const float*)d_in[19];
    p.moe_wg = (const float*)d_in[20]; p.moe_bg = (const float*)d_in[21]; p.moe_wr = (const float*)d_in[22]; p.moe_br = (const float*)d_in[23];
    p.moe_gate = (const float*)d_in[24]; p.moe_up = (const float*)d_in[25]; p.moe_down = (const float*)d_in[26];
    p.out = (float*)d_out;

    size_t off = 0; float* ws = (float*)d_ws;
    auto take = [&](size_t n) { float* q = ws + off; off += (n + 63) & ~(size_t)63; return q; };
    p.bar = (unsigned*)take(XCD_BAR_WORDS);
    p.modv = take((size_t)4 * NB * 3 * D); p.modp = take((size_t)16 * 4 * NB * 3 * D);
    p.ropet = take((size_t)S * 64 * 2);
    p.lam = take(64);
    p.cum = take((size_t)16 * S); p.flog = take((size_t)NTOK * 16); p.bz = take((size_t)NB * 16 * S);
    p.cnt = (int*)take(64); p.wgcnt = (int*)take(256 * 32); p.nrm2 = (unsigned*)take(512);
    p.tok_e = (int*)take(2 * NTOK); p.tok_pos = (int*)take(2 * NTOK); p.tok_w = take(2 * NTOK); p.tok_slot = (int*)take(2 * NTOK);
    p.slot_token = (int*)take(MAXSLOT); p.slot_w = take(MAXSLOT); p.panel_e = (int*)take(256);
    p.wt_in[0] = (bf16_t*)take((size_t)6144 * D / 2); p.wt_in[1] = (bf16_t*)take((size_t)6144 * D / 2);
    p.wt_out[0] = (bf16_t*)take((size_t)D * D / 2); p.wt_out[1] = (bf16_t*)take((size_t)D * D / 2);
    p.hb = (bf16_t*)take((size_t)NTOK * D / 2); p.ob = (bf16_t*)take((size_t)NTOK * D / 2);
    p.xA = nullptr; p.xB = nullptr; p.xAb = (bf16_t*)take((size_t)NTOK * D / 2); p.xBb = (bf16_t*)take((size_t)NTOK * D / 2); p.yb16 = (bf16_t*)take((size_t)NTOK * D / 2);
    p.rhi = (bf16_t*)take((size_t)2 * 48 * D / 2); p.rlo = (bf16_t*)take((size_t)2 * 48 * D / 2); p.fhi = (bf16_t*)take((size_t)16 * D / 2); p.flo = (bf16_t*)take((size_t)16 * D / 2);
    p.wgu = (bf16_t*)take((size_t)32 * 1024 * D / 2); p.wdn = (bf16_t*)take((size_t)32 * D * 512 / 2);
    p.wgu1 = (bf16_t*)take((size_t)32 * 1024 * D / 2); p.wdn1 = (bf16_t*)take((size_t)32 * D * 512 / 2); p.npan = (int*)take(64);
    float* region = ws + off;
    p.qh = (bf16_t*)take((size_t)NTOK * D / 2); p.kh = (bf16_t*)take((size_t)NTOK * D / 2); p.vh = (bf16_t*)take((size_t)NTOK * D / 2);
    p.o1 = (bf16_t*)take((size_t)NTOK * D / 2); p.o2 = (bf16_t*)take((size_t)NTOK * D / 2);
    take((size_t)3 << 20);
    p.Hs = (bf16_t*)region; p.hid = p.Hs + (size_t)MAXSLOT * D; p.y2b = p.hid + (size_t)MAXSLOT * 512;
    if (off * sizeof(float) > ws_size) { fprintf(stderr, "kernel_launch: workspace too small (%zu > %zu)\n", off * sizeof(float), ws_size); return; }

    static int grid = 0;
    if (!grid) { int dev = 0, cus = 0; (void)hipGetDevice(&dev);
        if (hipDeviceGetAttribute(&cus, hipDeviceAttributeMultiprocessorCount, dev) != hipSuccess || cus <= 0) cus = 256;
        if (hipFuncSetAttribute((const void*)fwd_kernel, hipFuncAttributeMaxDynamicSharedMemorySize, LDS_BYTES) != hipSuccess) fprintf(stderr, "kernel_launch: hipFuncSetAttribute failed\n");
        grid = cus; }
    (void)hipMemsetAsync(p.bar, 0, XCD_BAR_WORDS * sizeof(unsigned), stream);
    hipLaunchKernelGGL(fwd_kernel, dim3(grid), dim3(NTHR), LDS_BYTES, stream, p);
}
```

```cpp
#include <hip/hip_runtime.h>
#include <cstdio>
#include <cstdint>
#include <cmath>
#include <cstring>

namespace pg8 {
#define PG8_LAS __attribute__((address_space(3)))
typedef unsigned short bf16_t;
typedef short bf16x8 __attribute__((ext_vector_type(8)));
typedef float f32x4 __attribute__((ext_vector_type(4)));
typedef unsigned u32x4 __attribute__((ext_vector_type(4)));
constexpr int BM = 256, BK = 64, HALF = 128, HTB = HALF * BK * 2  , STAGE_BYTES = 8 * HTB, NXCD = 8, WGM = 8;

__host__ __device__ __forceinline__ int lds_byte(int r, int c) { const int st = (r >> 4) * 2 + (c >> 5), rr = r & 15, cc = c & 31, ob = rr * 64 + cc * 2; return st * 1024 + (ob ^ (((ob >> 9) & 1) << 5)); }
__host__ __device__ __forceinline__ void stage_rc(int b, int& R, int& C) { const int st = b / 1024, sb = b % 1024, swz = sb ^ (((sb >> 9) & 1) << 5); R = (st >> 1) * 16 + swz / 64; C = (st & 1) * 32 + (swz % 64) / 2; }
__host__ __device__ __forceinline__ int perm32(int rho) { const int n = rho >> 4, i = rho & 15; return 8 * (i >> 2) + 4 * n + (i & 3); }

struct Unit { int pm, pn; };
struct Gemm { const bf16_t* A; const bf16_t* Bt; int M, N, K; };

struct StaticOrder {
    int nM, nN, nwg, G, c;
    __host__ __device__ void init(int M, int N, int G_, int c_) { nM = M / BM; nN = N / BM; nwg = nM * nN; G = G_; c = c_; }
    __host__ __device__ bool next(int i, Unit& u) const {
        const long L = (long)i * G + c; if (L >= nwg) return false;
        int wgid = (int)L; { const int q = nwg / NXCD, r = nwg % NXCD, xcd = wgid % NXCD, off = wgid / NXCD; wgid = (xcd < r ? xcd * (q + 1) : r * (q + 1) + (xcd - r) * q) + off; }
        const int nig = WGM * nN, gid = wgid / nig, fm = gid * WGM, gsz = (nM - fm) < WGM ? (nM - fm) : WGM;
        u.pm = fm + ((wgid % nig) % gsz); u.pn = (wgid % nig) / gsz; return true;
    }
    __device__ __forceinline__ void a_ready(const Unit&) const {}
    __device__ __forceinline__ void done(const Unit&) const {}
};

__device__ __forceinline__ unsigned cvt_pk_bf16(float lo, float hi) { unsigned r; asm volatile("v_cvt_pk_bf16_f32 %0, %1, %2" : "=v"(r) : "v"(lo), "v"(hi)); return r; }
typedef float f32x2 __attribute__((ext_vector_type(2)));

struct EpiF32 {
    static constexpr bool PERM = false, AFTER_DRAIN = false;
    float* C; int ldc;
    __device__ __forceinline__ void operator()(const f32x4 (&acc)[2][2][4][2], const Unit& u, int wr, int wc, int fr, int fq) const {
        const int col0 = u.pn * BM + wc * 32 + 4 * fq;
#pragma unroll
        for (int ai = 0; ai < 2; ++ai)
#pragma unroll
            for (int m = 0; m < 4; ++m) { float* rowp = C + (size_t)(u.pm * BM + ai * HALF + wr * 64 + m * 16 + fr) * ldc + col0;
#pragma unroll
                for (int bj = 0; bj < 2; ++bj)
#pragma unroll
                    for (int n = 0; n < 2; ++n) *(f32x4*)(rowp + bj * HALF + n * 16) = acc[ai][bj][m][n]; }
    }
};


struct EpiB16 {
    static constexpr bool PERM = true, AFTER_DRAIN = false;
    bf16_t* C; int ldc;
    __device__ __forceinline__ void operator()(const f32x4 (&acc)[2][2][4][2], const Unit& u, int wr, int wc, int fr, int fq) const {
        const int col0 = u.pn * BM + wc * 32 + 8 * fq;
#pragma unroll
        for (int ai = 0; ai < 2; ++ai)
#pragma unroll
            for (int m = 0; m < 4; ++m) { bf16_t* rowp = C + (size_t)(u.pm * BM + ai * HALF + wr * 64 + m * 16 + fr) * ldc + col0;
#pragma unroll
                for (int bj = 0; bj < 2; ++bj) { const f32x4 v0 = acc[ai][bj][m][0], v1 = acc[ai][bj][m][1];
                    u32x4 w; w.x = cvt_pk_bf16(v0[0], v0[1]); w.y = cvt_pk_bf16(v0[2], v0[3]); w.z = cvt_pk_bf16(v1[0], v1[1]); w.w = cvt_pk_bf16(v1[2], v1[3]);
                    *(u32x4*)(rowp + bj * HALF) = w; } }
    }
};

struct EpiQKV {
    static constexpr bool PERM = true, AFTER_DRAIN = false;
    bf16_t* qkv;
    unsigned* nrm2;
    PG8_LAS float* rowsq;
    const float* rope;
    __device__ __forceinline__ void operator()(const f32x4 (&acc)[2][2][4][2], const Unit& u, int wr, int wc, int fr, int fq) const {
        if (rope && u.pn < 16) {
            const int slot = 2 * u.pn + (wc >> 1), type = slot >> 4, head = slot & 15, i0 = (wc & 1) * 32 + 8 * fq;
            bf16_t* base = qkv + (size_t)type * ((size_t)16384 * 2048);
            f32x4 cn[4];
            { const int row0 = u.pm * BM + wr * 64 + fr, sq0 = row0 & 4095; const f32x4* cs0 = (const f32x4*)(rope + ((size_t)sq0 * 64 + i0) * 2);
#pragma unroll
              for (int q = 0; q < 4; ++q) cn[q] = cs0[q]; }
#pragma unroll
            for (int r = 0; r < 8; ++r) { const int ai = r >> 2, m = r & 3;
                const int row = u.pm * BM + ai * HALF + wr * 64 + m * 16 + fr, b = row >> 12, sq = row & 4095;
                const f32x4 c0 = cn[0], c1 = cn[1], c2 = cn[2], c3 = cn[3];
                if (r + 1 < 8) { const int rn = r + 1, rown = u.pm * BM + (rn >> 2) * HALF + wr * 64 + (rn & 3) * 16 + fr, sqn = rown & 4095; const f32x4* csn = (const f32x4*)(rope + ((size_t)sqn * 64 + i0) * 2);
#pragma unroll
                    for (int q = 0; q < 4; ++q) cn[q] = csn[q]; }
                __builtin_amdgcn_sched_barrier(0);
                float o1[8], o2[8];
#pragma unroll
                for (int n = 0; n < 2; ++n) { const f32x4 x1 = acc[ai][0][m][n], x2 = acc[ai][1][m][n], ca = n == 0 ? c0 : c2, cb = n == 0 ? c1 : c3;
                    o1[4 * n + 0] = x1[0] * ca[0] - x2[0] * ca[1]; o2[4 * n + 0] = x2[0] * ca[0] + x1[0] * ca[1];
                    o1[4 * n + 1] = x1[1] * ca[2] - x2[1] * ca[3]; o2[4 * n + 1] = x2[1] * ca[2] + x1[1] * ca[3];
                    o1[4 * n + 2] = x1[2] * cb[0] - x2[2] * cb[1]; o2[4 * n + 2] = x2[2] * cb[0] + x1[2] * cb[1];
                    o1[4 * n + 3] = x1[3] * cb[2] - x2[3] * cb[3]; o2[4 * n + 3] = x2[3] * cb[2] + x1[3] * cb[3]; }
                bf16_t* dst = base + ((size_t)(b * 16 + head) * 4096 + sq) * 128 + i0;
                u32x4 w; w.x = cvt_pk_bf16(o1[0], o1[1]); w.y = cvt_pk_bf16(o1[2], o1[3]); w.z = cvt_pk_bf16(o1[4], o1[5]); w.w = cvt_pk_bf16(o1[6], o1[7]);
                *(u32x4*)dst = w;
                w.x = cvt_pk_bf16(o2[0], o2[1]); w.y = cvt_pk_bf16(o2[2], o2[3]); w.z = cvt_pk_bf16(o2[4], o2[5]); w.w = cvt_pk_bf16(o2[6], o2[7]);
                *(u32x4*)(dst + 64) = w;
                __builtin_amdgcn_sched_barrier(0); }
            return;
        }
        const int d = wc * 32 + 8 * fq;
        if (nrm2 && u.pn < 16) {
#pragma unroll
            for (int bj = 0; bj < 2; ++bj)
#pragma unroll
                for (int ai = 0; ai < 2; ++ai)
#pragma unroll
                    for (int m = 0; m < 4; ++m) { const f32x4 v0 = acc[ai][bj][m][0], v1 = acc[ai][bj][m][1];
                        float sq = (v0[0] * v0[0] + v0[1] * v0[1]) + (v0[2] * v0[2] + v0[3] * v0[3]) + (v1[0] * v1[0] + v1[1] * v1[1]) + (v1[2] * v1[2] + v1[3] * v1[3]);
                        { const auto r = __builtin_amdgcn_permlane16_swap(__float_as_uint(sq), __float_as_uint(sq), false, false); sq = __uint_as_float(r[0]) + __uint_as_float(r[1]); }
                        { const auto r = __builtin_amdgcn_permlane32_swap(__float_as_uint(sq), __float_as_uint(sq), false, false); sq = __uint_as_float(r[0]) + __uint_as_float(r[1]); }
                        if (fq == 0) rowsq[(wc * 2 + bj) * 256 + ai * HALF + wr * 64 + m * 16 + fr] = sq; }
            asm volatile("s_waitcnt lgkmcnt(0)" ::: "memory"); __builtin_amdgcn_s_barrier();
            { const int t = (wr * 4 + wc) * 64 + fq * 16 + fr;
              float mx = (rowsq[t] + rowsq[512 + t]) + (rowsq[1024 + t] + rowsq[1536 + t]);
              mx = fmaxf(mx, __shfl_xor(mx, 1)); mx = fmaxf(mx, __shfl_xor(mx, 2)); mx = fmaxf(mx, __shfl_xor(mx, 4)); mx = fmaxf(mx, __shfl_xor(mx, 8)); mx = fmaxf(mx, __shfl_xor(mx, 16)); mx = fmaxf(mx, __shfl_xor(mx, 32));
              const int slot = 2 * u.pn + (wr), type = slot >> 4, head = slot & 15, b = (u.pm * BM) >> 12;
              if (fr == 0 && fq == 0) atomicMax(nrm2 + type * 64 + b * 16 + head, __float_as_uint(mx)); }
        }
#pragma unroll
        for (int bj = 0; bj < 2; ++bj) { const int slot = 2 * u.pn + bj, type = slot >> 4, head = slot & 15; bf16_t* base = qkv + (size_t)type * ((size_t)16384 * 2048);
#pragma unroll
            for (int ai = 0; ai < 2; ++ai)
#pragma unroll
                for (int m = 0; m < 4; ++m) { const int row = u.pm * BM + ai * HALF + wr * 64 + m * 16 + fr, b = row >> 12, sq = row & 4095;
                    const f32x4 v0 = acc[ai][bj][m][0], v1 = acc[ai][bj][m][1];
                    u32x4 w; w.x = cvt_pk_bf16(v0[0], v0[1]); w.y = cvt_pk_bf16(v0[2], v0[3]); w.z = cvt_pk_bf16(v1[0], v1[1]); w.w = cvt_pk_bf16(v1[2], v1[3]);
                    *(u32x4*)(base + ((size_t)(b * 16 + head) * 4096 + sq) * 128 + d) = w; } }
    }
};

struct EpiSwiGLU {
    static constexpr bool PERM = true, AFTER_DRAIN = false;
    bf16_t* hid; const float* slot_w;
    __device__ __forceinline__ void operator()(const f32x4 (&acc)[2][2][4][2], const Unit& u, int wr, int wc, int fr, int fq) const {
        const int col = (u.pn & 3) * 128 + wc * 32 + 8 * fq;
        float wv[2][4];
#pragma unroll
        for (int ai = 0; ai < 2; ++ai)
#pragma unroll
            for (int m = 0; m < 4; ++m) wv[ai][m] = slot_w[u.pm * BM + ai * HALF + wr * 64 + m * 16 + fr];
        __builtin_amdgcn_sched_barrier(0);
#pragma unroll
        for (int ai = 0; ai < 2; ++ai)
#pragma unroll
            for (int m = 0; m < 4; ++m) { const int row = u.pm * BM + ai * HALF + wr * 64 + m * 16 + fr; const float w = wv[ai][m];
                float o[8];
#pragma unroll
                for (int n = 0; n < 2; ++n)
#pragma unroll
                    for (int i = 0; i < 4; ++i) { const float g = acc[ai][0][m][n][i], up = acc[ai][1][m][n][i];
                        o[4 * n + i] = g * __builtin_amdgcn_rcpf(1.f + __expf(-g)) * up * w; }
                u32x4 q; q.x = cvt_pk_bf16(o[0], o[1]); q.y = cvt_pk_bf16(o[2], o[3]); q.z = cvt_pk_bf16(o[4], o[5]); q.w = cvt_pk_bf16(o[6], o[7]);
                *(u32x4*)(hid + (size_t)row * 512 + col) = q; }
    }
};
struct EpiScatter {
    static constexpr bool PERM = true, AFTER_DRAIN = false;
    bf16_t* y2; const int* slot_dst;
    __device__ __forceinline__ void operator()(const f32x4 (&acc)[2][2][4][2], const Unit& u, int wr, int wc, int fr, int fq) const {
        const int col = (u.pn & 7) * 256 + wc * 32 + 8 * fq;
        int dv[2][4];
#pragma unroll
        for (int ai = 0; ai < 2; ++ai)
#pragma unroll
            for (int m = 0; m < 4; ++m) dv[ai][m] = slot_dst[u.pm * BM + ai * HALF + wr * 64 + m * 16 + fr];
        __builtin_amdgcn_sched_barrier(0);
#pragma unroll
        for (int ai = 0; ai < 2; ++ai)
#pragma unroll
            for (int m = 0; m < 4; ++m) { const int dst = dv[ai][m];
                if (dst >= 0) {
#pragma unroll
                    for (int bj = 0; bj < 2; ++bj) { const f32x4 v0 = acc[ai][bj][m][0], v1 = acc[ai][bj][m][1];
                        u32x4 q; q.x = cvt_pk_bf16(v0[0], v0[1]); q.y = cvt_pk_bf16(v0[2], v0[3]); q.z = cvt_pk_bf16(v1[0], v1[1]); q.w = cvt_pk_bf16(v1[2], v1[3]);
                        *(u32x4*)(y2 + (size_t)dst * 2048 + col + bj * HALF) = q; } } }
    }
};
struct MoeOrder {
    const int* panel_e; int npan, NJ, G, c;
    __device__ __forceinline__ bool next(int i, Unit& u) const {
        int pm, j;
        if ((G & 7) == 0) { const int xc = c & 7, p0 = (xc * npan) >> 3, p1 = ((xc + 1) * npan) >> 3, idx = (c >> 3) + (G >> 3) * i; if (idx >= (p1 - p0) * NJ) return false; pm = p0 + idx / NJ; j = idx - (idx / NJ) * NJ; }
        else { const int L = i * G + c; if (L >= npan * NJ) return false; pm = L / NJ; j = L - pm * NJ; }
        u.pm = pm; u.pn = panel_e[pm] * NJ + j; return true; }
    __device__ __forceinline__ void a_ready(const Unit&) const {}
    __device__ __forceinline__ void done(const Unit&) const {}
};

template <class Epi, class Sched, bool ALIGN_EPI = false, bool SP2 = false>
__device__ __forceinline__ void gemm_phase(PG8_LAS unsigned char* lds, const Gemm g, const Sched& S, const Epi& E) {
    int tid_ = threadIdx.x; asm volatile("" : "+v"(tid_));
    const int tid = tid_, wid = __builtin_amdgcn_readfirstlane(tid >> 6), lane = tid & 63, wr = wid >> 2, wc = wid & 3, fr = lane & 15, fq = lane >> 4;
    const int K = g.K, nt = K / BK;
    unsigned voffA[2], voffB[2];
#pragma unroll
    for (int i = 0; i < 2; ++i) { int R, C; stage_rc(tid * 16 + i * 8192, R, C); const int Rb = Epi::PERM ? ((R & ~31) + perm32(R & 31)) : R;
        voffA[i] = (unsigned)(R * K + C) * 2u; voffB[i] = (unsigned)(Rb * K + C) * 2u; }
    const size_t kstep = (size_t)(BK * 2);
    const size_t hstep = (size_t)HALF * K * 2;
    const size_t tstep = 2 * hstep;
    const unsigned ldsw = (unsigned)wid * 1024u;
    const int aoff = lds_byte(wr * 64 + fr, fq * 8), boff = lds_byte(wc * 32 + fr, fq * 8);
#define PG8_SA(b, h) (((b) * 2 + (h)) * HTB)
#define PG8_SB(b, h) ((4 + (b) * 2 + (h)) * HTB)
#define PG8_STAGE(bufoff, gbase, voff) do { _Pragma("unroll") for (int _i = 0; _i < 2; ++_i) \
        __builtin_amdgcn_global_load_lds((const unsigned*)((const char*)(gbase) + (voff)[_i]), (PG8_LAS unsigned*)(lds + (bufoff) + ldsw + _i * 8192), 16, 0, 0); } while (0)
#define PG8_LDA(dst, b, h) do { _Pragma("unroll") for (int m = 0; m < 4; ++m) _Pragma("unroll") for (int k = 0; k < 2; ++k) dst[m][k] = *(const PG8_LAS bf16x8*)(lds + PG8_SA(b, h) + aoff + m * 2048 + k * 1024); } while (0)
#define PG8_LDB(dst, b, h) do { _Pragma("unroll") for (int n = 0; n < 2; ++n) _Pragma("unroll") for (int k = 0; k < 2; ++k) dst[n][k] = *(const PG8_LAS bf16x8*)(lds + PG8_SB(b, h) + boff + n * 2048 + k * 1024); } while (0)
#define PG8_MMA(ai, bj, At, Bt) do { __builtin_amdgcn_s_setprio(1); _Pragma("unroll") for (int m = 0; m < 4; ++m) _Pragma("unroll") for (int n = 0; n < 2; ++n) _Pragma("unroll") for (int k = 0; k < 2; ++k) \
        acc[ai][bj][m][n] = __builtin_amdgcn_mfma_f32_16x16x32_bf16(Bt[n][k], At[m][k], acc[ai][bj][m][n], 0, 0, 0); __builtin_amdgcn_s_setprio(0); } while (0)
#define PG8_WAIT_V(n) asm volatile("s_waitcnt vmcnt(" #n ")" ::: "memory")
#define PG8_WAIT_L(n) asm volatile("s_waitcnt lgkmcnt(" #n ")" ::: "memory")
#define PG8_BAR __builtin_amdgcn_s_barrier()
#define PG8_SCHED __builtin_amdgcn_sched_barrier(0)
    Unit cur, nxt; int ui = 0;
    if (!S.next(0, cur)) return;
    f32x4 acc[2][2][4][2];
#pragma unroll
    for (int a = 0; a < 2; ++a)
#pragma unroll
        for (int b = 0; b < 2; ++b)
#pragma unroll
            for (int m = 0; m < 4; ++m)
#pragma unroll
                for (int n = 0; n < 2; ++n) acc[a][b][m][n] = (f32x4){0.f, 0.f, 0.f, 0.f};
    bf16x8 At[4][2], B0[2][2], B1[2][2];
    const char* cA = (const char*)g.A + (size_t)cur.pm * tstep; const char* cB = (const char*)g.Bt + (size_t)cur.pn * tstep;
    S.a_ready(cur);
    if constexpr (SP2) {
        PG8_STAGE(PG8_SB(0, 0), cB, voffB); PG8_STAGE(PG8_SB(0, 1), cB + hstep, voffB); PG8_STAGE(PG8_SA(0, 0), cA, voffA); PG8_STAGE(PG8_SA(0, 1), cA + hstep, voffA);
        if (wr == 1) PG8_BAR;
        PG8_WAIT_V(2); PG8_BAR;
        PG8_STAGE(PG8_SB(1, 0), cB + kstep, voffB); PG8_STAGE(PG8_SA(1, 0), cA + kstep, voffA); PG8_STAGE(PG8_SB(1, 1), cB + hstep + kstep, voffB);
        PG8_WAIT_V(6); PG8_BAR;
    } else {
        PG8_STAGE(PG8_SB(0, 0), cB, voffB); PG8_STAGE(PG8_SA(0, 0), cA, voffA); PG8_STAGE(PG8_SB(0, 1), cB + hstep, voffB); PG8_STAGE(PG8_SA(0, 1), cA + hstep, voffA);
        if (wr == 1) PG8_BAR;
        PG8_WAIT_V(4); PG8_BAR;
        PG8_STAGE(PG8_SB(1, 0), cB + kstep, voffB); PG8_STAGE(PG8_SA(1, 0), cA + kstep, voffA); PG8_STAGE(PG8_SB(1, 1), cB + hstep + kstep, voffB);
        PG8_WAIT_V(6); PG8_BAR;
    }
    for (;;) {
        const bool has_next = S.next(ui + 1, nxt);
        const char* nA = has_next ? (const char*)g.A + (size_t)nxt.pm * tstep : cA; const char* nB = has_next ? (const char*)g.Bt + (size_t)nxt.pn * tstep : cB;
        for (int t = 0; t < nt; t += 2) {
            const bool last = (t == nt - 2);
            const char* a1 = cA + (size_t)(t + 1) * kstep;
            const char* a2 = last ? nA : cA + (size_t)(t + 2) * kstep; const char* b2 = last ? nB : cB + (size_t)(t + 2) * kstep;
            const char* a3 = a2 + kstep; const char* b3 = b2 + kstep;
            if (last && has_next) S.a_ready(nxt);
            if constexpr (SP2) {
            PG8_LDB(B0, 0, 0); PG8_LDB(B1, 0, 1); PG8_SCHED; PG8_LDA(At, 0, 0); PG8_STAGE(PG8_SA(1, 1), a1 + hstep, voffA);
            PG8_WAIT_V(8); PG8_WAIT_L(0); PG8_BAR; PG8_MMA(0, 0, At, B0); PG8_MMA(0, 1, At, B1); PG8_BAR; PG8_SCHED;
            PG8_LDA(At, 0, 1); PG8_STAGE(PG8_SB(0, 0), b2, voffB); PG8_STAGE(PG8_SB(0, 1), b2 + hstep, voffB); PG8_STAGE(PG8_SA(0, 0), a2, voffA);
            PG8_WAIT_V(8); PG8_WAIT_L(0); PG8_BAR; PG8_MMA(1, 0, At, B0); PG8_MMA(1, 1, At, B1); PG8_BAR; PG8_SCHED;
            PG8_LDB(B0, 1, 0); PG8_LDB(B1, 1, 1); PG8_SCHED; PG8_LDA(At, 1, 0); PG8_STAGE(PG8_SA(0, 1), a2 + hstep, voffA);
            PG8_WAIT_V(8); PG8_WAIT_L(0); PG8_BAR; PG8_MMA(0, 0, At, B0); PG8_MMA(0, 1, At, B1); PG8_BAR; PG8_SCHED;
            PG8_LDA(At, 1, 1); PG8_STAGE(PG8_SB(1, 0), b3, voffB); PG8_STAGE(PG8_SB(1, 1), b3 + hstep, voffB); PG8_STAGE(PG8_SA(1, 0), a3, voffA);
            PG8_WAIT_V(8); PG8_WAIT_L(0); PG8_BAR; PG8_MMA(1, 0, At, B0); PG8_MMA(1, 1, At, B1); PG8_BAR; PG8_SCHED;
            } else {
            PG8_LDB(B0, 0, 0); PG8_SCHED; PG8_LDA(At, 0, 0); PG8_STAGE(PG8_SA(1, 1), a1 + hstep, voffA);
            PG8_WAIT_L(8); PG8_BAR; PG8_WAIT_L(0); PG8_MMA(0, 0, At, B0); PG8_BAR; PG8_SCHED;
            PG8_LDB(B1, 0, 1); PG8_STAGE(PG8_SB(0, 0), b2, voffB);
            PG8_BAR; PG8_WAIT_L(0); PG8_MMA(0, 1, At, B1); PG8_BAR;
            PG8_LDA(At, 0, 1); PG8_STAGE(PG8_SA(0, 0), a2, voffA);
            PG8_BAR; PG8_WAIT_L(0); PG8_MMA(1, 0, At, B0); PG8_BAR; PG8_SCHED;
            PG8_STAGE(PG8_SB(0, 1), b2 + hstep, voffB);
            PG8_WAIT_V(6); PG8_BAR; PG8_MMA(1, 1, At, B1); PG8_BAR;
            PG8_LDB(B0, 1, 0); PG8_SCHED; PG8_LDA(At, 1, 0); PG8_STAGE(PG8_SA(0, 1), a2 + hstep, voffA);
            PG8_WAIT_L(8); PG8_BAR; PG8_WAIT_L(0); PG8_MMA(0, 0, At, B0); PG8_BAR; PG8_SCHED;
            PG8_LDB(B1, 1, 1); PG8_STAGE(PG8_SB(1, 0), b3, voffB);
            PG8_BAR; PG8_WAIT_L(0); PG8_MMA(0, 1, At, B1); PG8_BAR;
            PG8_LDA(At, 1, 1); PG8_STAGE(PG8_SA(1, 0), a3, voffA);
            PG8_BAR; PG8_WAIT_L(0); PG8_MMA(1, 0, At, B0); PG8_BAR; PG8_SCHED;
            PG8_STAGE(PG8_SB(1, 1), b3 + hstep, voffB);
            PG8_WAIT_V(6); PG8_BAR; PG8_MMA(1, 1, At, B1); PG8_BAR;
            }
        }
        if constexpr (ALIGN_EPI) { if (wr == 0) PG8_BAR; }
        if constexpr (!Epi::AFTER_DRAIN) { E(acc, cur, wr, wc, fr, fq); S.done(cur); }
        if (!has_next) break;
#pragma unroll
        for (int a = 0; a < 2; ++a)
#pragma unroll
            for (int b = 0; b < 2; ++b)
#pragma unroll
                for (int m = 0; m < 4; ++m)
#pragma unroll
                    for (int n = 0; n < 2; ++n) acc[a][b][m][n] = (f32x4){0.f, 0.f, 0.f, 0.f};
        cur = nxt; cA = nA; cB = nB; ++ui;
        if constexpr (ALIGN_EPI) { if (wr == 1) PG8_BAR; }
    }
    PG8_WAIT_V(0);
    if constexpr (!ALIGN_EPI) { if (wr == 0) PG8_BAR; }
    PG8_BAR;
    if constexpr (Epi::AFTER_DRAIN) { E.fused(acc, cur, wr, wc, fr, fq, lds, wid, lane); S.done(cur); }
#undef PG8_SA
#undef PG8_SB
#undef PG8_STAGE
#undef PG8_LDA
#undef PG8_LDB
#undef PG8_MMA
#undef PG8_WAIT_V
#undef PG8_WAIT_L
#undef PG8_BAR
#undef PG8_SCHED
}
template <class Epi, class Sched>
__device__ __forceinline__ void gemm_phase_gather(PG8_LAS unsigned char* lds, const Gemm g, const int* rowmap, const Sched& S, const Epi& E) {
    constexpr bool ALIGN_EPI = true, SP2 = true;
    int tid_ = threadIdx.x; asm volatile("" : "+v"(tid_));
    const int tid = tid_, wid = __builtin_amdgcn_readfirstlane(tid >> 6), lane = tid & 63, wr = wid >> 2, wc = wid & 3, fr = lane & 15, fq = lane >> 4;
    const int K = g.K, nt = K / BK;
    unsigned voffA[2], voffB[2]; int rowA[2];
#pragma unroll
    for (int i = 0; i < 2; ++i) { int R, C; stage_rc(tid * 16 + i * 8192, R, C); const int Rb = Epi::PERM ? ((R & ~31) + perm32(R & 31)) : R;
        voffA[i] = (unsigned)C * 2u; voffB[i] = (unsigned)(Rb * K + C) * 2u; rowA[i] = R; }
    const size_t kstep = (size_t)(BK * 2);
    const size_t hstep = (size_t)HALF * K * 2;
    const size_t tstep = 2 * hstep;
    const unsigned ldsw = (unsigned)wid * 1024u;
    const int aoff = lds_byte(wr * 64 + fr, fq * 8), boff = lds_byte(wc * 32 + fr, fq * 8);
#define PG8_SA(b, h) (((b) * 2 + (h)) * HTB)
#define PG8_SB(b, h) ((4 + (b) * 2 + (h)) * HTB)
#define PG8_STAGE(bufoff, gbase, voff) do { _Pragma("unroll") for (int _i = 0; _i < 2; ++_i) \
        __builtin_amdgcn_global_load_lds((const unsigned*)((const char*)(gbase) + (voff)[_i]), (PG8_LAS unsigned*)(lds + (bufoff) + ldsw + _i * 8192), 16, 0, 0); } while (0)
#define PG8_LDA(dst, b, h) do { _Pragma("unroll") for (int m = 0; m < 4; ++m) _Pragma("unroll") for (int k = 0; k < 2; ++k) dst[m][k] = *(const PG8_LAS bf16x8*)(lds + PG8_SA(b, h) + aoff + m * 2048 + k * 1024); } while (0)
#define PG8_LDB(dst, b, h) do { _Pragma("unroll") for (int n = 0; n < 2; ++n) _Pragma("unroll") for (int k = 0; k < 2; ++k) dst[n][k] = *(const PG8_LAS bf16x8*)(lds + PG8_SB(b, h) + boff + n * 2048 + k * 1024); } while (0)
#define PG8_MMA(ai, bj, At, Bt) do { __builtin_amdgcn_s_setprio(1); _Pragma("unroll") for (int m = 0; m < 4; ++m) _Pragma("unroll") for (int n = 0; n < 2; ++n) _Pragma("unroll") for (int k = 0; k < 2; ++k) \
        acc[ai][bj][m][n] = __builtin_amdgcn_mfma_f32_16x16x32_bf16(Bt[n][k], At[m][k], acc[ai][bj][m][n], 0, 0, 0); __builtin_amdgcn_s_setprio(0); } while (0)
#define PG8_WAIT_V(n) asm volatile("s_waitcnt vmcnt(" #n ")" ::: "memory")
#define PG8_WAIT_L(n) asm volatile("s_waitcnt lgkmcnt(" #n ")" ::: "memory")
#define PG8_BAR __builtin_amdgcn_s_barrier()
#define PG8_SCHED __builtin_amdgcn_sched_barrier(0)
    Unit cur, nxt; int ui = 0;
    if (!S.next(0, cur)) return;
    unsigned cA0[2], cA1[2], nA0[2], nA1[2];
#define PG8_ROWS(pm_, o0, o1) do { _Pragma("unroll") for (int _i = 0; _i < 2; ++_i) { const int s0_ = rowmap[(pm_) * BM + rowA[_i]], s1_ = rowmap[(pm_) * BM + HALF + rowA[_i]]; \
        o0[_i] = (unsigned)((s0_ < 0 ? 0 : (s0_ >> 1)) * K) * 2u + voffA[_i]; o1[_i] = (unsigned)((s1_ < 0 ? 0 : (s1_ >> 1)) * K) * 2u + voffA[_i]; } } while (0)
    PG8_ROWS(cur.pm, cA0, cA1);
    f32x4 acc[2][2][4][2];
#pragma unroll
    for (int a = 0; a < 2; ++a)
#pragma unroll
        for (int b = 0; b < 2; ++b)
#pragma unroll
            for (int m = 0; m < 4; ++m)
#pragma unroll
                for (int n = 0; n < 2; ++n) acc[a][b][m][n] = (f32x4){0.f, 0.f, 0.f, 0.f};
    bf16x8 At[4][2], B0[2][2], B1[2][2];
    const char* const Ab = (const char*)g.A; const char* cB = (const char*)g.Bt + (size_t)cur.pn * tstep;
    S.a_ready(cur);
    if constexpr (SP2) {
        PG8_STAGE(PG8_SB(0, 0), cB, voffB); PG8_STAGE(PG8_SB(0, 1), cB + hstep, voffB); PG8_STAGE(PG8_SA(0, 0), Ab, cA0); PG8_STAGE(PG8_SA(0, 1), Ab, cA1);
        if (wr == 1) PG8_BAR;
        PG8_WAIT_V(2); PG8_BAR;
        PG8_STAGE(PG8_SB(1, 0), cB + kstep, voffB); PG8_STAGE(PG8_SA(1, 0), Ab + kstep, cA0); PG8_STAGE(PG8_SB(1, 1), cB + hstep + kstep, voffB);
        PG8_WAIT_V(6); PG8_BAR;
    } else {
        static_assert(SP2, "gather variant: SP2 schedule only");
    }
    for (;;) {
        const bool has_next = S.next(ui + 1, nxt);
        const char* nB = has_next ? (const char*)g.Bt + (size_t)nxt.pn * tstep : cB;
        if (has_next) PG8_ROWS(nxt.pm, nA0, nA1); else { nA0[0] = cA0[0]; nA0[1] = cA0[1]; nA1[0] = cA1[0]; nA1[1] = cA1[1]; }
        for (int t = 0; t < nt; t += 2) {
            const bool last = (t == nt - 2);
            const char* a1 = Ab + (size_t)(t + 1) * kstep;
            const char* a2 = last ? Ab : Ab + (size_t)(t + 2) * kstep; const char* b2 = last ? nB : cB + (size_t)(t + 2) * kstep;
            const char* a3 = a2 + kstep; const char* b3 = b2 + kstep;
            unsigned x0[2], x1[2];
            x0[0] = last ? nA0[0] : cA0[0]; x0[1] = last ? nA0[1] : cA0[1]; x1[0] = last ? nA1[0] : cA1[0]; x1[1] = last ? nA1[1] : cA1[1];
            if (last && has_next) S.a_ready(nxt);
            if constexpr (SP2) {
            PG8_LDB(B0, 0, 0); PG8_LDB(B1, 0, 1); PG8_SCHED; PG8_LDA(At, 0, 0); PG8_STAGE(PG8_SA(1, 1), a1, cA1);
            PG8_WAIT_V(8); PG8_WAIT_L(0); PG8_BAR; PG8_MMA(0, 0, At, B0); PG8_MMA(0, 1, At, B1); PG8_BAR; PG8_SCHED;
            PG8_LDA(At, 0, 1); PG8_STAGE(PG8_SB(0, 0), b2, voffB); PG8_STAGE(PG8_SB(0, 1), b2 + hstep, voffB); PG8_STAGE(PG8_SA(0, 0), a2, x0);
            PG8_WAIT_V(8); PG8_WAIT_L(0); PG8_BAR; PG8_MMA(1, 0, At, B0); PG8_MMA(1, 1, At, B1); PG8_BAR; PG8_SCHED;
            PG8_LDB(B0, 1, 0); PG8_LDB(B1, 1, 1); PG8_SCHED; PG8_LDA(At, 1, 0); PG8_STAGE(PG8_SA(0, 1), a2, x1);
            PG8_WAIT_V(8); PG8_WAIT_L(0); PG8_BAR; PG8_MMA(0, 0, At, B0); PG8_MMA(0, 1, At, B1); PG8_BAR; PG8_SCHED;
            PG8_LDA(At, 1, 1); PG8_STAGE(PG8_SB(1, 0), b3, voffB); PG8_STAGE(PG8_SB(1, 1), b3 + hstep, voffB); PG8_STAGE(PG8_SA(1, 0), a3, x0);
            PG8_WAIT_V(8); PG8_WAIT_L(0); PG8_BAR; PG8_MMA(1, 0, At, B0); PG8_MMA(1, 1, At, B1); PG8_BAR; PG8_SCHED;
            }
        }
        if constexpr (ALIGN_EPI) { if (wr == 0) PG8_BAR; }
        if constexpr (!Epi::AFTER_DRAIN) { E(acc, cur, wr, wc, fr, fq); S.done(cur); }
        if (!has_next) break;
#pragma unroll
        for (int a = 0; a < 2; ++a)
#pragma unroll
            for (int b = 0; b < 2; ++b)
#pragma unroll
                for (int m = 0; m < 4; ++m)
#pragma unroll
                    for (int n = 0; n < 2; ++n) acc[a][b][m][n] = (f32x4){0.f, 0.f, 0.f, 0.f};
        cur = nxt; cB = nB; ++ui; cA0[0] = nA0[0]; cA0[1] = nA0[1]; cA1[0] = nA1[0]; cA1[1] = nA1[1];
        if constexpr (ALIGN_EPI) { if (wr == 1) PG8_BAR; }
    }
    PG8_WAIT_V(0);
    if constexpr (!ALIGN_EPI) { if (wr == 0) PG8_BAR; }
    PG8_BAR;
    if constexpr (Epi::AFTER_DRAIN) { E.fused(acc, cur, wr, wc, fr, fq, lds, wid, lane); S.done(cur); }
#undef PG8_SA
#undef PG8_SB
#undef PG8_STAGE
#undef PG8_LDA
#undef PG8_LDB
#undef PG8_MMA
#undef PG8_WAIT_V
#undef PG8_WAIT_L
#undef PG8_BAR
#undef PG8_SCHED
#undef PG8_ROWS
}
}

#include <hip/hip_bf16.h>
namespace swa {
constexpr int D = 128; constexpr float THR = 8.f; constexpr bool WSKIP = false;
constexpr float SCALE = 0.08838834764831845f;
constexpr int NW = 8, QBLK = 32, KVBLK = 64, QB = NW * QBLK;
constexpr int SHM_V = KVBLK * D * 2, SHM_K = KVBLK * D * 2;
constexpr int SWA_LDS_BYTES = 2 * SHM_V + 2 * SHM_K + NW * 64 * 4;
constexpr int BZ_OFF = 69632;

using bf16 = __hip_bfloat16;
typedef short bf16x8 __attribute__((ext_vector_type(8)));
typedef short s16x4 __attribute__((ext_vector_type(4)));
typedef float f32x16 __attribute__((ext_vector_type(16)));
typedef float f32x4 __attribute__((ext_vector_type(4)));
typedef unsigned u32x4 __attribute__((ext_vector_type(4)));
template <class A, class Bt> struct same_t { static constexpr bool v = false; };
template <class A> struct same_t<A, A> { static constexpr bool v = true; };

#define KSWZ(row, colB) ((row) * 256 + ((colB) ^ (((row) & 7) << 4)))
#define SBAR() __builtin_amdgcn_sched_barrier(0)
__device__ __forceinline__ int v_st(int k, int c) { const int kk = (k & ~0xC) | ((k & 4) << 1) | ((k & 8) >> 1); return ((kk >> 3) * 4 + (c >> 5)) * 512 + ((kk & 7) * 32 + (c & 31)) * 2; }
__device__ __forceinline__ int v_rd_base(int lane) { return ((lane & 3) << 3) | (((lane >> 2) & 3) << 6) | (((lane >> 4) & 1) << 5) | (((lane >> 5) & 1) << 8); }
constexpr int v_rd_off(int d0, int ks, int half) { return d0 * 512 + ks * 4096 + half * 2048; }
__device__ __forceinline__ int crow(int r, int hi) { return (r & 3) + 8 * (r >> 2) + 4 * hi; }
__device__ __forceinline__ unsigned cvtpk(float lo, float hi) {
    unsigned r; asm volatile("v_cvt_pk_bf16_f32 %0, %1, %2" : "=v"(r) : "v"(lo), "v"(hi)); return r;
}
__device__ __forceinline__ bf16x8 pack8(f32x4 a, f32x4 b) {
    u32x4 w = {cvtpk(a[0], a[1]), cvtpk(a[2], a[3]), cvtpk(b[0], b[1]), cvtpk(b[2], b[3])};
    return *reinterpret_cast<bf16x8*>(&w);
}
template <class T> __device__ __forceinline__ bf16x8 load8(const T* p) {
    if constexpr (same_t<T, float>::v) { return pack8(*(const f32x4*)p, *(const f32x4*)(p + 4)); }
    else { return *reinterpret_cast<const bf16x8*>(p); }
}
__device__ __forceinline__ void mask_tile(f32x16& p0, f32x16& p1, int dq, unsigned W) {
    const float NEG = -__builtin_inff();
#pragma unroll
    for (int r = 0; r < 16; ++r) {
        const int c = (r & 3) + 8 * (r >> 2);
        if ((unsigned)(dq - c) >= W) p0[r] = NEG;
        if ((unsigned)(dq - c - 32) >= W) p1[r] = NEG;
    }
}
__device__ __forceinline__ void partialSM(f32x16& p0, f32x16& p1, float& m_reg, float& mn, float& alpha) {
    float pmax = p0[0]; for (int r = 1; r < 16; ++r) pmax = fmaxf(pmax, p0[r]); for (int r = 0; r < 16; ++r) pmax = fmaxf(pmax, p1[r]);
    { auto rr = __builtin_amdgcn_permlane32_swap(__float_as_uint(pmax), __float_as_uint(pmax), false, false);
      pmax = fmaxf(__uint_as_float(rr[0]), __uint_as_float(rr[1])); }
    constexpr float C2 = 1.4426950408889634f * SCALE;
    if (__builtin_expect(__all((pmax - m_reg) * SCALE <= THR), 1)) { mn = m_reg; alpha = 1.f; }
    else { mn = fmaxf(m_reg, pmax); alpha = __builtin_amdgcn_exp2f((m_reg - mn) * C2); m_reg = mn; }
    const float mnL = -mn * C2;
    for (int r = 0; r < 16; ++r) p0[r] = fmaf(p0[r], C2, mnL); for (int r = 0; r < 16; ++r) p1[r] = fmaf(p1[r], C2, mnL);
    for (int r = 0; r < 16; ++r) p0[r] = __builtin_amdgcn_exp2f(p0[r]);
}
__device__ __forceinline__ void finishSM(f32x16& p0, f32x16& p1, float alpha, float& l_reg, bf16x8& pa0, bf16x8& pa1, bf16x8& pa2, bf16x8& pa3) {
    for (int r = 0; r < 16; ++r) p1[r] = __builtin_amdgcn_exp2f(p1[r]);
    float ps = 0; for (int r = 0; r < 16; ++r) ps += p0[r]; for (int r = 0; r < 16; ++r) ps += p1[r];
    { auto rr = __builtin_amdgcn_permlane32_swap(__float_as_uint(ps), __float_as_uint(ps), false, false);
      ps = __uint_as_float(rr[0]) + __uint_as_float(rr[1]); }
    l_reg = l_reg * alpha + ps;
#define PK4(P, B_, OUT) do { unsigned a0 = cvtpk(P[B_+0], P[B_+1]), a1 = cvtpk(P[B_+2], P[B_+3]);                          \
        unsigned b0 = cvtpk(P[B_+4], P[B_+5]), b1 = cvtpk(P[B_+6], P[B_+7]);                                             \
        auto r0 = __builtin_amdgcn_permlane32_swap(a0, b0, false, false); auto r1 = __builtin_amdgcn_permlane32_swap(a1, b1, false, false); \
        u32x4 w = {r0[0], r1[0], r0[1], r1[1]}; OUT = *reinterpret_cast<bf16x8*>(&w); } while (0)
    PK4(p0, 0, pa0); PK4(p0, 8, pa1); PK4(p1, 0, pa2); PK4(p1, 8, pa3);
#undef PK4
}
template <int KB, bool SK, bool BIAS>
__device__ __forceinline__ void qkt(f32x16& p0, f32x16& p1, const char* K_lds, int r32, int hi, const bf16x8* qr, bool act, const float* bz) {
    if (SK && !act) { const float NEG = -__builtin_inff();
#pragma unroll
        for (int r = 0; r < 16; ++r) { p0[r] = NEG; p1[r] = NEG; } return; }
    if constexpr (BIAS) {
#pragma unroll
        for (int g = 0; g < 4; ++g) { const f32x4 b0 = *(const f32x4*)(bz + 8 * g + 4 * hi), b1 = *(const f32x4*)(bz + 32 + 8 * g + 4 * hi);
#pragma unroll
            for (int i = 0; i < 4; ++i) { p0[4 * g + i] = b0[i]; p1[4 * g + i] = b1[i]; } }
    } else { p0 = f32x16{}; p1 = f32x16{}; }
    const char* kb[4];
#pragma unroll
    for (int dd = 0; dd < 4; ++dd) kb[dd] = K_lds + KB * SHM_K + KSWZ(r32, (dd * 16 + hi * 8) * 2);
#pragma unroll
    for (int d0 = 0; d0 < 8; ++d0) { const char* a = kb[d0 & 3] + (d0 >> 2) * 128;
        bf16x8 b0 = *reinterpret_cast<const bf16x8*>(a);
        bf16x8 b1 = *reinterpret_cast<const bf16x8*>(a + 32 * 256);
        p0 = __builtin_amdgcn_mfma_f32_32x32x16_bf16(b0, qr[d0], p0, 0, 0, 0);
        p1 = __builtin_amdgcn_mfma_f32_32x32x16_bf16(b1, qr[d0], p1, 0, 0, 0); }
}
template <int VB, bool SK>
__device__ __forceinline__ void pv_tile(f32x16* o, int vb0, bf16x8 pa0, bf16x8 pa1, bf16x8 pa2, bf16x8 pa3, bool act) {
    if (SK && !act) return;
#define TRRD(dst, off) asm volatile("ds_read_b64_tr_b16 %0, %1 offset:%2" : "=&v"(dst) : "v"(vb0), "i"(off) : "memory")
#define PV_D0(d0) do { s16x4 l0, l1, l2, l3, h0, h1, h2, h3; constexpr int b_ = VB * SHM_V + v_rd_off(d0, 0, 0);     \
        TRRD(l0, b_); TRRD(h0, b_ + 2048); TRRD(l1, b_ + 4096); TRRD(h1, b_ + 6144); TRRD(l2, b_ + 8192); TRRD(h2, b_ + 10240); TRRD(l3, b_ + 12288); TRRD(h3, b_ + 14336); \
        asm volatile("s_waitcnt lgkmcnt(0)" ::: "memory"); SBAR();                 \
        o[d0] = __builtin_amdgcn_mfma_f32_32x32x16_bf16(pa0, (bf16x8){l0[0], l0[1], l0[2], l0[3], h0[0], h0[1], h0[2], h0[3]}, o[d0], 0, 0, 0);   \
        o[d0] = __builtin_amdgcn_mfma_f32_32x32x16_bf16(pa1, (bf16x8){l1[0], l1[1], l1[2], l1[3], h1[0], h1[1], h1[2], h1[3]}, o[d0], 0, 0, 0);   \
        o[d0] = __builtin_amdgcn_mfma_f32_32x32x16_bf16(pa2, (bf16x8){l2[0], l2[1], l2[2], l2[3], h2[0], h2[1], h2[2], h2[3]}, o[d0], 0, 0, 0);   \
        o[d0] = __builtin_amdgcn_mfma_f32_32x32x16_bf16(pa3, (bf16x8){l3[0], l3[1], l3[2], l3[3], h3[0], h3[1], h3[2], h3[3]}, o[d0], 0, 0, 0); } while (0)
    PV_D0(0); PV_D0(1); PV_D0(2); PV_D0(3);
#undef PV_D0
#undef TRRD
}

template <class TIn, class TOut> struct BlockRef { const TIn* Q; const TIn* K; const TIn* V; TOut* O; const float* Bz; int P0; int JLO; };
template <class TIn> struct Seam {
    bf16x8 qr[8];
    bf16x8 st_v0, st_v1, st_k0, st_k1; f32x4 sf0, sf1, sf2, sf3;
    f32x4 tq[16];
};
__device__ __forceinline__ int swa_jlo(int P0, int W) { const int lowk = P0 - W + 1; return lowk > 0 ? lowk / KVBLK : 0; }
__device__ __forceinline__ int swa_jlo2(int P0, int W, int jlo) { const int j = swa_jlo(P0, W); return j > jlo ? j : jlo; }
#define ROW(p, k0, rr) ((p) + (size_t)((k0) + (rr)) * D + sc)
#define VMW() asm volatile("s_waitcnt vmcnt(0)" ::: "memory")
#define VMWN(n) asm volatile("s_waitcnt vmcnt(%0)" :: "i"(n) : "memory")
#define SLOAD_H(Kp, Vp, k0) do { S.st_v0 = load8<TIn>(ROW(Vp, k0, sr)); S.st_v1 = load8<TIn>(ROW(Vp, k0, 32 + sr));              \
                         S.st_k0 = load8<TIn>(ROW(Kp, k0, sr)); S.st_k1 = load8<TIn>(ROW(Kp, k0, 32 + sr)); } while (0)
#define SWRITE_HK(bf) do { *(bf16x8*)(K_lds + (bf) * SHM_K + kws) = S.st_k0; *(bf16x8*)(K_lds + (bf) * SHM_K + kws + 32 * 256) = S.st_k1; } while (0)
#define SWRITE_HV(bf) do { *(bf16x8*)(V_lds + (bf) * SHM_V + vst0) = S.st_v0; *(bf16x8*)(V_lds + (bf) * SHM_V + vst1) = S.st_v1; } while (0)
#define SWRITE_H(bf) do { SWRITE_HV(bf); SWRITE_HK(bf); } while (0)
#define SLOAD_F(p, k0) do { S.sf0 = *(const f32x4*)ROW(p, k0, sr); S.sf1 = *(const f32x4*)(ROW(p, k0, sr) + 4);                \
                            S.sf2 = *(const f32x4*)ROW(p, k0, 32 + sr); S.sf3 = *(const f32x4*)(ROW(p, k0, 32 + sr) + 4); } while (0)
#define SWRITE_KF(bf) do { *(bf16x8*)(K_lds + (bf) * SHM_K + kws) = pack8(S.sf0, S.sf1); *(bf16x8*)(K_lds + (bf) * SHM_K + kws + 32 * 256) = pack8(S.sf2, S.sf3); } while (0)
#define SWRITE_VF(bf) do { *(bf16x8*)(V_lds + (bf) * SHM_V + vst0) = pack8(S.sf0, S.sf1); *(bf16x8*)(V_lds + (bf) * SHM_V + vst1) = pack8(S.sf2, S.sf3); } while (0)
template <class TIn, class TOut>
__device__ __forceinline__ void causal_swa_prime(const BlockRef<TIn, TOut>& cur, int W, char* lds, Seam<TIn>& S) {
    constexpr bool F32 = same_t<TIn, float>::v;
    int tid_ = threadIdx.x; asm volatile("" : "+v"(tid_)); const int tid = tid_, wid = __builtin_amdgcn_readfirstlane(tid >> 6), lane = tid & 63, r32 = lane & 31, hi = lane >> 5;
    const int sr = tid >> 4, sc = (tid & 15) * 8, kws = KSWZ(sr, sc * 2); char* K_lds = lds + 2 * SHM_V;
    const int kb0 = swa_jlo2(cur.P0, W, cur.JLO) * KVBLK;
    for (int d0 = 0; d0 < 8; ++d0) S.qr[d0] = load8<TIn>(cur.Q + (size_t)(wid * QBLK + r32) * D + d0 * 16 + hi * 8);
    if constexpr (F32) { SLOAD_F((const float*)cur.K, kb0); VMW(); SWRITE_KF(0); SBAR(); SLOAD_F((const float*)cur.V, kb0); }
    else { SLOAD_H(cur.K, cur.V, kb0); VMW(); SWRITE_HK(0); }
    __syncthreads();
}
template <class TIn, class TOut, int OLD, bool BIAS>
__device__ __forceinline__ void causal_swa_block(const BlockRef<TIn, TOut>& cur, const BlockRef<TIn, TOut>& nxt, int skv, int W, char* lds, Seam<TIn>& S) {
    constexpr bool F32 = same_t<TIn, float>::v;
    int tid_ = threadIdx.x; asm volatile("" : "+v"(tid_)); const int tid = tid_, wid = __builtin_amdgcn_readfirstlane(tid >> 6), lane = tid & 63, r32 = lane & 31, hi = lane >> 5;
    const int j_lo = swa_jlo2(cur.P0, W, cur.JLO);
    int j_hi = (cur.P0 + QB - 1) / KVBLK + 1; if (j_hi > skv / KVBLK) j_hi = skv / KVBLK;
    const int NT = j_hi - j_lo;
    const float* bzl = (const float*)(lds + BZ_OFF);
    if constexpr (BIAS) {
        float* bzw = (float*)(lds + BZ_OFF); const int nk = j_hi * KVBLK;
        for (int i = j_lo * KVBLK + tid * 4; i < nk; i += 64 * NW * 4) *(f32x4*)(bzw + i) = *(const f32x4*)(cur.Bz + i);
        __syncthreads();
    }
#define BZP(t) (bzl + KBASE(t))
    const int kbn = swa_jlo2(nxt.P0, W, nxt.JLO) * KVBLK;
    const int qlo = cur.P0 + wid * QBLK, qm = qlo + r32 - 4 * hi;
    char* V_lds = lds; char* K_lds = lds + 2 * SHM_V;
    float* ws = (float*)(lds + 2 * SHM_V + 2 * SHM_K) + wid * 64; float* li_l = ws, * al_l = ws + 32;
    float m_reg = -1e30f, l_reg = 0; f32x16 o[4] = {};
    const int sr = tid >> 4, sc = (tid & 15) * 8, vst0 = v_st(sr, sc), vst1 = v_st(32 + sr, sc), kws = KSWZ(sr, sc * 2);
    const int vb0 = (int)(uintptr_t)V_lds + v_rd_base(lane);
    const TIn* Kh = cur.K; const TIn* Vh = cur.V;
#define RESC(a) do { if (__any((a) < 1.f)) { if (hi == 0) al_l[r32] = (a); asm volatile("s_waitcnt lgkmcnt(0)" ::: "memory");              \
                     for (int d_ = 0; d_ < 4; ++d_) for (int r = 0; r < 16; ++r) o[d_][r] *= al_l[crow(r, hi)]; } } while (0)
#define KBASE(t) ((j_lo + (t)) * KVBLK)
#define ACT(t) (KBASE(t) <= qlo + QBLK - 1 && KBASE(t) + KVBLK - 1 >= qlo - W + 1)
#define MASKT(P0_, P1_, t) do { const int kb_ = KBASE(t); if ((!SK || ACT(t)) && (kb_ + KVBLK - 1 > qlo || kb_ <= qlo + QBLK - 1 - W)) mask_tile(P0_, P1_, qm - kb_, (unsigned)W); } while (0)
    constexpr int NQL = F32 ? 16 : 8;
    constexpr bool SK = WSKIP && !F32;
#define SEAM_K0() do { VMWN(NQL); if constexpr (F32) { SWRITE_KF(0); SBAR(); SLOAD_F((const float*)nxt.V, kbn); } else { SWRITE_HK(0); } SBAR(); } while (0)
    f32x16 pA0, pA1, pB0, pB1; float mnA, mnB, alA, alB; bf16x8 pa0, pa1, pa2, pa3;
    if constexpr (F32) { VMW(); SWRITE_VF(0); SBAR(); } else { SWRITE_HV(0); SBAR(); }
    if (NT > 1) { if constexpr (F32) SLOAD_F((const float*)Kh, KBASE(1)); else SLOAD_H(Kh, Vh, KBASE(1)); }
    SBAR(); qkt<0, SK, BIAS>(pA0, pA1, K_lds, r32, hi, S.qr, ACT(0), BZP(0));
    if constexpr (F32) { if (NT > 1) { VMW(); SWRITE_KF(1); SBAR(); SLOAD_F((const float*)Vh, KBASE(1)); } }
    MASKT(pA0, pA1, 0); partialSM(pA0, pA1, m_reg, mnA, alA);
    if (NT > 1) { VMW(); if constexpr (F32) { SWRITE_VF(1); SBAR(); if (NT > 2) SLOAD_F((const float*)Kh, KBASE(2)); } else SWRITE_H(1); }
    __syncthreads();
#define HALF_STEP(PX0, PX1, mnX, alX, PY0, PY1, alY, t, KB, VB, SB) do {                                                      \
        SBAR(); qkt<KB, SK, BIAS>(PX0, PX1, K_lds, r32, hi, S.qr, ACT(t), BZP(t));                                             \
        finishSM(PY0, PY1, alY, l_reg, pa0, pa1, pa2, pa3); SBAR();                                                           \
        if ((t) + 1 < NT) { if constexpr (F32) { VMW(); SWRITE_KF(SB); SBAR(); SLOAD_F((const float*)Vh, KBASE((t) + 1)); }  \
                            else { SLOAD_H(Kh, Vh, KBASE((t) + 1)); } SBAR(); }                                               \
        pv_tile<VB, SK>(o, vb0, pa0, pa1, pa2, pa3, ACT((t) - 1)); MASKT(PX0, PX1, (t)); partialSM(PX0, PX1, m_reg, mnX, alX);                                        \
        __syncthreads();                                                                                                      \
        if ((t) + 1 < NT) { VMW(); if constexpr (F32) { SWRITE_VF(SB); SBAR(); if ((t) + 2 < NT) SLOAD_F((const float*)Kh, KBASE((t) + 2)); } \
                            else { SWRITE_H(SB); } }                                                                          \
        RESC(alX); __syncthreads(); } while (0)
    for (int t = 1; t + 1 < NT; t += 2) {
        HALF_STEP(pB0, pB1, mnB, alB, pA0, pA1, alA, t, 1, 0, 0);
        HALF_STEP(pA0, pA1, mnA, alA, pB0, pB1, alB, t + 1, 0, 1, 1);
    }
    const bool even = (NT & 1) == 0;
    if (even) { SBAR(); qkt<1, SK, BIAS>(pB0, pB1, K_lds, r32, hi, S.qr, ACT(NT - 1), BZP(NT - 1)); SBAR(); }
#define QROW(e) (nxt.Q + (size_t)(wid * QBLK + r32) * D + ((e) >> 1) * 16 + hi * 8 + ((e) & 1) * 4)
    if constexpr (F32) { SLOAD_F((const float*)nxt.K, kbn); SBAR();
#pragma unroll
        for (int e = 0; e < 8; ++e) S.tq[e] = *(const f32x4*)QROW(e); }
    else { SLOAD_H(nxt.K, nxt.V, kbn); SBAR();
#pragma unroll
        for (int d0 = 0; d0 < 8; ++d0) S.qr[d0] = load8<TIn>(nxt.Q + (size_t)(wid * QBLK + r32) * D + d0 * 16 + hi * 8); }
    SBAR();
    finishSM(pA0, pA1, alA, l_reg, pa0, pa1, pa2, pa3); SBAR();
    if constexpr (F32) {
#pragma unroll
        for (int e = 8; e < 16; ++e) S.tq[e] = *(const f32x4*)QROW(e); SBAR(); }
#undef QROW
    pv_tile<0, SK>(o, vb0, pa0, pa1, pa2, pa3, ACT(even ? NT - 2 : NT - 1));
    if (even) { MASKT(pB0, pB1, NT - 1); partialSM(pB0, pB1, m_reg, mnB, alB); __syncthreads(); RESC(alB);
        finishSM(pB0, pB1, alB, l_reg, pa0, pa1, pa2, pa3); SBAR(); pv_tile<1, SK>(o, vb0, pa0, pa1, pa2, pa3, ACT(NT - 1)); }
    SBAR(); SEAM_K0();
    if (hi == 0) li_l[r32] = l_reg; asm volatile("s_waitcnt lgkmcnt(0)" ::: "memory");
    float rli[16];
#pragma unroll
    for (int r = 0; r < 16; ++r) rli[r] = __builtin_amdgcn_rcpf(li_l[crow(r, hi)]);
    TOut* Ow = cur.O + (size_t)(wid * QBLK) * OLD;
#pragma unroll
    for (int r = 0; r < 16; ++r) { const int orow = crow(r, hi);
#pragma unroll
        for (int d0 = 0; d0 < 4; ++d0) { const float v = o[d0][r] * rli[r];
            if constexpr (same_t<TOut, float>::v) { Ow[(size_t)orow * OLD + d0 * 32 + r32] = v; }
            else { const float vn = __shfl_xor(v, 1);
                   if ((r32 & 1) == 0) *(unsigned*)(Ow + (size_t)orow * OLD + d0 * 32 + r32) = cvtpk(v, vn); } } }
    if constexpr (F32) {
#pragma unroll
        for (int d0 = 0; d0 < 8; ++d0) S.qr[d0] = pack8(S.tq[2 * d0], S.tq[2 * d0 + 1]); }
    __syncthreads();
#undef RESC
#undef KBASE
#undef BZP
#undef ACT
#undef MASKT
#undef SEAM_K0
#undef HALF_STEP
}
#undef ROW
#undef VMW
#undef VMWN
#undef SLOAD_H
#undef SWRITE_HK
#undef SWRITE_HV
#undef SWRITE_H
#undef SLOAD_F
#undef SWRITE_KF
#undef SWRITE_VF
}

namespace {
constexpr int D = 2048, NB = 4, S = 4096, NTOK = NB * S;
constexpr int NTHR = 512;
constexpr int MAXSLOT = 40960;
constexpr int NPANEL = MAXSLOT / 256;
constexpr float LN_EPS = 1e-5f, RMS_EPS = 1e-5f;
constexpr float ALPHA = 1.41421356237309515f;
constexpr float LAM_INIT0 = 0.2f;


#define XB_TMO      128
#define XB_XCNT(j)  (256  + 64 * (j))
#define XB_XSUB(j)  (1280 + 64 * (j))
#define XB_XGEN(j)  (2304 + 64 * (j))
#define XB_TOP      3328
#define XB_TOPGEN   3392
#define XCD_BAR_WORDS 3456
#define XB_SPIN_CAP (1u << 18)
#define LAS __attribute__((address_space(3)))
__device__ __forceinline__ unsigned xb_ld(unsigned* p)              { return __hip_atomic_load(p, __ATOMIC_RELAXED, __HIP_MEMORY_SCOPE_AGENT); }
__device__ __forceinline__ unsigned xb_add(unsigned* p, unsigned v) { return __hip_atomic_fetch_add(p, v, __ATOMIC_RELAXED, __HIP_MEMORY_SCOPE_AGENT); }
__device__ __forceinline__ unsigned xb_xcc_id() { return (unsigned)__builtin_amdgcn_s_getreg((3 << 11) | 20) & 0xFu; }
#define XB_SPIN(cond, bar) do { unsigned _sp = 0; while (cond) { __builtin_amdgcn_s_sleep(1); \
    if ((++_sp & 255u) == 0u) { if (xb_ld(&(bar)[XB_TMO])) break; if (_sp > XB_SPIN_CAP) { atomicAdd(&(bar)[XB_TMO], 1u); break; } } } } while (0)
struct XcdBarrier { unsigned* bar; unsigned x; volatile LAS unsigned* st; };
__device__ __forceinline__ XcdBarrier xcd_barrier_post(unsigned* bar, volatile LAS unsigned* st) {
    XcdBarrier b; b.bar = bar; b.x = (unsigned)__builtin_amdgcn_readfirstlane((int)xb_xcc_id()); b.st = st;
    if (threadIdx.x == 0) (void)xb_add(&bar[XB_XCNT(b.x)], 1u);
    return b;
}
__device__ __forceinline__ void xcd_barrier_complete(unsigned* bar, unsigned x, unsigned& nloc, unsigned& nx) {
    const unsigned G = gridDim.x * gridDim.y * gridDim.z;
    unsigned sum, cnt, mine, sp = 0u;
    for (;;) {
        sum = 0u; cnt = 0u; mine = 0u;
#pragma unroll
        for (unsigned j = 0; j < 16; ++j) { const unsigned c = xb_ld(&bar[XB_XCNT(j)]); sum += c; cnt += (c > 0u) ? 1u : 0u; mine = (j == x) ? c : mine; }
        if (sum == G) break;
        __builtin_amdgcn_s_sleep(1);
        if ((++sp & 255u) == 0u) { if (xb_ld(&bar[XB_TMO])) break; if (sp > XB_SPIN_CAP) { atomicAdd(&bar[XB_TMO], 1u); break; } }
    }
    nloc = mine > 0u ? mine : 1u; nx = cnt > 0u ? cnt : 1u;
}
__device__ __forceinline__ void xcd_barrier(const XcdBarrier& b) {
    asm volatile("s_waitcnt vmcnt(0)" ::: "memory");
    __syncthreads();
    int t0_ = threadIdx.x; asm volatile("" : "+v"(t0_));
    if (t0_ == 0) {
        unsigned* bar = b.bar;
        unsigned bx = b.x; asm volatile("" : "+s"(bx));
        __builtin_amdgcn_s_waitcnt(0);
        unsigned nloc = b.st[0], nx = b.st[1];
        if (nloc == 0u) { xcd_barrier_complete(bar, bx, nloc, nx); b.st[0] = nloc; b.st[1] = nx; }
        const unsigned old = xb_add(&bar[XB_XSUB(bx)], 1u);
        const unsigned gen = old / nloc;
        if (old + 1u == (gen + 1u) * nloc) {
            __builtin_amdgcn_fence(__ATOMIC_RELEASE, "agent");
            asm volatile("s_waitcnt vmcnt(0)" ::: "memory");
            const unsigned og = xb_add(&bar[XB_TOP], 1u);
            const unsigned tg = og / nx;
            if (og + 1u == (tg + 1u) * nx) xb_add(&bar[XB_TOPGEN], 1u);
            else XB_SPIN(xb_ld(&bar[XB_TOPGEN]) == tg, bar);
            __builtin_amdgcn_fence(__ATOMIC_ACQUIRE, "agent");
            xb_add(&bar[XB_XGEN(bx)], 1u);
            asm volatile("s_waitcnt vmcnt(0)" ::: "memory");
        } else {
            XB_SPIN(xb_ld(&bar[XB_XGEN(bx)]) == gen, bar);
            __builtin_amdgcn_fence(__ATOMIC_ACQUIRE, "agent");
            asm volatile("s_waitcnt vmcnt(0)" ::: "memory");
        }
    }
    __syncthreads();
}

__device__ __forceinline__ float wave_sum(float v) {
#pragma unroll
    for (int o = 32; o >= 1; o >>= 1) v += __shfl_xor(v, o);
    return v;
}
__device__ __forceinline__ float wave_max(float v) {
#pragma unroll
    for (int o = 32; o >= 1; o >>= 1) v = fmaxf(v, __shfl_xor(v, o));
    return v;
}

extern __shared__ __attribute__((aligned(16))) unsigned char g_lds[];
constexpr int RING_BYTES = 131072, LDS_BYTES = 147456, LDSCTL_OFF = LDS_BYTES - 256;
__device__ __forceinline__ int obid() { int b = blockIdx.x; asm volatile("" : "+s"(b)); return b; }
__device__ __forceinline__ int otid() { int t = threadIdx.x; asm volatile("" : "+v"(t)); return t; }

struct ModF {
    const float* c; const float* w0; const float* w1; float* modp;
    __device__ __forceinline__ void operator()(int vb) const {
        float (*sc)[128] = (float (*)[128])g_lds;
        const int tid = otid();
        const int kc = vb & 15, nb = (vb >> 4) % 12, set = vb / 192, n = nb * NTHR + tid, k0 = kc * 128;
        const float* W = ((set & 1) ? w1 : w0) + (size_t)(set >> 1) * D * 3 * D + (size_t)k0 * (3 * D) + n;
        __syncthreads();
        { const float v = c[(tid >> 7) * D + k0 + (tid & 127)]; sc[tid >> 7][tid & 127] = v / (1.f + expf(-v)); }
        __syncthreads();
        float a0 = 0.f, a1 = 0.f, a2 = 0.f, a3 = 0.f;
#pragma unroll 16
        for (int k = 0; k < 128; ++k) { const float w = W[(size_t)k * (3 * D)]; a0 += sc[0][k] * w; a1 += sc[1][k] * w; a2 += sc[2][k] * w; a3 += sc[3][k] * w; }
        float* o = modp + ((size_t)(kc * 4 + set) * NB) * 3 * D + n;
        o[0 * 3 * D] = a0; o[1 * 3 * D] = a1; o[2 * 3 * D] = a2; o[3 * 3 * D] = a3;
    }
};
struct ModRedF {
    const float* modp; const float* b0; const float* b1; float* out;
    __device__ __forceinline__ void operator()(int vb) const {
        const int i = vb * NTHR + otid();
        const int n = i % (3 * D), set = i / (NB * 3 * D);
        float a = ((set & 1) ? b1 : b0)[(size_t)(set >> 1) * 3 * D + n];
#pragma unroll
        for (int kc = 0; kc < 16; ++kc) a += modp[(size_t)kc * 4 * NB * 3 * D + i];
        out[i] = a;
    }
};

typedef unsigned short bf16_t;
__device__ __forceinline__ unsigned pkbf(float lo, float hi) { unsigned r; asm volatile("v_cvt_pk_bf16_f32 %0, %1, %2" : "=v"(r) : "v"(lo), "v"(hi)); return r; }
struct ModulateF {
    const float* x; const float* mod; float* h; bf16_t* hb;
    __device__ __forceinline__ void operator()(int vb) const {
        const size_t i4 = (size_t)vb * NTHR + otid();
        const size_t e = i4 * 4; const int t = (int)(e / D), d = (int)(e % D), b = t / S;
        const float4 xv = *(const float4*)(x + e);
        const float4 sh = *(const float4*)(mod + (size_t)b * 3 * D + d);
        const float4 sc = *(const float4*)(mod + (size_t)b * 3 * D + D + d);
        float4 o; o.x = xv.x * (1.f + sc.x) + sh.x; o.y = xv.y * (1.f + sc.y) + sh.y; o.z = xv.z * (1.f + sc.z) + sh.z; o.w = xv.w * (1.f + sc.w) + sh.w;
        if (h) *(float4*)(h + e) = o;
        if (hb) { uint2 w; w.x = pkbf(o.x, o.y); w.y = pkbf(o.z, o.w); *(uint2*)(hb + e) = w; }
    }
};
struct Mod0F {
    const float* x; const float* modp; const float* bias; bf16_t* hb;
    __device__ __forceinline__ void run() const {
        float* sv = (float*)g_lds;
        const int tid = otid(), wave = tid >> 6, lane = tid & 63;
        const int G = gridDim.x, per = G >> 2, bid = obid();
        if (per == 0 || bid >= 4 * per) return;
        const int b = bid / per, r = bid - b * per;
        __syncthreads();
        for (int i = tid; i < 2 * D; i += NTHR) { float a = bias[i];
#pragma unroll
            for (int kc = 0; kc < 16; ++kc) a += modp[((size_t)(kc * 4 + 0) * NB + b) * 3 * D + i];
            sv[i] = a; }
        __syncthreads();
        for (int row = r * 8 + wave; row < S; row += per * 8) { const size_t t = (size_t)b * S + row;
            float4 xv[8];
#pragma unroll
            for (int i = 0; i < 8; ++i) xv[i] = *(const float4*)(x + t * D + (i * 64 + lane) * 4);
#pragma unroll
            for (int i = 0; i < 8; ++i) { const int d = (i * 64 + lane) * 4; const float4 s4 = *(const float4*)(sv + d), c4 = *(const float4*)(sv + D + d);
                uint2 w; w.x = pkbf(xv[i].x * (1.f + c4.x) + s4.x, xv[i].y * (1.f + c4.y) + s4.y); w.y = pkbf(xv[i].z * (1.f + c4.z) + s4.z, xv[i].w * (1.f + c4.w) + s4.w);
                *(uint2*)(hb + t * D + d) = w; } }
        __syncthreads();
    }
};
struct ConvF {
    const float* src; bf16_t* dst;
    __device__ __forceinline__ void operator()(int vb) const {
        const size_t e = ((size_t)vb * NTHR + otid()) * 4;
        const float4 v = *(const float4*)(src + e); uint2 w; w.x = pkbf(v.x, v.y); w.y = pkbf(v.z, v.w); *(uint2*)(dst + e) = w;
    }
};
struct TransF {
    const float* W; bf16_t* WT; int K, ldw, ncols, ileave;
    __device__ __forceinline__ int nitems() const { return (K / 64) * (ncols / 64); }
    __device__ __forceinline__ void load(int it, int lane, float4 (&v)[16]) const {
        const int nblk = ncols / 64, kb = it / nblk, nb = it - kb * nblk, k0 = 64 * kb, n0 = 64 * nb;
        const int n4 = lane & 15, kr = lane >> 4;
        const float* src = W + (size_t)(k0 + kr * 16) * ldw + n0 + 4 * n4;
#pragma unroll
        for (int i = 0; i < 16; ++i) v[i] = *(const float4*)(src + (size_t)i * ldw);
    }
    __device__ __forceinline__ void item(int it, int wave, int lane) const { float4 v[16]; load(it, lane, v); finish(it, wave, lane, v); }
    __device__ __forceinline__ void finish(int it, int wave, int lane, const float4 (&v)[16]) const {
        unsigned char* scr = g_lds + wave * 16384;
        const int nblk = ncols / 64, kb = it / nblk, nb = it - kb * nblk, k0 = 64 * kb, n0 = 64 * nb;
        const int n4 = lane & 15, kr = lane >> 4;
#pragma unroll
        for (int j = 0; j < 4; ++j) { uint4 lo4, hi4;
            const float e0 = j == 0 ? v[0].x : j == 1 ? v[0].y : j == 2 ? v[0].z : v[0].w; (void)e0;
#define TF_EL(i) (j == 0 ? v[i].x : j == 1 ? v[i].y : j == 2 ? v[i].z : v[i].w)
            lo4.x = pkbf(TF_EL(0), TF_EL(1)); lo4.y = pkbf(TF_EL(2), TF_EL(3)); lo4.z = pkbf(TF_EL(4), TF_EL(5)); lo4.w = pkbf(TF_EL(6), TF_EL(7));
            hi4.x = pkbf(TF_EL(8), TF_EL(9)); hi4.y = pkbf(TF_EL(10), TF_EL(11)); hi4.z = pkbf(TF_EL(12), TF_EL(13)); hi4.w = pkbf(TF_EL(14), TF_EL(15));
#undef TF_EL
            unsigned char* d = scr + (4 * n4 + j) * 144 + kr * 32;
            *(uint4*)d = lo4; *(uint4*)(d + 16) = hi4; }
        asm volatile("s_waitcnt lgkmcnt(0)" ::: "memory");
        const int c = lane & 7;
        uint4 ov[8];
#pragma unroll
        for (int j = 0; j < 8; ++j) ov[j] = *(const uint4*)(scr + ((lane >> 3) + 8 * j) * 144 + c * 16);
#pragma unroll
        for (int j = 0; j < 8; ++j) { const int n = (lane >> 3) + 8 * j; const uint4 o = ov[j];
            const int nn = n0 + n;
            const int dr = ileave == 0 ? nn : (ileave == 3 ? (nn < 4096 ? ((nn >> 8) * 256 + ((nn >> 6) & 1) * 128 + ((nn >> 7) & 1) * 64 + (nn & 63)) : nn)
                                                         : ((nn >> 7) * 256 + (ileave - 1) * 128 + (nn & 127)));
            *(uint4*)(WT + (size_t)dr * K + k0 + 8 * c) = o; }
        asm volatile("s_waitcnt lgkmcnt(0)" ::: "memory");
    }
    __device__ __forceinline__ void run() const {
        const int tid = otid(), wave = tid >> 6, lane = tid & 63;
        for (int it = obid() * 8 + wave; it < nitems(); it += gridDim.x * 8) item(it, wave, lane);
    }
};

struct GemmF {
    const float* A; const float* B; float* C;
    const int* rowidx;
    const int* panel_e;
    long long strideBe;
    int lda, ldb, ldc, M, N, K;
    int transB, causal;
    int tilesN, pad0;
    __device__ __forceinline__ void operator()(int vb) const {
        float (*As)[132] = (float (*)[132])g_lds; float (*Bs)[132] = (float (*)[132])(g_lds + 16 * 132 * 4);
        const int tm = vb / tilesN, tn = vb % tilesN, m0 = tm * 128, n0 = tn * 128;
        const float* Bp = B;
        if (panel_e) { const int e = panel_e[m0 >> 8]; if (e < 0) return; Bp += (size_t)e * strideBe; }
        if (causal == 1 && n0 > m0 + 127) return;
        int Kend = K; if (causal == 2 && m0 + 128 < K) Kend = m0 + 128;
        const int tid = otid(), tx = tid & 31, ty = tid >> 5;
        float acc[8][4];
#pragma unroll
        for (int i = 0; i < 8; ++i)
#pragma unroll
            for (int j = 0; j < 4; ++j) acc[i][j] = 0.f;
        const int ar = tid >> 2, ak = (tid & 3) * 4;
        long long arow = m0 + ar; bool aval = arow < M;
        if (rowidx && aval) { const int ri = rowidx[arow]; aval = ri >= 0; arow = ri; }
        const float* Ap = A + (aval ? arow : 0) * (long long)lda + ak;
        int bk, bn; if (!transB) { bk = tid >> 5; bn = (tid & 31) * 4; } else { bn = tid >> 2; bk = (tid & 3) * 4; }
        const bool bval = (n0 + bn) < N;
        for (int k0 = 0; k0 < Kend; k0 += 16) {
            float4 av = make_float4(0.f, 0.f, 0.f, 0.f), bv = make_float4(0.f, 0.f, 0.f, 0.f);
            if (aval) av = *(const float4*)(Ap + k0);
            if (bval) { if (!transB) bv = *(const float4*)(Bp + (size_t)(k0 + bk) * ldb + n0 + bn); else bv = *(const float4*)(Bp + (size_t)(n0 + bn) * ldb + k0 + bk); }
            __syncthreads();
            As[ak + 0][ar] = av.x; As[ak + 1][ar] = av.y; As[ak + 2][ar] = av.z; As[ak + 3][ar] = av.w;
            if (!transB) { *(float4*)&Bs[bk][bn] = bv; } else { Bs[bk + 0][bn] = bv.x; Bs[bk + 1][bn] = bv.y; Bs[bk + 2][bn] = bv.z; Bs[bk + 3][bn] = bv.w; }
            __syncthreads();
#pragma unroll
            for (int kk = 0; kk < 16; ++kk) {
                const float4 a0 = *(const float4*)&As[kk][ty * 8], a1 = *(const float4*)&As[kk][ty * 8 + 4], b = *(const float4*)&Bs[kk][tx * 4];
                const float a[8] = {a0.x, a0.y, a0.z, a0.w, a1.x, a1.y, a1.z, a1.w};
#pragma unroll
                for (int i = 0; i < 8; ++i) { acc[i][0] += a[i] * b.x; acc[i][1] += a[i] * b.y; acc[i][2] += a[i] * b.z; acc[i][3] += a[i] * b.w; }
            }
        }
        const int col = n0 + tx * 4;
        if (col < N) {
#pragma unroll
            for (int i = 0; i < 8; ++i) { const int row = m0 + ty * 8 + i; if (row < M) *(float4*)(C + (size_t)row * ldc + col) = make_float4(acc[i][0], acc[i][1], acc[i][2], acc[i][3]); }
        }
        __syncthreads();
    }
};

struct RopeTab { float inv_freq[64]; };
struct RopeTableF {
    float* tab;
    __device__ __forceinline__ void operator()(int vb) const {
        const int idx = vb * NTHR + otid(); const int s = idx >> 6, i = idx & 63;
        const float inv_freq = (float)exp2(-(double)i * (13.287712379549449 / 64.0));
        const float angf = (float)s * inv_freq;
        double r = (double)angf;
        const double k = rint(r * 0.63661977236758134308);
        r = fma(-k, 1.57079632679489655800e+00, r); r = fma(-k, 6.12323399573676603587e-17, r);
        const int q = ((int)k) & 3;
        const double r2 = r * r;
        double sn = -1.0 / 6227020800.0 * -1.0;
        sn = 1.0 / 6227020800.0;
        sn = sn * r2 - 1.0 / 39916800.0; sn = sn * r2 + 1.0 / 362880.0; sn = sn * r2 - 1.0 / 5040.0; sn = sn * r2 + 1.0 / 120.0; sn = sn * r2 - 1.0 / 6.0; sn = sn * r2 + 1.0; sn = sn * r;
        double cs = -1.0 / 87178291200.0;
        cs = cs * r2 + 1.0 / 479001600.0; cs = cs * r2 - 1.0 / 3628800.0; cs = cs * r2 + 1.0 / 40320.0; cs = cs * r2 - 1.0 / 720.0; cs = cs * r2 + 1.0 / 24.0; cs = cs * r2 - 0.5; cs = cs * r2 + 1.0;
        double c, sv;
        if (q == 0) { c = cs; sv = sn; } else if (q == 1) { c = -sn; sv = cs; } else if (q == 2) { c = -cs; sv = -sn; } else { c = sn; sv = -cs; }
        tab[(size_t)idx * 2] = (float)c; tab[(size_t)idx * 2 + 1] = (float)sv;
    }
};
struct RopeF {
    float* p; const float* tab; int ld, pad0;
    __device__ __forceinline__ void operator()(int vb) const {
        const int idx = vb * NTHR + otid();
        const int i = idx & 63, head = (idx >> 6) & 31, s = idx >> 11;
        float* q = p + (size_t)s * ld + head * 128 + i;
        const float c = tab[((size_t)s * 64 + i) * 2], sn = tab[((size_t)s * 64 + i) * 2 + 1];
        const float x1 = q[0], x2 = q[64];
        q[0] = x1 * c - x2 * sn; q[64] = x2 * c + x1 * sn;
    }
};

struct LamF {
    const float* q1; const float* k1; const float* q2; const float* k2; float* lam;
    __device__ __forceinline__ void operator()(int vb) const {
        const int tid = otid();
        if (tid < 64) {
            float a = q1[tid] * k1[tid] + q1[tid + 64] * k1[tid + 64], b = q2[tid] * k2[tid] + q2[tid + 64] * k2[tid + 64];
            a = wave_sum(a); b = wave_sum(b);
            if (tid == 0) lam[0] = expf(a) - expf(b) + LAM_INIT0;
        }
    }
};

struct SoftmaxF {
    float* S1; float* S2;
    const float* lam; const float* cum;
    float scale; int pad0;
    __device__ __forceinline__ void operator()(int vb) const {
        const int tid = otid(), wave = tid >> 6, lane = tid & 63;
        const int i = vb * 8 + wave;
        float* r1 = S1 + (size_t)i * S; float* r2 = S2 ? S2 + (size_t)i * S : nullptr;
        const float ci = cum ? cum[i] : 0.f;
        float m1 = -INFINITY, m2 = -INFINITY;
        for (int j = lane; j <= i; j += 64) {
            float s = r1[j] * scale; if (cum) s += ci - cum[j]; m1 = fmaxf(m1, s);
            if (r2) m2 = fmaxf(m2, r2[j] * scale);
        }
        m1 = wave_max(m1); m2 = wave_max(m2);
        float l1 = 0.f, l2 = 0.f;
        for (int j = lane; j <= i; j += 64) {
            float s = r1[j] * scale; if (cum) s += ci - cum[j]; l1 += expf(s - m1);
            if (r2) l2 += expf(r2[j] * scale - m2);
        }
        l1 = wave_sum(l1); l2 = wave_sum(l2);
        const float lm = r2 ? lam[0] : 0.f;
        const int jend = ((i >> 7) + 1) << 7;
        for (int j = lane; j < jend; j += 64) {
            float o = 0.f;
            if (j <= i) {
                float s = r1[j] * scale; if (cum) s += ci - cum[j];
                o = expf(s - m1) / l1;
                if (r2) o -= lm * (expf(r2[j] * scale - m2) / l2);
            }
            r1[j] = o;
        }
    }
};

struct RmsF {
    float* o; const float* w; bf16_t* ob;
    __device__ __forceinline__ void operator()(int vb) const {
        const int tid = otid(), wave = tid >> 6, lane = tid & 63;
        const size_t g = (size_t)vb * 8 + wave;
        float4 v = *(float4*)(o + g * 256 + lane * 4);
        float ss = v.x * v.x + v.y * v.y + v.z * v.z + v.w * v.w; ss = wave_sum(ss);
        const float r = 1.0f / sqrtf(ss * (1.f / 256.f) + RMS_EPS) * (1.f - LAM_INIT0);
        const float4 ww = *(const float4*)(w + lane * 4);
        v.x = v.x * r * ww.x; v.y = v.y * r * ww.y; v.z = v.z * r * ww.z; v.w = v.w * r * ww.w;
        *(float4*)(o + g * 256 + lane * 4) = v;
        if (ob) { uint2 q; q.x = pkbf(v.x, v.y); q.y = pkbf(v.z, v.w); *(uint2*)(ob + g * 256 + lane * 4) = q; }
    }
};

struct CumF {
    const float* proj; const float* fb; float* cum; int ld, pad0;
    __device__ __forceinline__ void operator()(int vb) const {
        float* tot = (float*)g_lds;
        const int h = vb, tid = otid();
        float v[8]; float run = 0.f;
#pragma unroll
        for (int j = 0; j < 8; ++j) { const float x = proj[(size_t)(tid * 8 + j) * ld + 6144 + h] + fb[h];
            const float ls = fminf(x, 0.f) - log1pf(expf(-fabsf(x))); run += ls; v[j] = run; }
        __syncthreads();
        tot[tid] = run;
        __syncthreads();
        if (tid == 0) { float a = 0.f; for (int i = 0; i < NTHR; ++i) { const float t = tot[i]; tot[i] = a; a += t; } }
        __syncthreads();
        const float off = tot[tid];
#pragma unroll
        for (int j = 0; j < 8; ++j) cum[(size_t)h * S + tid * 8 + j] = v[j] + off;
        __syncthreads();
    }
};

struct LnF {
    const float* x; const float* ya; const int* tok_slot;
    const bf16_t* yb;
    const float* mod; const float* g; const float* bta; float* out;
    __device__ __forceinline__ void operator()(int vb) const {
        const int tid = otid(), wave = tid >> 6, lane = tid & 63;
        const int t = vb * 8 + wave, b = t / S;
        const float* xr = x + (size_t)t * D; const float* gt = mod + (size_t)b * 3 * D + 2 * D;
        const float* y0; const float* y1 = nullptr;
        if (tok_slot) { y0 = ya + (size_t)tok_slot[2 * t] * D; y1 = ya + (size_t)tok_slot[2 * t + 1] * D; } else y0 = ya + (size_t)t * D;
        if (yb) { y0 = xr; y1 = nullptr; }
        float4 z[8]; float sum = 0.f;
#pragma unroll
        for (int i = 0; i < 8; ++i) { const int d = (i * 64 + lane) * 4;
            const float4 xv = *(const float4*)(xr + d), gv = *(const float4*)(gt + d); float4 yv;
            if (yb) { const uint2 a = *(const uint2*)(yb + (size_t)(2 * t) * D + d), bq = *(const uint2*)(yb + (size_t)(2 * t + 1) * D + d);
                yv.x = __uint_as_float(a.x << 16) + __uint_as_float(bq.x << 16); yv.y = __uint_as_float(a.x & 0xffff0000u) + __uint_as_float(bq.x & 0xffff0000u);
                yv.z = __uint_as_float(a.y << 16) + __uint_as_float(bq.y << 16); yv.w = __uint_as_float(a.y & 0xffff0000u) + __uint_as_float(bq.y & 0xffff0000u); }
            else yv = *(const float4*)(y0 + d);
            if (y1) { const float4 y2 = *(const float4*)(y1 + d); yv.x += y2.x; yv.y += y2.y; yv.z += y2.z; yv.w += y2.w; }
            z[i].x = ALPHA * xv.x + (1.f + gv.x) * yv.x; z[i].y = ALPHA * xv.y + (1.f + gv.y) * yv.y; z[i].z = ALPHA * xv.z + (1.f + gv.z) * yv.z; z[i].w = ALPHA * xv.w + (1.f + gv.w) * yv.w;
            sum += (z[i].x + z[i].y) + (z[i].z + z[i].w); }
        sum = wave_sum(sum); const float mu = sum * (1.f / D);
        float var = 0.f;
#pragma unroll
        for (int i = 0; i < 8; ++i) { const float a = z[i].x - mu, bq = z[i].y - mu, c = z[i].z - mu, dd = z[i].w - mu; var += (a * a + bq * bq) + (c * c + dd * dd); }
        var = wave_sum(var) * (1.f / D);
        const float rs = 1.0f / sqrtf(var + LN_EPS);
#pragma unroll
        for (int i = 0; i < 8; ++i) { const int d = (i * 64 + lane) * 4; const float4 gg = *(const float4*)(g + d), bb = *(const float4*)(bta + d);
            float4 o; o.x = (z[i].x - mu) * rs * gg.x + bb.x; o.y = (z[i].y - mu) * rs * gg.y + bb.y; o.z = (z[i].z - mu) * rs * gg.z + bb.z; o.w = (z[i].w - mu) * rs * gg.w + bb.w;
            *(float4*)(out + (size_t)t * D + d) = o; }
    }
};

__device__ __forceinline__ int rowf_vb(int w, int i, int G, int nvb) { return (G == 256 && nvb == 1024) ? ((w >> 6) * 256 + (w & 63) + 64 * i) : (w + i * G); }
__device__ __forceinline__ int rowf_wg(int vb, int G, int nvb) { return (G == 256 && nvb == 1024) ? ((vb >> 8) * 64 + (vb & 63)) : (vb % G); }
typedef short bf16x8_t __attribute__((ext_vector_type(8)));
typedef _Float16 f16x8_t __attribute__((ext_vector_type(8)));
typedef float f32x4_t __attribute__((ext_vector_type(4)));
template <int MODE, bool XBF> struct RowF {
    const bf16_t* xb; bf16_t* outb;
    const float* x; const bf16_t* y; const bf16_t* yb; const float* modg; const float* g; const float* bta; float* out;
    const float* modn; bf16_t* hb; const bf16_t* whi; const bf16_t* wlo;
    const float* bg; const float* br; int* wgcnt; int* tok_e; int* tok_pos; float* tok_w; float* flog;
    __device__ __forceinline__ void run(int nvb) const {
        constexpr int NCB = MODE == 0 ? 3 : 1, NC = NCB * 16, HS = 2056, LOGIT_BATCHES = MODE == 0 ? 2 : 1;
        _Float16* H = (_Float16*)g_lds; float* P = (float*)(g_lds + 66048); float* Lg = (float*)(g_lds + 90624);
        LAS int* lc = (LAS int*)(g_lds + 93696);
        float* Vg = (float*)(g_lds + 93952); float* Vb = Vg + D; float* Vgate = Vb + D; float* Vsh = Vgate + D; float* Vsc = Vsh + D;
        const int tid = otid(), wave = tid >> 6, lane = tid & 63, G = gridDim.x;
        __syncthreads();
        float* Bs = (float*)(g_lds + 134912);
        if (MODE == 0) { if (tid < 32) lc[tid] = 0; if (tid < 36) Bs[tid] = tid < 4 ? bg[tid] : br[tid - 4]; }
        { const float4 a = *(const float4*)(g + tid * 4), c = *(const float4*)(bta + tid * 4); *(float4*)(Vg + tid * 4) = a; *(float4*)(Vb + tid * 4) = c; }
        int bcur = -1;
        float4 xv[8]; uint2 xq[8], ya[8], yc[8];
#define ROWF_LOAD(t_) do { _Pragma("unroll") for (int i_ = 0; i_ < 8; ++i_) { const int d_ = (i_ * 64 + lane) * 4; \
                    if (XBF) { xq[i_] = *(const uint2*)(xb + (size_t)(t_) * D + d_); xv[i_] = make_float4(0.f, 0.f, 0.f, 0.f); } else { xv[i_] = *(const float4*)(x + (size_t)(t_) * D + d_); xq[i_] = make_uint2(0u, 0u); } \
                    if (MODE != 0) { ya[i_] = *(const uint2*)(yb + (size_t)(2 * (t_)) * D + d_); yc[i_] = *(const uint2*)(yb + (size_t)(2 * (t_) + 1) * D + d_); } \
                    else { ya[i_] = *(const uint2*)(y + (size_t)(t_) * D + d_); yc[i_] = make_uint2(0u, 0u); } } } while (0)
        const bool bmap = G == 256 && nvb == 1024; const int vstep = bmap ? 64 : G, vb0 = rowf_vb(obid(), 0, G, nvb), vend = bmap ? vb0 + 256 : nvb;
        if (vb0 < vend) ROWF_LOAD(vb0 * 16 + wave * 2);
        for (int vb = vb0; vb < vend; vb += vstep) {
            const int b = (vb * 16) / S;
            if (b != bcur) {
                __syncthreads();
                const int tq = otid() * 4;
                { float4 a = *(const float4*)(modg + (size_t)b * 3 * D + 2 * D + tq); a.x += 1.f; a.y += 1.f; a.z += 1.f; a.w += 1.f; *(float4*)(Vgate + tq) = a; }
                if (MODE != 2) { const float4 sh4 = *(const float4*)(modn + (size_t)b * 3 * D + tq); float4 c = *(const float4*)(modn + (size_t)b * 3 * D + D + tq); c.x += 1.f; c.y += 1.f; c.z += 1.f; c.w += 1.f;
                    *(float4*)(Vsh + tq) = sh4; *(float4*)(Vsc + tq) = c; }
                __syncthreads(); bcur = b; }
            const int t0 = vb * 16 + wave * 2;
#pragma unroll
            for (int r = 0; r < 2; ++r) { const int t = t0 + r;
                float4 z[8]; float sum = 0.f;
#pragma unroll
                for (int i = 0; i < 8; ++i) { const int d = (i * 64 + lane) * 4;
                    const float4 gv = *(const float4*)(Vgate + d); float4 yv;
                    yv.x = __uint_as_float(ya[i].x << 16); yv.y = __uint_as_float(ya[i].x & 0xffff0000u); yv.z = __uint_as_float(ya[i].y << 16); yv.w = __uint_as_float(ya[i].y & 0xffff0000u);
                    if (MODE != 0) { yv.x += __uint_as_float(yc[i].x << 16); yv.y += __uint_as_float(yc[i].x & 0xffff0000u); yv.z += __uint_as_float(yc[i].y << 16); yv.w += __uint_as_float(yc[i].y & 0xffff0000u); }
                    float4 xf = xv[i]; if (XBF) { xf.x = __uint_as_float(xq[i].x << 16); xf.y = __uint_as_float(xq[i].x & 0xffff0000u); xf.z = __uint_as_float(xq[i].y << 16); xf.w = __uint_as_float(xq[i].y & 0xffff0000u); }
                    z[i].x = ALPHA * xf.x + gv.x * yv.x; z[i].y = ALPHA * xf.y + gv.y * yv.y; z[i].z = ALPHA * xf.z + gv.z * yv.z; z[i].w = ALPHA * xf.w + gv.w * yv.w;
                    sum += (z[i].x + z[i].y) + (z[i].z + z[i].w); }
                if (r == 0) { __builtin_amdgcn_sched_barrier(0); ROWF_LOAD(t0 + 1); __builtin_amdgcn_sched_barrier(0); }
                else if (vb + vstep < vend) { __builtin_amdgcn_sched_barrier(0); ROWF_LOAD((vb + vstep) * 16 + wave * 2); __builtin_amdgcn_sched_barrier(0); }
                sum = wave_sum(sum); const float mu = sum * (1.f / D);
                float var = 0.f;
#pragma unroll
                for (int i = 0; i < 8; ++i) { const float a = z[i].x - mu, bq = z[i].y - mu, c = z[i].z - mu, dd = z[i].w - mu; var += (a * a + bq * bq) + (c * c + dd * dd); }
                var = wave_sum(var) * (1.f / D);
                const float rs = 1.0f / sqrtf(var + LN_EPS);
#pragma unroll
                for (int i = 0; i < 8; ++i) { const int d = (i * 64 + lane) * 4; const float4 gg = *(const float4*)(Vg + d), bb = *(const float4*)(Vb + d);
                    float4 o; o.x = (z[i].x - mu) * rs * gg.x + bb.x; o.y = (z[i].y - mu) * rs * gg.y + bb.y; o.z = (z[i].z - mu) * rs * gg.z + bb.z; o.w = (z[i].w - mu) * rs * gg.w + bb.w;
                    if (MODE == 2) { *(float4*)(out + (size_t)t * D + d) = o; continue; }
                    { uint2 ow; ow.x = pkbf(o.x, o.y); ow.y = pkbf(o.z, o.w); *(uint2*)(outb + (size_t)t * D + d) = ow; }
                    const float4 s4 = *(const float4*)(Vsh + d), c4 = *(const float4*)(Vsc + d);
                    float4 h; h.x = o.x * c4.x + s4.x; h.y = o.y * c4.y + s4.y; h.z = o.z * c4.z + s4.z; h.w = o.w * c4.w + s4.w;
                    uint2 w; w.x = pkbf(h.x, h.y); w.y = pkbf(h.z, h.w); *(uint2*)(hb + (size_t)t * D + d) = w;
                    typedef _Float16 f16x4_t __attribute__((ext_vector_type(4)));
                    f16x4_t hq; hq[0] = (_Float16)h.x; hq[1] = (_Float16)h.y; hq[2] = (_Float16)h.z; hq[3] = (_Float16)h.w;
                    *(f16x4_t*)(H + (wave * 2 + r) * HS + d) = hq; } }
            if (MODE == 2) continue;
            __syncthreads();
            f32x4_t acc[NCB];
#pragma unroll
            for (int cb = 0; cb < NCB; ++cb) acc[cb] = (f32x4_t){0.f, 0.f, 0.f, 0.f};
            const int row = lane & 15, kg = lane >> 4, col = lane & 15;
            constexpr int KBATCH = 8 / LOGIT_BATCHES;
#pragma unroll
            for (int kq = 0; kq < LOGIT_BATCHES; ++kq) {
                f16x8_t Bw[KBATCH][NCB];
#pragma unroll
                for (int k2 = 0; k2 < KBATCH; ++k2)
#pragma unroll
                    for (int cb = 0; cb < NCB; ++cb) Bw[k2][cb] = *(const f16x8_t*)((const _Float16*)whi + ((size_t)((wave * 8 + kq * KBATCH + k2) * NCB + cb) * 64 + lane) * 8);
                __builtin_amdgcn_sched_barrier(0);
#pragma unroll
                for (int k2 = 0; k2 < KBATCH; ++k2) { const int kb = wave * 256 + (kq * KBATCH + k2) * 32 + kg * 8;
                    const f16x8_t A = *(const f16x8_t*)(H + row * HS + kb);
#pragma unroll
                    for (int cb = 0; cb < NCB; ++cb) acc[cb] = __builtin_amdgcn_mfma_f32_16x16x32_f16(A, Bw[k2][cb], acc[cb], 0, 0, 0); }
                __builtin_amdgcn_sched_barrier(0); }
#pragma unroll
            for (int cb = 0; cb < NCB; ++cb)
#pragma unroll
                for (int i = 0; i < 4; ++i) P[(wave * 16 + 4 * (lane >> 4) + i) * 48 + cb * 16 + col] = acc[cb][i];
            __syncthreads();
            for (int idx = tid; idx < 16 * NC; idx += NTHR) { const int r = idx / NC, c = idx - r * NC; float a = 0.f;
#pragma unroll
                for (int w = 0; w < 8; ++w) a += P[(w * 16 + r) * 48 + c];
                Lg[r * 48 + c] = a; }
            __syncthreads();
#pragma unroll
            for (int r = 0; r < 2; ++r) { const int t = t0 + r; const float* lr = Lg + (wave * 2 + r) * 48;
                if (MODE == 1) { if (lane < 16) flog[(size_t)t * 16 + lane] = lr[lane]; }
                else {
                    float gl[4] = {lr[0] + Bs[0], lr[1] + Bs[1], lr[2] + Bs[2], lr[3] + Bs[3]};
                    int gi = 0; float gm = gl[0];
#pragma unroll
                    for (int c = 1; c < 4; ++c) if (gl[c] > gm) { gm = gl[c]; gi = c; }
                    float gs = 0.f;
#pragma unroll
                    for (int c = 0; c < 4; ++c) gs += expf(gl[c] - gm);
                    const float gw = 1.f / gs;
                    float e[8];
#pragma unroll
                    for (int c = 0; c < 8; ++c) e[c] = lr[4 + gi * 8 + c] + Bs[4 + gi * 8 + c];
                    int i0 = 0; float v0 = e[0];
#pragma unroll
                    for (int c = 1; c < 8; ++c) if (e[c] > v0) { v0 = e[c]; i0 = c; }
                    int i1 = -1; float v1 = -INFINITY;
#pragma unroll
                    for (int c = 0; c < 8; ++c) if (c != i0 && e[c] > v1) { v1 = e[c]; i1 = c; }
                    const float ex = expf(v1 - v0), pa = 1.f / (1.f + ex), pb = ex / (1.f + ex);
                    if (lane == 0) {
                        const int e0 = gi * 8 + i0, e1 = gi * 8 + i1;
                        tok_e[2 * t] = e0; tok_e[2 * t + 1] = e1;
                        tok_w[2 * t] = gw * pa; tok_w[2 * t + 1] = gw * pb;
                        tok_pos[2 * t] = __hip_atomic_fetch_add(lc + e0, 1, __ATOMIC_RELAXED, __HIP_MEMORY_SCOPE_WORKGROUP); tok_pos[2 * t + 1] = __hip_atomic_fetch_add(lc + e1, 1, __ATOMIC_RELAXED, __HIP_MEMORY_SCOPE_WORKGROUP);
                    }
                }
            }
        }
#undef ROWF_LOAD
        if (MODE == 0) { __syncthreads(); const int t2 = otid(); if (t2 < 32) wgcnt[obid() * 32 + t2] = lc[t2]; }
    }
};
struct SmallWF {
    const float* wg; const float* wr; const float* bwin; bf16_t* rhi; bf16_t* rlo; bf16_t* fhi; bf16_t* flo;
    __device__ __forceinline__ void operator()(int vb) const {
        const int i = vb * NTHR + otid();
        float w; bf16_t* ph; bf16_t* pl; int k, col, ncb;
        if (i < 2 * 48 * D) { const int layer = i / (48 * D); k = i % D; col = (i / D) % 48; ncb = 3;
            if (col < 4) w = wg[((size_t)layer * D + k) * 4 + col];
            else if (col < 36) { const int gq = (col - 4) >> 3, e = (col - 4) & 7; w = wr[(((size_t)layer * 4 + gq) * D + k) * 8 + e]; }
            else w = 0.f;
            ph = rhi + (size_t)layer * 48 * D; pl = rlo + (size_t)layer * 48 * D; }
        else { const int j = i - 2 * 48 * D; k = j % D; col = j / D; ncb = 1; w = bwin[(size_t)k * 6160 + 6144 + col]; ph = fhi; pl = flo; }
        const size_t o = ((size_t)((((k >> 8) * 8 + ((k >> 5) & 7)) * ncb + (col >> 4)) * 64 + ((k >> 3) & 3) * 16 + (col & 15))) * 8 + (k & 7);
        (void)pl; ((_Float16*)ph)[o] = (_Float16)w;
    }
};

struct InitF {
    int* cnt; int* slot_token; int* panel_e; unsigned* nrm2;
    __device__ __forceinline__ void operator()(int vb) const {
        const int i = vb * NTHR + otid();
        if (i < 32) cnt[i] = 0;
        if (nrm2 && i < 512) nrm2[i] = 0u;
        if (i < NPANEL) panel_e[i] = -1;
        if (i < MAXSLOT) slot_token[i] = -1;
    }
};
struct RouteF {
    const float* h; const float* wg; const float* bg; const float* wr; const float* br;
    int* cnt; int* tok_e; int* tok_pos; float* tok_w;
    __device__ __forceinline__ void operator()(int vb) const {
        const int tid = otid(), wave = tid >> 6, lane = tid & 63;
        const int t = vb * 8 + wave;
        const float* hr = h + (size_t)t * D;
        float hv[32];
#pragma unroll
        for (int i = 0; i < 32; ++i) hv[i] = hr[lane + 64 * i];
        float p0 = 0.f, p1 = 0.f, p2 = 0.f, p3 = 0.f;
#pragma unroll
        for (int i = 0; i < 32; ++i) { const float4 w = *(const float4*)(wg + (size_t)(lane + 64 * i) * 4); p0 += hv[i] * w.x; p1 += hv[i] * w.y; p2 += hv[i] * w.z; p3 += hv[i] * w.w; }
        float gl[4] = {wave_sum(p0) + bg[0], wave_sum(p1) + bg[1], wave_sum(p2) + bg[2], wave_sum(p3) + bg[3]};
        int gi = 0; float gm = gl[0];
#pragma unroll
        for (int c = 1; c < 4; ++c) if (gl[c] > gm) { gm = gl[c]; gi = c; }
        float gs = 0.f;
#pragma unroll
        for (int c = 0; c < 4; ++c) gs += expf(gl[c] - gm);
        const float gw = 1.f / gs;
        const float* wrg = wr + (size_t)gi * D * 8;
        float e[8];
#pragma unroll
        for (int c = 0; c < 8; ++c) e[c] = 0.f;
#pragma unroll
        for (int i = 0; i < 32; ++i) { const float4 wa = *(const float4*)(wrg + (size_t)(lane + 64 * i) * 8), wb = *(const float4*)(wrg + (size_t)(lane + 64 * i) * 8 + 4);
            e[0] += hv[i] * wa.x; e[1] += hv[i] * wa.y; e[2] += hv[i] * wa.z; e[3] += hv[i] * wa.w; e[4] += hv[i] * wb.x; e[5] += hv[i] * wb.y; e[6] += hv[i] * wb.z; e[7] += hv[i] * wb.w; }
#pragma unroll
        for (int c = 0; c < 8; ++c) e[c] = wave_sum(e[c]) + br[gi * 8 + c];
        int i0 = 0; float v0 = e[0];
#pragma unroll
        for (int c = 1; c < 8; ++c) if (e[c] > v0) { v0 = e[c]; i0 = c; }
        int i1 = -1; float v1 = -INFINITY;
#pragma unroll
        for (int c = 0; c < 8; ++c) if (c != i0 && e[c] > v1) { v1 = e[c]; i1 = c; }
        const float ex = expf(v1 - v0), pa = 1.f / (1.f + ex), pb = ex / (1.f + ex);
        if (lane == 0) {
            const int e0 = gi * 8 + i0, e1 = gi * 8 + i1;
            tok_e[2 * t] = e0; tok_e[2 * t + 1] = e1;
            tok_w[2 * t] = gw * pa; tok_w[2 * t + 1] = gw * pb;
            tok_pos[2 * t] = atomicAdd(cnt + e0, 1); tok_pos[2 * t + 1] = atomicAdd(cnt + e1, 1);
        }
    }
};
struct ScatterF {
    const int* cnt; const int* tok_e; const int* tok_pos; const float* tok_w;
    int* tok_slot; int* slot_token; float* slot_w; int* panel_e; int* npan;
    __device__ __forceinline__ void operator()(int vb) const {
        const int i = vb * NTHR + otid();
        if (i < 2 * NTOK) {
            const int e = tok_e[i]; int off = 0;
            for (int q = 0; q < e; ++q) off += (cnt[q] + 255) & ~255;
            const int slot = off + tok_pos[i];
            tok_slot[i] = slot; slot_token[slot] = i; slot_w[slot] = tok_w[i];
        }
        if (vb == 0 && otid() < 32) {
            const int e = otid(); int off = 0;
            for (int q = 0; q < e; ++q) off += (cnt[q] + 255) & ~255;
            const int np = (cnt[e] + 255) >> 8;
            for (int p = 0; p < np; ++p) panel_e[(off >> 8) + p] = e;
            if (e == 31) npan[0] = (off >> 8) + np;
        }
    }
};
struct GatherF {
    const bf16_t* hb; bf16_t* Hs; const int* slot_token; float* slot_w; const int* npan;
    __device__ __forceinline__ void operator()(int vb) const {
        const int tid = otid(), wave = tid >> 6, lane = tid & 63;
        const int slot = vb * 8 + wave;
        if (slot >= npan[0] * 256) return;
        const int st = slot_token[slot];
        uint4* dst = (uint4*)(Hs + (size_t)slot * D) + lane;
        if (st >= 0) { const uint4* src = (const uint4*)(hb + (size_t)(st >> 1) * D) + lane;
#pragma unroll
            for (int j = 0; j < 4; ++j) dst[64 * j] = src[64 * j]; }
        else { const uint4 z = make_uint4(0u, 0u, 0u, 0u);
#pragma unroll
            for (int j = 0; j < 4; ++j) dst[64 * j] = z;
            if (lane == 0) slot_w[slot] = 0.f; }
    }
};
struct ScatF {
    const int* wgcnt; const int* tok_e; const int* tok_pos; const float* tok_w;
    int* slot_token; float* slot_w; int* panel_e; int* npan;
    __device__ __forceinline__ void operator()(int vb) const {
        int* base = (int*)g_lds;
        int* sego = base + 256 * 32;
        int* tot = sego + 16 * 32;
        int* off = tot + 32;
        const int tid = otid(), G = gridDim.x;
        __syncthreads();
        { const int e = tid & 31, seg = tid >> 5; int run = 0;
#pragma unroll
          for (int j = 0; j < 16; ++j) { const int w = seg * 16 + j; const int c = w < G ? wgcnt[w * 32 + e] : 0; base[w * 32 + e] = run; run += c; }
          sego[seg * 32 + e] = run; }
        __syncthreads();
        if (tid < 32) { int run = 0;
#pragma unroll
            for (int sgi = 0; sgi < 16; ++sgi) { const int c = sego[sgi * 32 + tid]; sego[sgi * 32 + tid] = run; run += c; }
            tot[tid] = run; }
        __syncthreads();
        if (tid == 0) { int run = 0; for (int e = 0; e < 32; ++e) { off[e] = run; run += (tot[e] + 255) & ~255; } }
        __syncthreads();
        const int i = vb * NTHR + tid;
        if (i < 2 * NTOK) {
            const int e = tok_e[i], w = rowf_wg((i >> 1) >> 4, G, NTOK / 16);
            const int slot = off[e] + sego[(w >> 4) * 32 + e] + base[w * 32 + e] + tok_pos[i];
            slot_token[slot] = i; slot_w[slot] = tok_w[i];
        } else if (i < 2 * NTOK + 32 * 256) {
            const int idx = i - 2 * NTOK, e = idx >> 8, r = idx & 255, c = tot[e], npad = ((c + 255) & ~255) - c;
            if (r < npad) slot_w[off[e] + c + r] = 0.f;
        }
        if (vb == 0 && tid < 32) {
            const int e = tid, np = (tot[e] + 255) >> 8;
            for (int q = 0; q < np; ++q) panel_e[(off[e] >> 8) + q] = e;
            if (e == 31) npan[0] = (off[e] >> 8) + np;
        }
        __syncthreads();
    }
};
struct HidF {
    float* a; const float* u; const float* slot_w; const int* slot_token; const int* panel_e;
    __device__ __forceinline__ void operator()(int vb) const {
        const size_t i4 = (size_t)vb * NTHR + otid(); const size_t e = i4 * 4; const int slot = (int)(e / 512);
        if (panel_e[slot >> 8] < 0) return;
        float4 o = make_float4(0.f, 0.f, 0.f, 0.f);
        if (slot_token[slot] >= 0) { const float w = slot_w[slot]; const float4 av = *(const float4*)(a + e), uv = *(const float4*)(u + e);
            o.x = av.x / (1.f + expf(-av.x)) * uv.x * w; o.y = av.y / (1.f + expf(-av.y)) * uv.y * w; o.z = av.z / (1.f + expf(-av.z)) * uv.z * w; o.w = av.w / (1.f + expf(-av.w)) * uv.w * w; }
        *(float4*)(a + e) = o;
    }
};

struct RopeHF {
    bf16_t* q; bf16_t* k; const float* tab;
    __device__ __forceinline__ void operator()(int vb) const {
        const size_t idx = (size_t)vb * NTHR + otid();
        const int i = (int)(idx & 63), s = (int)((idx >> 6) & 4095), bh = (int)((idx >> 18) & 63), which = (int)(idx >> 24);
        bf16_t* pp = (which ? k : q) + ((size_t)bh * S + s) * 128 + i;
        const float c = tab[((size_t)s * 64 + i) * 2], sn = tab[((size_t)s * 64 + i) * 2 + 1];
        const float x1 = __uint_as_float((unsigned)pp[0] << 16), x2 = __uint_as_float((unsigned)pp[64] << 16);
        pp[0] = (bf16_t)(pkbf(x1 * c - x2 * sn, 0.f) & 0xffffu); pp[64] = (bf16_t)(pkbf(x2 * c + x1 * sn, 0.f) & 0xffffu);
    }
};
struct CombineF {
    const bf16_t* o1; const bf16_t* o2; const float* lam; const float* w; bf16_t* ob;
    __device__ __forceinline__ void load(int vb, int wave, int lane, uint2 (&a)[4], uint2 (&bq)[4]) const {
        const size_t g0 = ((size_t)vb * 8 + wave) * 4;
#pragma unroll
        for (int j = 0; j < 4; ++j) { a[j] = *(const uint2*)(o1 + (g0 + j) * 256 + lane * 4); bq[j] = *(const uint2*)(o2 + (g0 + j) * 256 + lane * 4); }
    }
    __device__ __forceinline__ void finish(int vb, int wave, int lane, const uint2 (&a)[4], const uint2 (&bq)[4], float lm, const float4 ww) const {
        const size_t g0 = ((size_t)vb * 8 + wave) * 4;
#pragma unroll
        for (int j = 0; j < 4; ++j) {
            const float v0 = __uint_as_float(a[j].x << 16) - lm * __uint_as_float(bq[j].x << 16), v1 = __uint_as_float(a[j].x & 0xffff0000u) - lm * __uint_as_float(bq[j].x & 0xffff0000u);
            const float v2 = __uint_as_float(a[j].y << 16) - lm * __uint_as_float(bq[j].y << 16), v3 = __uint_as_float(a[j].y & 0xffff0000u) - lm * __uint_as_float(bq[j].y & 0xffff0000u);
            float ss = v0 * v0 + v1 * v1 + v2 * v2 + v3 * v3; ss = wave_sum(ss);
            const float r = 1.0f / sqrtf(ss * (1.f / 256.f) + RMS_EPS) * (1.f - LAM_INIT0);
            uint2 q; q.x = pkbf(v0 * r * ww.x, v1 * r * ww.y); q.y = pkbf(v2 * r * ww.z, v3 * r * ww.w);
            *(uint2*)(ob + (g0 + j) * 256 + lane * 4) = q; }
    }
    __device__ __forceinline__ void run(int nvb) const {
        const int tid = otid(), wave = __builtin_amdgcn_readfirstlane(tid >> 6), lane = tid & 63, G = gridDim.x, it0 = obid();
        const int nit = it0 < nvb ? (nvb - it0 + G - 1) / G : 0;
        if (nit <= 0) return;
        const int last = it0 + (nit - 1) * G;
        const float lm = lam[0]; const float4 ww = *(const float4*)(w + lane * 4);
        uint2 a0[4], b0[4], a1[4], b1[4];
        int it = it0, k = 0;
        load(it, wave, lane, a0, b0);
        for (; k + 1 < nit; k += 2) {
            load(it + G, wave, lane, a1, b1);
            __builtin_amdgcn_sched_barrier(0);
            finish(it, wave, lane, a0, b0, lm, ww);
            __builtin_amdgcn_sched_barrier(0);
            load(it + 2 * G < last ? it + 2 * G : last, wave, lane, a0, b0);
            __builtin_amdgcn_sched_barrier(0);
            finish(it + G, wave, lane, a1, b1, lm, ww);
            it += 2 * G;
        }
        if (k < nit) finish(it, wave, lane, a0, b0, lm, ww);
    }
};
struct CumBF {
    const float* flog; const float* fb; float* bz;
    __device__ __forceinline__ void operator()(int vb) const {
        float* tot = (float*)g_lds;
        const int b = vb >> 4, h = vb & 15, tid = otid();
        float v[8]; float run = 0.f;
#pragma unroll
        for (int j = 0; j < 8; ++j) { const float x = flog[((size_t)b * S + tid * 8 + j) * 16 + h] + fb[h];
            const float ls = fminf(x, 0.f) - log1pf(expf(-fabsf(x))); run += ls; v[j] = run; }
        __syncthreads();
        tot[tid] = run;
        __syncthreads();
        if (tid < 64) { float t8[8]; float a = 0.f;
#pragma unroll
            for (int j = 0; j < 8; ++j) { t8[j] = tot[tid * 8 + j]; a += t8[j]; }
            float inc = a;
#pragma unroll
            for (int o = 1; o < 64; o <<= 1) { const float v = __shfl_up(inc, o); if (tid >= o) inc += v; }
            float ex = inc - a;
#pragma unroll
            for (int j = 0; j < 8; ++j) { tot[tid * 8 + j] = ex; ex += t8[j]; } }
        __syncthreads();
        const float off = tot[tid];
#pragma unroll
        for (int j = 0; j < 8; ++j) bz[((size_t)b * 16 + h) * S + tid * 8 + j] = -(v[j] + off) * 11.313708498984761f;
        __syncthreads();
    }
};
struct AttnArgs { const bf16_t* q; const bf16_t* k; const bf16_t* v; bf16_t* o0; bf16_t* o1; const float* bz; const unsigned* nrm2; };
typedef swa::BlockRef<__hip_bfloat16, __hip_bfloat16> ARef;
template <int LAYER> __device__ __forceinline__ ARef attn_ref(const AttnArgs& a, int prob, int qb) {
    ARef r; r.P0 = qb * 256; r.Bz = nullptr; r.JLO = 0;
    if (LAYER == 0) {
        const int vh = prob & 1, c = (prob >> 1) & 1, h = (prob >> 2) & 7, b = prob >> 5, qh = 2 * h + c, vv = 2 * h + vh;
        r.Q = (const __hip_bfloat16*)a.q + ((size_t)(b * 16 + qh) * S + qb * 256) * 128;
        r.K = (const __hip_bfloat16*)a.k + (size_t)(b * 16 + qh) * S * 128;
        r.V = (const __hip_bfloat16*)a.v + (size_t)(b * 16 + vv) * S * 128;
        r.O = (__hip_bfloat16*)(c ? a.o1 : a.o0) + ((size_t)b * S + qb * 256) * D + h * 256 + vh * 128;
    } else {
        r.Q = (const __hip_bfloat16*)a.q + ((size_t)prob * S + qb * 256) * 128;
        r.K = (const __hip_bfloat16*)a.k + (size_t)prob * S * 128;
        r.V = (const __hip_bfloat16*)a.v + (size_t)prob * S * 128;
        r.O = (__hip_bfloat16*)a.o0 + ((size_t)(prob >> 4) * S + qb * 256) * D + (prob & 15) * 128;
        r.Bz = a.bz + (size_t)prob * S;
    }
    return r;
}
template <int NPROB> __device__ __forceinline__ void attn_item(int L, int& prob, int& x) { const int xc = L & 7, j = L >> 3; prob = xc * (NPROB / 8) + (j >> 3); x = j & 7; }
__device__ __forceinline__ float fox_R(const AttnArgs& a, int prob) {
    const float q2 = __uint_as_float(__hip_atomic_load(a.nrm2 + prob, __ATOMIC_RELAXED, __HIP_MEMORY_SCOPE_AGENT)), k2 = __uint_as_float(__hip_atomic_load(a.nrm2 + 64 + prob, __ATOMIC_RELAXED, __HIP_MEMORY_SCOPE_AGENT));
    return 2.f * sqrtf(q2 * k2) * 1.02f + 339.5f;
}
__device__ __forceinline__ int fox_jlo2(const AttnArgs& a, int prob, int x) {
    const float* bzp = a.bz + (size_t)prob * S; const int lane = otid() & 63;
    const float v = bzp[64 * lane + 63], f = bzp[256 * (lane & 15)], R = fox_R(a, prob);
    const float f0 = __shfl(f, x), f1 = __shfl(f, 15 - x);
    return __popcll(__ballot(f0 - v >= R)) | (__popcll(__ballot(f1 - v >= R)) << 8);
}
struct FoxPair { int probA, probB, x; bool paired; };
__device__ __forceinline__ FoxPair fox_pairing(const AttnArgs& a) {
    FoxPair fp; fp.probA = fp.probB = fp.x = 0; fp.paired = gridDim.x == 256;
    if (!fp.paired) return fp;
    const int bid = obid(), c = bid & 7, b = c >> 1, g = c & 1, j = bid >> 3, slot = j >> 3;
    LAS int* cost = (LAS int*)(g_lds + 100 * 1024); LAS int* order = cost + 16;
    const int tid = otid(), wave = __builtin_amdgcn_readfirstlane(tid >> 6), lane = tid & 63;
    __syncthreads();
#pragma unroll 1
    for (int hh = 0; hh < 2; ++hh) { const int h = wave * 2 + hh, prob = b * 16 + h;
        const float* bzp = a.bz + (size_t)prob * S;
        const float v = bzp[64 * lane + 63], f = bzp[256 * (lane & 15)], R = fox_R(a, prob);
        int cst = 0;
#pragma unroll
        for (int q = 0; q < 16; ++q) cst += 4 * (q + 1) + 1 - __popcll(__ballot(__shfl(f, q) - v >= R));
        if (lane == 0) cost[h] = cst; }
    __syncthreads();
    if (tid < 16) { const int ch = cost[tid]; int rk = 0;
        for (int h2 = 0; h2 < 16; ++h2) { const int c2 = cost[h2]; rk += (c2 > ch || (c2 == ch && h2 < tid)) ? 1 : 0; }
        order[rk] = tid; }
    __syncthreads();
    const int p = g == 0 ? (slot == 0 ? 0 : slot == 1 ? 3 : slot == 2 ? 4 : 7) : (slot == 0 ? 1 : slot == 1 ? 2 : slot == 2 ? 5 : 6);
    fp.probA = b * 16 + order[p]; fp.probB = b * 16 + order[15 - p]; fp.x = j & 7;
    __syncthreads();
    return fp;
}
template <int LAYER> __device__ __forceinline__ void attn_item_of(const FoxPair& fp, int i, int L, int& prob, int& x) {
    if (LAYER == 1 && fp.paired) { prob = (i & 1) ? fp.probB : fp.probA; x = (i & 1) ? 7 - fp.x : fp.x; }
    else { attn_item<LAYER == 0 ? 128 : 64>(L, prob, x); if (LAYER == 1 && (i & 1)) x = 7 - x; }
}
template <int LAYER> __device__ __forceinline__ void attn_stream(const AttnArgs& a, const FoxPair& fp, int i0, int i1) {
    constexpr int NPROB = LAYER == 0 ? 128 : 64, NX = 8, TOTAL = NPROB * NX;
    char* lds = (char*)g_lds;
    const int stride = gridDim.x;
    int i = i0, L = obid() + i0 * stride; if (i0 >= i1 || L >= TOTAL) return;
    int pass = 0, prob, x, jp = 0;
    if (LAYER == 1) {
        attn_item_of<LAYER>(fp, i0, L, prob, x); jp = fox_jlo2(a, prob, x);
        if (i0 + 1 < i1 && L + stride < TOTAL) { attn_item_of<LAYER>(fp, i0 + 1, L + stride, prob, x); jp |= fox_jlo2(a, prob, x) << 16; } }
#define JLO_OF(ii, ps) ((LAYER == 1 && (ii) - i0 < 2) ? ((jp >> (16 * ((ii) - i0) + 8 * (ps))) & 255) : 0)
    attn_item_of<LAYER>(fp, i, L, prob, x);
    ARef cur = attn_ref<LAYER>(a, prob, x); cur.JLO = JLO_OF(i, 0);
    swa::Seam<__hip_bfloat16> Sm;
    swa::causal_swa_prime<__hip_bfloat16, __hip_bfloat16>(cur, S, lds, Sm);
    for (;;) {
        const bool more_pass = pass == 0, more_item = (i + 1 < i1) && (L + stride < TOTAL), last = !more_pass && !more_item;
        int passn = pass + 1, Ln = L, in = i;
        if (!more_pass) { passn = 0; if (more_item) { Ln = L + stride; in = i + 1; } }
        attn_item_of<LAYER>(fp, in, Ln, prob, x);
        ARef nxt = last ? cur : attn_ref<LAYER>(a, prob, passn ? 15 - x : x);
        if (!last) nxt.JLO = JLO_OF(in, passn);
        swa::causal_swa_block<__hip_bfloat16, __hip_bfloat16, D, LAYER == 1>(cur, nxt, S, S, lds, Sm);
        if (last) break;
        cur = nxt; pass = passn; L = Ln; i = in;
    }
#undef JLO_OF
}
struct Params {
    const float* x; const float* c;
    const float* mix_mod_w; const float* mix_mod_b; const float* mix_ln_g; const float* mix_ln_b;
    const float* a_w_in; const float* a_lq1; const float* a_lk1; const float* a_lq2; const float* a_lk2; const float* a_subln; const float* a_w_out;
    const float* b_w_in; const float* b_fb; const float* b_w_out;
    const float* ffn_mod_w; const float* ffn_mod_b; const float* ffn_ln_g; const float* ffn_ln_b;
    const float* moe_wg; const float* moe_bg; const float* moe_wr; const float* moe_br; const float* moe_gate; const float* moe_up; const float* moe_down;
    float* out; unsigned* bar;
    float* modv; float* ropet; float* lam; float* cum; int* cnt; int* tok_e; int* tok_pos; float* tok_w; int* tok_slot; int* slot_token; float* slot_w; int* panel_e;
    float* xA; float* xB; float* hbuf; float* abuf; float* ubuf; float* obuf; float* projb; float* sc1; float* sc2; float* y2;
    bf16_t* hb; bf16_t* ob; bf16_t* wt_in[2]; bf16_t* wt_out[2];
    bf16_t* qh; bf16_t* kh; bf16_t* vh; bf16_t* o1; bf16_t* o2; float* flog; float* bz;
    bf16_t* wgu; bf16_t* wdn; bf16_t* wgu1; bf16_t* wdn1; bf16_t* Hs; bf16_t* hid; bf16_t* y2b; int* npan; float* modp; bf16_t* yb16;
    bf16_t* rhi; bf16_t* rlo; bf16_t* fhi; bf16_t* flo; int* wgcnt; bf16_t* xAb; bf16_t* xBb; unsigned* nrm2;
};

template <class F> __device__ __forceinline__ void phase(const F& f, int nvb, const XcdBarrier& bar) {
    for (int vb = obid(); vb < nvb; vb += gridDim.x) f(vb);
    xcd_barrier(bar);
}
template <class F> __device__ __forceinline__ void run_nb(const F& f, int nvb) { for (int vb = obid(); vb < nvb; vb += gridDim.x) f(vb); }
__device__ __forceinline__ void gemm(const XcdBarrier& bar, const float* A, int lda, const float* B, int ldb, float* C, int ldc, int M, int N, int K, int transB, int causal,
          const int* rowidx = nullptr, const int* panel_e = nullptr, long long strideBe = 0, bool sync = true) {
    GemmF g; g.A = A; g.B = B; g.C = C; g.rowidx = rowidx; g.panel_e = panel_e; g.strideBe = strideBe; g.lda = lda; g.ldb = ldb; g.ldc = ldc; g.M = M; g.N = N; g.K = K;
    g.transB = transB; g.causal = causal; g.tilesN = (N + 127) / 128; g.pad0 = 0;
    run_nb(g, ((M + 127) / 128) * g.tilesN);
    if (sync) xcd_barrier(bar);
}
__device__ __forceinline__ void mgemm_f32(const bf16_t* A, const bf16_t* Bt, float* C, int ldc, int M, int N, int K) {
    pg8::Gemm g{A, Bt, M, N, K}; pg8::StaticOrder S; S.init(M, N, (int)gridDim.x, obid());
    pg8::EpiF32 E{C, ldc};
    pg8::gemm_phase<pg8::EpiF32, pg8::StaticOrder, true, true>((PG8_LAS unsigned char*)g_lds, g, S, E);
}

__device__ __forceinline__ void mgemm_b16(const bf16_t* A, const bf16_t* Bt, bf16_t* C, int ldc, int M, int N, int K) {
    pg8::Gemm g{A, Bt, M, N, K}; pg8::StaticOrder So; So.init(M, N, (int)gridDim.x, obid());
    pg8::EpiB16 E{C, ldc};
    pg8::gemm_phase<pg8::EpiB16, pg8::StaticOrder, true, true>((PG8_LAS unsigned char*)g_lds, g, So, E);
}
__device__ __forceinline__ void mgemm_qkv(const bf16_t* A, const bf16_t* Bt, bf16_t* q, const float* rope, unsigned* nrm2) {
    pg8::Gemm g{A, Bt, NTOK, 6144, D}; pg8::StaticOrder So; So.init(NTOK, 6144, (int)gridDim.x, obid());
    PG8_LAS float* rowsq = (PG8_LAS float*)(g_lds + 131072);
    pg8::EpiQKV E{q, nrm2, rowsq, rope};
    pg8::gemm_phase<pg8::EpiQKV, pg8::StaticOrder, true, true>((PG8_LAS unsigned char*)g_lds, g, So, E);
}

__device__ __forceinline__ void moe_weights(const float* gate, const float* up, const float* down, bf16_t* wgu, bf16_t* wdn) {
    const int tid = otid(), wave = __builtin_amdgcn_readfirstlane(tid >> 6), lane = tid & 63;
    constexpr int IPE = 256;
#define MW_DESC(it_) const int which = (it_) / (32 * IPE), r = (it_) - which * (32 * IPE), e = r / IPE, ii = r - e * IPE; TransF t; \
        if (which == 0) { t.W = gate + (size_t)e * D * 512; t.WT = wgu + (size_t)e * 1024 * D; t.K = D; t.ldw = 512; t.ncols = 512; t.ileave = 1; } \
        else if (which == 1) { t.W = up + (size_t)e * D * 512; t.WT = wgu + (size_t)e * 1024 * D; t.K = D; t.ldw = 512; t.ncols = 512; t.ileave = 2; } \
        else { t.W = down + (size_t)e * 512 * D; t.WT = wdn + (size_t)e * D * 512; t.K = 512; t.ldw = D; t.ncols = D; t.ileave = 0; }
    const int step = gridDim.x * 8, total = 3 * 32 * IPE, it0 = obid() * 8 + wave;
    const int nit = it0 < total ? (total - it0 + step - 1) / step : 0;
    if (nit > 0) {
        const int last = it0 + (nit - 1) * step;
        int it = it0, k = 0;
        float4 va[16], vb[16];
        { MW_DESC(it); t.load(ii, lane, va); }
        for (; k + 1 < nit; k += 2) {
            { MW_DESC(it + step); t.load(ii, lane, vb); }
            __builtin_amdgcn_sched_barrier(0);
            { MW_DESC(it); t.finish(ii, wave, lane, va); }
            __builtin_amdgcn_sched_barrier(0);
            { const int itn = it + 2 * step < last ? it + 2 * step : last; MW_DESC(itn); t.load(ii, lane, va); }
            __builtin_amdgcn_sched_barrier(0);
            { MW_DESC(it + step); t.finish(ii, wave, lane, vb); }
            it += 2 * step;
        }
        if (k < nit) { MW_DESC(it); t.finish(ii, wave, lane, va); }
    }
#undef MW_DESC
}
__device__ __forceinline__ void moe_gemm1(const bf16_t* Hs, const int* rowmap, const bf16_t* wgu, bf16_t* hid, const float* slot_w, const int* panel_e, const int* npan) {
    pg8::Gemm g{Hs, wgu, MAXSLOT, 1024, D}; pg8::MoeOrder So{panel_e, npan[0], 4, (int)gridDim.x, obid()};
    pg8::EpiSwiGLU E{hid, slot_w};
    pg8::gemm_phase_gather<pg8::EpiSwiGLU, pg8::MoeOrder>((PG8_LAS unsigned char*)g_lds, g, rowmap, So, E);
}
__device__ __forceinline__ void moe_gemm2(const bf16_t* hid, const bf16_t* wdn, bf16_t* y2, const int* slot_dst, const int* panel_e, const int* npan) {
    pg8::Gemm g{hid, wdn, MAXSLOT, D, 512}; pg8::MoeOrder So{panel_e, npan[0], 8, (int)gridDim.x, obid()};
    pg8::EpiScatter E{y2, slot_dst};
    pg8::gemm_phase<pg8::EpiScatter, pg8::MoeOrder, true, true>((PG8_LAS unsigned char*)g_lds, g, So, E);
}

template <int LAYER> __device__ __forceinline__ void attn_conv_phase(const AttnArgs& a, const float* gate, const float* up, const float* down, bf16_t* wgu, bf16_t* wdn) {
    constexpr int TOTAL = (LAYER == 0 ? 128 : 64) * 8;
    const int bid = obid(), G = gridDim.x, n = bid < TOTAL ? (TOTAL - bid + G - 1) / G : 0, cls = bid % 3, split = cls == 0 ? 0 : (cls == 1 ? n / 2 : n);
    FoxPair fp; fp.probA = fp.probB = fp.x = 0; fp.paired = false;
    if (LAYER == 1) fp = fox_pairing(a);
    attn_stream<LAYER>(a, fp, 0, split);
    __syncthreads();
    moe_weights(gate, up, down, wgu, wdn);
    __syncthreads();
    attn_stream<LAYER>(a, fp, split, n);
}

typedef const __attribute__((address_space(4))) Params* KParamsPtr;
__device__ __forceinline__ KParamsPtr kp() { KParamsPtr q = (KParamsPtr)__builtin_amdgcn_kernarg_segment_ptr(); asm volatile("" : "+s"(q)); return q; }
__global__ void __launch_bounds__(NTHR, 2) fwd_kernel(Params p_arg) {
#define p (*kp())
    for (int u = threadIdx.x; u < (LDS_BYTES - LDSCTL_OFF) / 4; u += NTHR) ((LAS unsigned*)(g_lds + LDSCTL_OFF))[u] = 0u;
    __syncthreads();
    const XcdBarrier bar = xcd_barrier_post(p.bar, (volatile LAS unsigned*)(g_lds + LDSCTL_OFF + 64));

    { ModF f; f.c = p.c; f.w0 = p.mix_mod_w; f.w1 = p.ffn_mod_w; f.modp = p.modp; run_nb(f, 768); }
    __syncthreads();
    { RopeTableF f; f.tab = p.ropet; run_nb(f, S * 64 / NTHR); }
    { SmallWF f; f.wg = p.moe_wg; f.wr = p.moe_wr; f.bwin = p.b_w_in; f.rhi = p.rhi; f.rlo = p.rlo; f.fhi = p.fhi; f.flo = p.flo; run_nb(f, (2 * 48 * D + 16 * D) / NTHR); }
    { LamF f; f.q1 = p.a_lq1; f.k1 = p.a_lk1; f.q2 = p.a_lq2; f.k2 = p.a_lk2; f.lam = p.lam; if (obid() == gridDim.x - 1) f(0); }
    { TransF t; t.W = p.a_w_in; t.WT = p.wt_in[0]; t.K = D; t.ldw = 6144; t.ncols = 6144; t.ileave = 3; t.run(); }
    { TransF t; t.W = p.b_w_in; t.WT = p.wt_in[1]; t.K = D; t.ldw = 6160; t.ncols = 6144; t.ileave = 0; t.run(); }
    { TransF t; t.W = p.a_w_out; t.WT = p.wt_out[0]; t.K = D; t.ldw = D; t.ncols = D; t.ileave = 0; t.run(); }
    { TransF t; t.W = p.b_w_out; t.WT = p.wt_out[1]; t.K = D; t.ldw = D; t.ncols = D; t.ileave = 0; t.run(); }
    xcd_barrier(bar);
    { ModRedF f; f.modp = p.modp; f.b0 = p.mix_mod_b; f.b1 = p.ffn_mod_b; f.out = p.modv; run_nb(f, 4 * NB * 3 * D / NTHR); }
    { Mod0F f; f.x = p.x; f.modp = p.modp; f.bias = p.mix_mod_b; f.hb = p.hb; f.run(); }
    xcd_barrier(bar);
    const float scale = 0.08838834764831845f;

    const float* xin = p.x;
#pragma unroll 1
    for (int layer = 0; layer < 2; ++layer) {
        const float* modm = p.modv + (size_t)(2 * layer) * NB * 3 * D; const float* modf = p.modv + (size_t)(2 * layer + 1) * NB * 3 * D;
        if (layer == 1) { CumBF f; f.flog = p.flog; f.fb = p.b_fb; f.bz = p.bz; run_nb(f, NB * 16); __syncthreads(); }
        mgemm_qkv(p.hb, p.wt_in[layer], p.qh, layer == 0 ? p.ropet : nullptr, layer == 1 ? p.nrm2 : nullptr);
        xcd_barrier(bar);
        AttnArgs aa; aa.q = p.qh; aa.k = p.kh; aa.v = p.vh; aa.o0 = layer == 0 ? p.o1 : p.ob; aa.o1 = p.o2; aa.bz = p.bz; aa.nrm2 = p.nrm2;
        if (layer == 0) {
            attn_conv_phase<0>(aa, p.moe_gate, p.moe_up, p.moe_down, p.wgu, p.wdn);
            xcd_barrier(bar);
            { CombineF f; f.o1 = p.o1; f.o2 = p.o2; f.lam = p.lam; f.w = p.a_subln; f.ob = p.ob; f.run(NTOK * 8 / 8 / 4); xcd_barrier(bar); }
        } else {
            attn_conv_phase<1>(aa, p.moe_gate + (size_t)32 * D * 512, p.moe_up + (size_t)32 * D * 512, p.moe_down + (size_t)32 * 512 * D, p.wgu1, p.wdn1);
            xcd_barrier(bar);
        }
        { InitF f; f.cnt = p.cnt; f.slot_token = p.slot_token; f.panel_e = p.panel_e; f.nrm2 = layer == 0 ? p.nrm2 : nullptr; run_nb(f, MAXSLOT / NTHR); }
        mgemm_b16(p.ob, p.wt_out[layer], p.yb16, D, NTOK, D, D);
        xcd_barrier(bar);
#define ROWF0_ARGS f.y = p.yb16; f.yb = nullptr; f.modg = modm; f.g = p.mix_ln_g + (size_t)layer * D; f.bta = p.mix_ln_b + (size_t)layer * D; f.out = nullptr; f.outb = p.xAb; \
          f.modn = modf; f.hb = p.hb; f.whi = p.rhi + (size_t)layer * 48 * D; f.wlo = p.rlo + (size_t)layer * 48 * D; \
          f.bg = p.moe_bg + layer * 4; f.br = p.moe_br + layer * 32; f.wgcnt = p.wgcnt; f.tok_e = p.tok_e; f.tok_pos = p.tok_pos; f.tok_w = p.tok_w; f.flog = nullptr
        if (layer == 0) { RowF<0, false> f; f.x = p.x; f.xb = nullptr; ROWF0_ARGS; f.run(NTOK / 16); }
        else { RowF<0, true> f; f.x = nullptr; f.xb = p.xBb; ROWF0_ARGS; f.run(NTOK / 16); }
#undef ROWF0_ARGS
        xcd_barrier(bar);
        { ScatF f; f.wgcnt = p.wgcnt; f.tok_e = p.tok_e; f.tok_pos = p.tok_pos; f.tok_w = p.tok_w; f.slot_token = p.slot_token; f.slot_w = p.slot_w; f.panel_e = p.panel_e; f.npan = p.npan;
          phase(f, (2 * NTOK + 32 * 256) / NTHR, bar); }
        moe_gemm1(p.hb, p.slot_token, layer == 0 ? p.wgu : p.wgu1, p.hid, p.slot_w, p.panel_e, p.npan);
        xcd_barrier(bar);
        moe_gemm2(p.hid, layer == 0 ? p.wdn : p.wdn1, p.y2b, p.slot_token, p.panel_e, p.npan);
        xcd_barrier(bar);
        if (layer == 0) {
            RowF<1, true> f; f.x = nullptr; f.xb = p.xAb; f.y = nullptr; f.yb = p.y2b; f.modg = modf; f.g = p.ffn_ln_g; f.bta = p.ffn_ln_b; f.out = nullptr; f.outb = p.xBb;
            f.modn = p.modv + (size_t)2 * NB * 3 * D; f.hb = p.hb; f.whi = p.fhi; f.wlo = p.flo;
            f.bg = nullptr; f.br = nullptr; f.wgcnt = nullptr; f.tok_e = nullptr; f.tok_pos = nullptr; f.tok_w = nullptr; f.flog = p.flog;
            f.run(NTOK / 16);
        } else {
            RowF<2, true> f; f.x = nullptr; f.xb = p.xAb; f.outb = nullptr; f.y = nullptr; f.yb = p.y2b; f.modg = modf; f.g = p.ffn_ln_g + (size_t)layer * D; f.bta = p.ffn_ln_b + (size_t)layer * D; f.out = p.out;
            f.modn = nullptr; f.hb = nullptr; f.whi = nullptr; f.wlo = nullptr; f.bg = nullptr; f.br = nullptr; f.wgcnt = nullptr; f.tok_e = nullptr; f.tok_pos = nullptr; f.tok_w = nullptr; f.flog = nullptr;
            f.run(NTOK / 16);
        }
        if (layer == 0) xcd_barrier(bar);
        xin = p.xB;
    }
#undef p
}
}

extern "C" void kernel_launch(void* const* d_in, const int* in_sizes, int n_in, void* d_out, int out_size, void* d_ws, size_t ws_size, hipStream_t stream) {
    (void)in_sizes; (void)out_size;
    if (n_in != 27) { fprintf(stderr, "kernel_launch: expected 27 inputs, got %d\n", n_in); return; }
    Params p; memset(&p, 0, sizeof(p));
    p.x = (const float*)d_in[0]; p.c = (const float*)d_in[1];
    p.mix_mod_w = (const float*)d_in[2]; p.mix_mod_b = (const float*)d_in[3]; p.mix_ln_g = (const float*)d_in[4]; p.mix_ln_b = (const float*)d_in[5];
    p.a_w_in = (const float*)d_in[6]; p.a_lq1 = (const float*)d_in[7]; p.a_lk1 = (const float*)d_in[8]; p.a_lq2 = (const float*)d_in[9]; p.a_lk2 = (const float*)d_in[10];
    p.a_subln = (const float*)d_in[11]; p.a_w_out = (const float*)d_in[12];
    p.b_w_in = (const float*)d_in[13]; p.b_fb = (const float*)d_in[14]; p.b_w_out = (const float*)d_in[15];
    p.ffn_mod_w = (const float*)d_in[16]; p.ffn_mod_b = (const float*)d_in[17]; p.ffn_ln_g = (const float*)d_in[18]; p.ffn_ln_b = (const float*)d_in[19];
    p.moe_wg = (const float*)d_in[20]; p.moe_bg = (const float*)d_in[21]; p.moe_wr = (const float*)d_in[22]; p.moe_br = (const float*)d_in[23];
    p.moe_gate = (const float*)d_in[24]; p.moe_up = (const float*)d_in[25]; p.moe_down = (const float*)d_in[26];
    p.out = (float*)d_out;

    size_t off = 0; float* ws = (float*)d_ws;
    auto take = [&](size_t n) { float* q = ws + off; off += (n + 63) & ~(size_t)63; return q; };
    p.bar = (unsigned*)take(XCD_BAR_WORDS);
    p.modv = take((size_t)4 * NB * 3 * D); p.modp = take((size_t)16 * 4 * NB * 3 * D);
    p.ropet = take((size_t)S * 64 * 2);
    p.lam = take(64);
    p.cum = take((size_t)16 * S); p.flog = take((size_t)NTOK * 16); p.bz = take((size_t)NB * 16 * S);
    p.cnt = (int*)take(64); p.wgcnt = (int*)take(256 * 32); p.nrm2 = (unsigned*)take(512);
    p.tok_e = (int*)take(2 * NTOK); p.tok_pos = (int*)take(2 * NTOK); p.tok_w = take(2 * NTOK); p.tok_slot = (int*)take(2 * NTOK);
    p.slot_token = (int*)take(MAXSLOT); p.slot_w = take(MAXSLOT); p.panel_e = (int*)take(256);
    p.wt_in[0] = (bf16_t*)take((size_t)6144 * D / 2); p.wt_in[1] = (bf16_t*)take((size_t)6144 * D / 2);
    p.wt_out[0] = (bf16_t*)take((size_t)D * D / 2); p.wt_out[1] = (bf16_t*)take((size_t)D * D / 2);
    p.hb = (bf16_t*)take((size_t)NTOK * D / 2); p.ob = (bf16_t*)take((size_t)NTOK * D / 2);
    p.xA = nullptr; p.xB = nullptr; p.xAb = (bf16_t*)take((size_t)NTOK * D / 2); p.xBb = (bf16_t*)take((size_t)NTOK * D / 2); p.yb16 = (bf16_t*)take((size_t)NTOK * D / 2);
    p.rhi = (bf16_t*)take((size_t)2 * 48 * D / 2); p.rlo = (bf16_t*)take((size_t)2 * 48 * D / 2); p.fhi = (bf16_t*)take((size_t)16 * D / 2); p.flo = (bf16_t*)take((size_t)16 * D / 2);
    p.wgu = (bf16_t*)take((size_t)32 * 1024 * D / 2); p.wdn = (bf16_t*)take((size_t)32 * D * 512 / 2);
    p.wgu1 = (bf16_t*)take((size_t)32 * 1024 * D / 2); p.wdn1 = (bf16_t*)take((size_t)32 * D * 512 / 2); p.npan = (int*)take(64);
    float* region = ws + off;
    p.qh = (bf16_t*)take((size_t)NTOK * D / 2); p.kh = (bf16_t*)take((size_t)NTOK * D / 2); p.vh = (bf16_t*)take((size_t)NTOK * D / 2);
    p.o1 = (bf16_t*)take((size_t)NTOK * D / 2); p.o2 = (bf16_t*)take((size_t)NTOK * D / 2);
    take((size_t)3 << 20);
    p.Hs = (bf16_t*)region; p.hid = p.Hs + (size_t)MAXSLOT * D; p.y2b = p.hid + (size_t)MAXSLOT * 512;
    if (off * sizeof(float) > ws_size) { fprintf(stderr, "kernel_launch: workspace too small (%zu > %zu)\n", off * sizeof(float), ws_size); return; }

    static int grid = 0;
    if (!grid) { int dev = 0, cus = 0; (void)hipGetDevice(&dev);
        if (hipDeviceGetAttribute(&cus, hipDeviceAttributeMultiprocessorCount, dev) != hipSuccess || cus <= 0) cus = 256;
        if (hipFuncSetAttribute((const void*)fwd_kernel, hipFuncAttributeMaxDynamicSharedMemorySize, LDS_BYTES) != hipSuccess) fprintf(stderr, "kernel_launch: hipFuncSetAttribute failed\n");
        grid = cus; }
    (void)hipMemsetAsync(p.bar, 0, XCD_BAR_WORDS * sizeof(unsigned), stream);
    hipLaunchKernelGGL(fwd_kernel, dim3(grid), dim3(NTHR), LDS_BYTES, stream, p);
}
```

```cpp
#include <hip/hip_runtime.h>
#include <cstdio>
#include <cstdint>
#include <cmath>
#include <cstring>

namespace pg8 {
#define PG8_LAS __attribute__((address_space(3)))
typedef unsigned short bf16_t;
typedef short bf16x8 __attribute__((ext_vector_type(8)));
typedef float f32x4 __attribute__((ext_vector_type(4)));
typedef unsigned u32x4 __attribute__((ext_vector_type(4)));
constexpr int BM = 256, BK = 64, HALF = 128, HTB = HALF * BK * 2  , STAGE_BYTES = 8 * HTB, NXCD = 8, WGM = 8;

__host__ __device__ __forceinline__ int lds_byte(int r, int c) { const int st = (r >> 4) * 2 + (c >> 5), rr = r & 15, cc = c & 31, ob = rr * 64 + cc * 2; return st * 1024 + (ob ^ (((ob >> 9) & 1) << 5)); }
__host__ __device__ __forceinline__ void stage_rc(int b, int& R, int& C) { const int st = b / 1024, sb = b % 1024, swz = sb ^ (((sb >> 9) & 1) << 5); R = (st >> 1) * 16 + swz / 64; C = (st & 1) * 32 + (swz % 64) / 2; }
__host__ __device__ __forceinline__ int perm32(int rho) { const int n = rho >> 4, i = rho & 15; return 8 * (i >> 2) + 4 * n + (i & 3); }

struct Unit { int pm, pn; };
struct Gemm { const bf16_t* A; const bf16_t* Bt; int M, N, K; };

struct StaticOrder {
    int nM, nN, nwg, G, c;
    __host__ __device__ void init(int M, int N, int G_, int c_) { nM = M / BM; nN = N / BM; nwg = nM * nN; G = G_; c = c_; }
    __host__ __device__ bool next(int i, Unit& u) const {
        const long L = (long)i * G + c; if (L >= nwg) return false;
        int wgid = (int)L; { const int q = nwg / NXCD, r = nwg % NXCD, xcd = wgid % NXCD, off = wgid / NXCD; wgid = (xcd < r ? xcd * (q + 1) : r * (q + 1) + (xcd - r) * q) + off; }
        const int nig = WGM * nN, gid = wgid / nig, fm = gid * WGM, gsz = (nM - fm) < WGM ? (nM - fm) : WGM;
        u.pm = fm + ((wgid % nig) % gsz); u.pn = (wgid % nig) / gsz; return true;
    }
    __device__ __forceinline__ void a_ready(const Unit&) const {}
    __device__ __forceinline__ void done(const Unit&) const {}
};

__device__ __forceinline__ unsigned cvt_pk_bf16(float lo, float hi) { unsigned r; asm volatile("v_cvt_pk_bf16_f32 %0, %1, %2" : "=v"(r) : "v"(lo), "v"(hi)); return r; }
typedef float f32x2 __attribute__((ext_vector_type(2)));

struct EpiF32 {
    static constexpr bool PERM = false, AFTER_DRAIN = false;
    float* C; int ldc;
    __device__ __forceinline__ void operator()(const f32x4 (&acc)[2][2][4][2], const Unit& u, int wr, int wc, int fr, int fq) const {
        const int col0 = u.pn * BM + wc * 32 + 4 * fq;
#pragma unroll
        for (int ai = 0; ai < 2; ++ai)
#pragma unroll
            for (int m = 0; m < 4; ++m) { float* rowp = C + (size_t)(u.pm * BM + ai * HALF + wr * 64 + m * 16 + fr) * ldc + col0;
#pragma unroll
                for (int bj = 0; bj < 2; ++bj)
#pragma unroll
                    for (int n = 0; n < 2; ++n) *(f32x4*)(rowp + bj * HALF + n * 16) = acc[ai][bj][m][n]; }
    }
};


struct EpiB16 {
    static constexpr bool PERM = true, AFTER_DRAIN = false;
    bf16_t* C; int ldc;
    __device__ __forceinline__ void operator()(const f32x4 (&acc)[2][2][4][2], const Unit& u, int wr, int wc, int fr, int fq) const {
        const int col0 = u.pn * BM + wc * 32 + 8 * fq;
#pragma unroll
        for (int ai = 0; ai < 2; ++ai)
#pragma unroll
            for (int m = 0; m < 4; ++m) { bf16_t* rowp = C + (size_t)(u.pm * BM + ai * HALF + wr * 64 + m * 16 + fr) * ldc + col0;
#pragma unroll
                for (int bj = 0; bj < 2; ++bj) { const f32x4 v0 = acc[ai][bj][m][0], v1 = acc[ai][bj][m][1];
                    u32x4 w; w.x = cvt_pk_bf16(v0[0], v0[1]); w.y = cvt_pk_bf16(v0[2], v0[3]); w.z = cvt_pk_bf16(v1[0], v1[1]); w.w = cvt_pk_bf16(v1[2], v1[3]);
                    *(u32x4*)(rowp + bj * HALF) = w; } }
    }
};

struct EpiQKV {
    static constexpr bool PERM = true, AFTER_DRAIN = false;
    bf16_t* qkv;
    unsigned* nrm2;
    PG8_LAS float* rowsq;
    const float* rope;
    __device__ __forceinline__ void operator()(const f32x4 (&acc)[2][2][4][2], const Unit& u, int wr, int wc, int fr, int fq) const {
        if (rope && u.pn < 16) {
            const int slot = 2 * u.pn + (wc >> 1), type = slot >> 4, head = slot & 15, i0 = (wc & 1) * 32 + 8 * fq;
            bf16_t* base = qkv + (size_t)type * ((size_t)16384 * 2048);
            f32x4 cn[4];
            { const int row0 = u.pm * BM + wr * 64 + fr, sq0 = row0 & 4095; const f32x4* cs0 = (const f32x4*)(rope + ((size_t)sq0 * 64 + i0) * 2);
#pragma unroll
              for (int q = 0; q < 4; ++q) cn[q] = cs0[q]; }
#pragma unroll
            for (int r = 0; r < 8; ++r) { const int ai = r >> 2, m = r & 3;
                const int row = u.pm * BM + ai * HALF + wr * 64 + m * 16 + fr, b = row >> 12, sq = row & 4095;
                const f32x4 c0 = cn[0], c1 = cn[1], c2 = cn[2], c3 = cn[3];
                if (r + 1 < 8) { const int rn = r + 1, rown = u.pm * BM + (rn >> 2) * HALF + wr * 64 + (rn & 3) * 16 + fr, sqn = rown & 4095; const f32x4* csn = (const f32x4*)(rope + ((size_t)sqn * 64 + i0) * 2);
#pragma unroll
                    for (int q = 0; q < 4; ++q) cn[q] = csn[q]; }
                __builtin_amdgcn_sched_barrier(0);
                float o1[8], o2[8];
#pragma unroll
                for (int n = 0; n < 2; ++n) { const f32x4 x1 = acc[ai][0][m][n], x2 = acc[ai][1][m][n], ca = n == 0 ? c0 : c2, cb = n == 0 ? c1 : c3;
                    o1[4 * n + 0] = x1[0] * ca[0] - x2[0] * ca[1]; o2[4 * n + 0] = x2[0] * ca[0] + x1[0] * ca[1];
                    o1[4 * n + 1] = x1[1] * ca[2] - x2[1] * ca[3]; o2[4 * n + 1] = x2[1] * ca[2] + x1[1] * ca[3];
                    o1[4 * n + 2] = x1[2] * cb[0] - x2[2] * cb[1]; o2[4 * n + 2] = x2[2] * cb[0] + x1[2] * cb[1];
                    o1[4 * n + 3] = x1[3] * cb[2] - x2[3] * cb[3]; o2[4 * n + 3] = x2[3] * cb[2] + x1[3] * cb[3]; }
                bf16_t* dst = base + ((size_t)(b * 16 + head) * 4096 + sq) * 128 + i0;
                u32x4 w; w.x = cvt_pk_bf16(o1[0], o1[1]); w.y = cvt_pk_bf16(o1[2], o1[3]); w.z = cvt_pk_bf16(o1[4], o1[5]); w.w = cvt_pk_bf16(o1[6], o1[7]);
                *(u32x4*)dst = w;
                w.x = cvt_pk_bf16(o2[0], o2[1]); w.y = cvt_pk_bf16(o2[2], o2[3]); w.z = cvt_pk_bf16(o2[4], o2[5]); w.w = cvt_pk_bf16(o2[6], o2[7]);
                *(u32x4*)(dst + 64) = w;
                __builtin_amdgcn_sched_barrier(0); }
            return;
        }
        const int d = wc * 32 + 8 * fq;
        if (nrm2 && u.pn < 16) {
#pragma unroll
            for (int bj = 0; bj < 2; ++bj)
#pragma unroll
                for (int ai = 0; ai < 2; ++ai)
#pragma unroll
                    for (int m = 0; m < 4; ++m) { const f32x4 v0 = acc[ai][bj][m][0], v1 = acc[ai][bj][m][1];
                        float sq = (v0[0] * v0[0] + v0[1] * v0[1]) + (v0[2] * v0[2] + v0[3] * v0[3]) + (v1[0] * v1[0] + v1[1] * v1[1]) + (v1[2] * v1[2] + v1[3] * v1[3]);
                        { const auto r = __builtin_amdgcn_permlane16_swap(__float_as_uint(sq), __float_as_uint(sq), false, false); sq = __uint_as_float(r[0]) + __uint_as_float(r[1]); }
                        { const auto r = __builtin_amdgcn_permlane32_swap(__float_as_uint(sq), __float_as_uint(sq), false, false); sq = __uint_as_float(r[0]) + __uint_as_float(r[1]); }
                        if (fq == 0) rowsq[(wc * 2 + bj) * 256 + ai * HALF + wr * 64 + m * 16 + fr] = sq; }
            asm volatile("s_waitcnt lgkmcnt(0)" ::: "memory"); __builtin_amdgcn_s_barrier();
            { const int t = (wr * 4 + wc) * 64 + fq * 16 + fr;
              float mx = (rowsq[t] + rowsq[512 + t]) + (rowsq[1024 + t] + rowsq[1536 + t]);
              mx = fmaxf(mx, __shfl_xor(mx, 1)); mx = fmaxf(mx, __shfl_xor(mx, 2)); mx = fmaxf(mx, __shfl_xor(mx, 4)); mx = fmaxf(mx, __shfl_xor(mx, 8)); mx = fmaxf(mx, __shfl_xor(mx, 16)); mx = fmaxf(mx, __shfl_xor(mx, 32));
              const int slot = 2 * u.pn + (wr), type = slot >> 4, head = slot & 15, b = (u.pm * BM) >> 12;
              if (fr == 0 && fq == 0) atomicMax(nrm2 + type * 64 + b * 16 + head, __float_as_uint(mx)); }
        }
#pragma unroll
        for (int bj = 0; bj < 2; ++bj) { const int slot = 2 * u.pn + bj, type = slot >> 4, head = slot & 15; bf16_t* base = qkv + (size_t)type * ((size_t)16384 * 2048);
#pragma unroll
            for (int ai = 0; ai < 2; ++ai)
#pragma unroll
                for (int m = 0; m < 4; ++m) { const int row = u.pm * BM + ai * HALF + wr * 64 + m * 16 + fr, b = row >> 12, sq = row & 4095;
                    const f32x4 v0 = acc[ai][bj][m][0], v1 = acc[ai][bj][m][1];
                    u32x4 w; w.x = cvt_pk_bf16(v0[0], v0[1]); w.y = cvt_pk_bf16(v0[2], v0[3]); w.z = cvt_pk_bf16(v1[0], v1[1]); w.w = cvt_pk_bf16(v1[2], v1[3]);
                    *(u32x4*)(base + ((size_t)(b * 16 + head) * 4096 + sq) * 128 + d) = w; } }
    }
};

struct EpiSwiGLU {
    static constexpr bool PERM = true, AFTER_DRAIN = false;
    bf16_t* hid; const float* slot_w;
    __device__ __forceinline__ void operator()(const f32x4 (&acc)[2][2][4][2], const Unit& u, int wr, int wc, int fr, int fq) const {
        const int col = (u.pn & 3) * 128 + wc * 32 + 8 * fq;
        float wv[2][4];
#pragma unroll
        for (int ai = 0; ai < 2; ++ai)
#pragma unroll
            for (int m = 0; m < 4; ++m) wv[ai][m] = slot_w[u.pm * BM + ai * HALF + wr * 64 + m * 16 + fr];
        __builtin_amdgcn_sched_barrier(0);
#pragma unroll
        for (int ai = 0; ai < 2; ++ai)
#pragma unroll
            for (int m = 0; m < 4; ++m) { const int row = u.pm * BM + ai * HALF + wr * 64 + m * 16 + fr; const float w = wv[ai][m];
                float o[8];
#pragma unroll
                for (int n = 0; n < 2; ++n)
#pragma unroll
                    for (int i = 0; i < 4; ++i) { const float g = acc[ai][0][m][n][i], up = acc[ai][1][m][n][i];
                        o[4 * n + i] = g * __builtin_amdgcn_rcpf(1.f + __expf(-g)) * up * w; }
                u32x4 q; q.x = cvt_pk_bf16(o[0], o[1]); q.y = cvt_pk_bf16(o[2], o[3]); q.z = cvt_pk_bf16(o[4], o[5]); q.w = cvt_pk_bf16(o[6], o[7]);
                *(u32x4*)(hid + (size_t)row * 512 + col) = q; }
    }
};
struct EpiScatter {
    static constexpr bool PERM = true, AFTER_DRAIN = false;
    bf16_t* y2; const int* slot_dst;
    __device__ __forceinline__ void operator()(const f32x4 (&acc)[2][2][4][2], const Unit& u, int wr, int wc, int fr, int fq) const {
        const int col = (u.pn & 7) * 256 + wc * 32 + 8 * fq;
        int dv[2][4];
#pragma unroll
        for (int ai = 0; ai < 2; ++ai)
#pragma unroll
            for (int m = 0; m < 4; ++m) dv[ai][m] = slot_dst[u.pm * BM + ai * HALF + wr * 64 + m * 16 + fr];
        __builtin_amdgcn_sched_barrier(0);
#pragma unroll
        for (int ai = 0; ai < 2; ++ai)
#pragma unroll
            for (int m = 0; m < 4; ++m) { const int dst = dv[ai][m];
                if (dst >= 0) {
#pragma unroll
                    for (int bj = 0; bj < 2; ++bj) { const f32x4 v0 = acc[ai][bj][m][0], v1 = acc[ai][bj][m][1];
                        u32x4 q; q.x = cvt_pk_bf16(v0[0], v0[1]); q.y = cvt_pk_bf16(v0[2], v0[3]); q.z = cvt_pk_bf16(v1[0], v1[1]); q.w = cvt_pk_bf16(v1[2], v1[3]);
                        *(u32x4*)(y2 + (size_t)dst * 2048 + col + bj * HALF) = q; } } }
    }
};
struct MoeOrder {
    const int* panel_e; int npan, NJ, G, c;
    __device__ __forceinline__ bool next(int i, Unit& u) const {
        int pm, j;
        if ((G & 7) == 0) { const int xc = c & 7, p0 = (xc * npan) >> 3, p1 = ((xc + 1) * npan) >> 3, idx = (c >> 3) + (G >> 3) * i; if (idx >= (p1 - p0) * NJ) return false; pm = p0 + idx / NJ; j = idx - (idx / NJ) * NJ; }
        else { const int L = i * G + c; if (L >= npan * NJ) return false; pm = L / NJ; j = L - pm * NJ; }
        u.pm = pm; u.pn = panel_e[pm] * NJ + j; return true; }
    __device__ __forceinline__ void a_ready(const Unit&) const {}
    __device__ __forceinline__ void done(const Unit&) const {}
};

template <class Epi, class Sched, bool ALIGN_EPI = false, bool SP2 = false>
__device__ __forceinline__ void gemm_phase(PG8_LAS unsigned char* lds, const Gemm g, const Sched& S, const Epi& E) {
    int tid_ = threadIdx.x; asm volatile("" : "+v"(tid_));
    const int tid = tid_, wid = __builtin_amdgcn_readfirstlane(tid >> 6), lane = tid & 63, wr = wid >> 2, wc = wid & 3, fr = lane & 15, fq = lane >> 4;
    const int K = g.K, nt = K / BK;
    unsigned voffA[2], voffB[2];
#pragma unroll
    for (int i = 0; i < 2; ++i) { int R, C; stage_rc(tid * 16 + i * 8192, R, C); const int Rb = Epi::PERM ? ((R & ~31) + perm32(R & 31)) : R;
        voffA[i] = (unsigned)(R * K + C) * 2u; voffB[i] = (unsigned)(Rb * K + C) * 2u; }
    const size_t kstep = (size_t)(BK * 2);
    const size_t hstep = (size_t)HALF * K * 2;
    const size_t tstep = 2 * hstep;
    const unsigned ldsw = (unsigned)wid * 1024u;
    const int aoff = lds_byte(wr * 64 + fr, fq * 8), boff = lds_byte(wc * 32 + fr, fq * 8);
#define PG8_SA(b, h) (((b) * 2 + (h)) * HTB)
#define PG8_SB(b, h) ((4 + (b) * 2 + (h)) * HTB)
#define PG8_STAGE(bufoff, gbase, voff) do { _Pragma("unroll") for (int _i = 0; _i < 2; ++_i) \
        __builtin_amdgcn_global_load_lds((const unsigned*)((const char*)(gbase) + (voff)[_i]), (PG8_LAS unsigned*)(lds + (bufoff) + ldsw + _i * 8192), 16, 0, 0); } while (0)
#define PG8_LDA(dst, b, h) do { _Pragma("unroll") for (int m = 0; m < 4; ++m) _Pragma("unroll") for (int k = 0; k < 2; ++k) dst[m][k] = *(const PG8_LAS bf16x8*)(lds + PG8_SA(b, h) + aoff + m * 2048 + k * 1024); } while (0)
#define PG8_LDB(dst, b, h) do { _Pragma("unroll") for (int n = 0; n < 2; ++n) _Pragma("unroll") for (int k = 0; k < 2; ++k) dst[n][k] = *(const PG8_LAS bf16x8*)(lds + PG8_SB(b, h) + boff + n * 2048 + k * 1024); } while (0)
#define PG8_MMA(ai, bj, At, Bt) do { __builtin_amdgcn_s_setprio(1); _Pragma("unroll") for (int m = 0; m < 4; ++m) _Pragma("unroll") for (int n = 0; n < 2; ++n) _Pragma("unroll") for (int k = 0; k < 2; ++k) \
        acc[ai][bj][m][n] = __builtin_amdgcn_mfma_f32_16x16x32_bf16(Bt[n][k], At[m][k], acc[ai][bj][m][n], 0, 0, 0); __builtin_amdgcn_s_setprio(0); } while (0)
#define PG8_WAIT_V(n) asm volatile("s_waitcnt vmcnt(" #n ")" ::: "memory")
#define PG8_WAIT_L(n) asm volatile("s_waitcnt lgkmcnt(" #n ")" ::: "memory")
#define PG8_BAR __builtin_amdgcn_s_barrier()
#define PG8_SCHED __builtin_amdgcn_sched_barrier(0)
    Unit cur, nxt; int ui = 0;
    if (!S.next(0, cur)) return;
    f32x4 acc[2][2][4][2];
#pragma unroll
    for (int a = 0; a < 2; ++a)
#pragma unroll
        for (int b = 0; b < 2; ++b)
#pragma unroll
            for (int m = 0; m < 4; ++m)
#pragma unroll
                for (int n = 0; n < 2; ++n) acc[a][b][m][n] = (f32x4){0.f, 0.f, 0.f, 0.f};
    bf16x8 At[4][2], B0[2][2], B1[2][2];
    const char* cA = (const char*)g.A + (size_t)cur.pm * tstep; const char* cB = (const char*)g.Bt + (size_t)cur.pn * tstep;
    S.a_ready(cur);
    if constexpr (SP2) {
        PG8_STAGE(PG8_SB(0, 0), cB, voffB); PG8_STAGE(PG8_SB(0, 1), cB + hstep, voffB); PG8_STAGE(PG8_SA(0, 0), cA, voffA); PG8_STAGE(PG8_SA(0, 1), cA + hstep, voffA);
        if (wr == 1) PG8_BAR;
        PG8_WAIT_V(2); PG8_BAR;
        PG8_STAGE(PG8_SB(1, 0), cB + kstep, voffB); PG8_STAGE(PG8_SA(1, 0), cA + kstep, voffA); PG8_STAGE(PG8_SB(1, 1), cB + hstep + kstep, voffB);
        PG8_WAIT_V(6); PG8_BAR;
    } else {
        PG8_STAGE(PG8_SB(0, 0), cB, voffB); PG8_STAGE(PG8_SA(0, 0), cA, voffA); PG8_STAGE(PG8_SB(0, 1), cB + hstep, voffB); PG8_STAGE(PG8_SA(0, 1), cA + hstep, voffA);
        if (wr == 1) PG8_BAR;
        PG8_WAIT_V(4); PG8_BAR;
        PG8_STAGE(PG8_SB(1, 0), cB + kstep, voffB); PG8_STAGE(PG8_SA(1, 0), cA + kstep, voffA); PG8_STAGE(PG8_SB(1, 1), cB + hstep + kstep, voffB);
        PG8_WAIT_V(6); PG8_BAR;
    }
    for (;;) {
        const bool has_next = S.next(ui + 1, nxt);
        const char* nA = has_next ? (const char*)g.A + (size_t)nxt.pm * tstep : cA; const char* nB = has_next ? (const char*)g.Bt + (size_t)nxt.pn * tstep : cB;
        for (int t = 0; t < nt; t += 2) {
            const bool last = (t == nt - 2);
            const char* a1 = cA + (size_t)(t + 1) * kstep;
            const char* a2 = last ? nA : cA + (size_t)(t + 2) * kstep; const char* b2 = last ? nB : cB + (size_t)(t + 2) * kstep;
            const char* a3 = a2 + kstep; const char* b3 = b2 + kstep;
            if (last && has_next) S.a_ready(nxt);
            if constexpr (SP2) {
            PG8_LDB(B0, 0, 0); PG8_LDB(B1, 0, 1); PG8_SCHED; PG8_LDA(At, 0, 0); PG8_STAGE(PG8_SA(1, 1), a1 + hstep, voffA);
            PG8_WAIT_V(8); PG8_WAIT_L(0); PG8_BAR; PG8_MMA(0, 0, At, B0); PG8_MMA(0, 1, At, B1); PG8_BAR; PG8_SCHED;
            PG8_LDA(At, 0, 1); PG8_STAGE(PG8_SB(0, 0), b2, voffB); PG8_STAGE(PG8_SB(0, 1), b2 + hstep, voffB); PG8_STAGE(PG8_SA(0, 0), a2, voffA);
            PG8_WAIT_V(8); PG8_WAIT_L(0); PG8_BAR; PG8_MMA(1, 0, At, B0); PG8_MMA(1, 1, At, B1); PG8_BAR; PG8_SCHED;
            PG8_LDB(B0, 1, 0); PG8_LDB(B1, 1, 1); PG8_SCHED; PG8_LDA(At, 1, 0); PG8_STAGE(PG8_SA(0, 1), a2 + hstep, voffA);
            PG8_WAIT_V(8); PG8_WAIT_L(0); PG8_BAR; PG8_MMA(0, 0, At, B0); PG8_MMA(0, 1, At, B1); PG8_BAR; PG8_SCHED;
            PG8_LDA(At, 1, 1); PG8_STAGE(PG8_SB(1, 0), b3, voffB); PG8_STAGE(PG8_SB(1, 1), b3 + hstep, voffB); PG8_STAGE(PG8_SA(1, 0), a3, voffA);
            PG8_WAIT_V(8); PG8_WAIT_L(0); PG8_BAR; PG8_MMA(1, 0, At, B0); PG8_MMA(1, 1, At, B1); PG8_BAR; PG8_SCHED;
            } else {
            PG8_LDB(B0, 0, 0); PG8_SCHED; PG8_LDA(At, 0, 0); PG8_STAGE(PG8_SA(1, 1), a1 + hstep, voffA);
            PG8_WAIT_L(8); PG8_BAR; PG8_WAIT_L(0); PG8_MMA(0, 0, At, B0); PG8_BAR; PG8_SCHED;
            PG8_LDB(B1, 0, 1); PG8_STAGE(PG8_SB(0, 0), b2, voffB);
            PG8_BAR; PG8_WAIT_L(0); PG8_MMA(0, 1, At, B1); PG8_BAR;
            PG8_LDA(At, 0, 1); PG8_STAGE(PG8_SA(0, 0), a2, voffA);
            PG8_BAR; PG8_WAIT_L(0); PG8_MMA(1, 0, At, B0); PG8_BAR; PG8_SCHED;
            PG8_STAGE(PG8_SB(0, 1), b2 + hstep, voffB);
            PG8_WAIT_V(6); PG8_BAR; PG8_MMA(1, 1, At, B1); PG8_BAR;
            PG8_LDB(B0, 1, 0); PG8_SCHED; PG8_LDA(At, 1, 0); PG8_STAGE(PG8_SA(0, 1), a2 + hstep, voffA);
            PG8_WAIT_L(8); PG8_BAR; PG8_WAIT_L(0); PG8_MMA(0, 0, At, B0); PG8_BAR; PG8_SCHED;
            PG8_LDB(B1, 1, 1); PG8_STAGE(PG8_SB(1, 0), b3, voffB);
            PG8_BAR; PG8_WAIT_L(0); PG8_MMA(0, 1, At, B1); PG8_BAR;
            PG8_LDA(At, 1, 1); PG8_STAGE(PG8_SA(1, 0), a3, voffA);
            PG8_BAR; PG8_WAIT_L(0); PG8_MMA(1, 0, At, B0); PG8_BAR; PG8_SCHED;
            PG8_STAGE(PG8_SB(1, 1), b3 + hstep, voffB);
            PG8_WAIT_V(6); PG8_BAR; PG8_MMA(1, 1, At, B1); PG8_BAR;
            }
        }
        if constexpr (ALIGN_EPI) { if (wr == 0) PG8_BAR; }
        if constexpr (!Epi::AFTER_DRAIN) { E(acc, cur, wr, wc, fr, fq); S.done(cur); }
        if (!has_next) break;
#pragma unroll
        for (int a = 0; a < 2; ++a)
#pragma unroll
            for (int b = 0; b < 2; ++b)
#pragma unroll
                for (int m = 0; m < 4; ++m)
#pragma unroll
                    for (int n = 0; n < 2; ++n) acc[a][b][m][n] = (f32x4){0.f, 0.f, 0.f, 0.f};
        cur = nxt; cA = nA; cB = nB; ++ui;
        if constexpr (ALIGN_EPI) { if (wr == 1) PG8_BAR; }
    }
    PG8_WAIT_V(0);
    if constexpr (!ALIGN_EPI) { if (wr == 0) PG8_BAR; }
    PG8_BAR;
    if constexpr (Epi::AFTER_DRAIN) { E.fused(acc, cur, wr, wc, fr, fq, lds, wid, lane); S.done(cur); }
#undef PG8_SA
#undef PG8_SB
#undef PG8_STAGE
#undef PG8_LDA
#undef PG8_LDB
#undef PG8_MMA
#undef PG8_WAIT_V
#undef PG8_WAIT_L
#undef PG8_BAR
#undef PG8_SCHED
}
template <class Epi, class Sched>
__device__ __forceinline__ void gemm_phase_gather(PG8_LAS unsigned char* lds, const Gemm g, const int* rowmap, const Sched& S, const Epi& E) {
    constexpr bool ALIGN_EPI = true, SP2 = true;
    int tid_ = threadIdx.x; asm volatile("" : "+v"(tid_));
    const int tid = tid_, wid = __builtin_amdgcn_readfirstlane(tid >> 6), lane = tid & 63, wr = wid >> 2, wc = wid & 3, fr = lane & 15, fq = lane >> 4;
    const int K = g.K, nt = K / BK;
    unsigned voffA[2], voffB[2]; int rowA[2];
#pragma unroll
    for (int i = 0; i < 2; ++i) { int R, C; stage_rc(tid * 16 + i * 8192, R, C); const int Rb = Epi::PERM ? ((R & ~31) + perm32(R & 31)) : R;
        voffA[i] = (unsigned)C * 2u; voffB[i] = (unsigned)(Rb * K + C) * 2u; rowA[i] = R; }
    const size_t kstep = (size_t)(BK * 2);
    const size_t hstep = (size_t)HALF * K * 2;
    const size_t tstep = 2 * hstep;
    const unsigned ldsw = (unsigned)wid * 1024u;
    const int aoff = lds_byte(wr * 64 + fr, fq * 8), boff = lds_byte(wc * 32 + fr, fq * 8);
#define PG8_SA(b, h) (((b) * 2 + (h)) * HTB)
#define PG8_SB(b, h) ((4 + (b) * 2 + (h)) * HTB)
#define PG8_STAGE(bufoff, gbase, voff) do { _Pragma("unroll") for (int _i = 0; _i < 2; ++_i) \
        __builtin_amdgcn_global_load_lds((const unsigned*)((const char*)(gbase) + (voff)[_i]), (PG8_LAS unsigned*)(lds + (bufoff) + ldsw + _i * 8192), 16, 0, 0); } while (0)
#define PG8_LDA(dst, b, h) do { _Pragma("unroll") for (int m = 0; m < 4; ++m) _Pragma("unroll") for (int k = 0; k < 2; ++k) dst[m][k] = *(const PG8_LAS bf16x8*)(lds + PG8_SA(b, h) + aoff + m * 2048 + k * 1024); } while (0)
#define PG8_LDB(dst, b, h) do { _Pragma("unroll") for (int n = 0; n < 2; ++n) _Pragma("unroll") for (int k = 0; k < 2; ++k) dst[n][k] = *(const PG8_LAS bf16x8*)(lds + PG8_SB(b, h) + boff + n * 2048 + k * 1024); } while (0)
#define PG8_MMA(ai, bj, At, Bt) do { __builtin_amdgcn_s_setprio(1); _Pragma("unroll") for (int m = 0; m < 4; ++m) _Pragma("unroll") for (int n = 0; n < 2; ++n) _Pragma("unroll") for (int k = 0; k < 2; ++k) \
        acc[ai][bj][m][n] = __builtin_amdgcn_mfma_f32_16x16x32_bf16(Bt[n][k], At[m][k], acc[ai][bj][m][n], 0, 0, 0); __builtin_amdgcn_s_setprio(0); } while (0)
#define PG8_WAIT_V(n) asm volatile("s_waitcnt vmcnt(" #n ")" ::: "memory")
#define PG8_WAIT_L(n) asm volatile("s_waitcnt lgkmcnt(" #n ")" ::: "memory")
#define PG8_BAR __builtin_amdgcn_s_barrier()
#define PG8_SCHED __builtin_amdgcn_sched_barrier(0)
    Unit cur, nxt; int ui = 0;
    if (!S.next(0, cur)) return;
    unsigned cA0[2], cA1[2], nA0[2], nA1[2];
#define PG8_ROWS(pm_, o0, o1) do { _Pragma("unroll") for (int _i = 0; _i < 2; ++_i) { const int s0_ = rowmap[(pm_) * BM + rowA[_i]], s1_ = rowmap[(pm_) * BM + HALF + rowA[_i]]; \
        o0[_i] = (unsigned)((s0_ < 0 ? 0 : (s0_ >> 1)) * K) * 2u + voffA[_i]; o1[_i] = (unsigned)((s1_ < 0 ? 0 : (s1_ >> 1)) * K) * 2u + voffA[_i]; } } while (0)
    PG8_ROWS(cur.pm, cA0, cA1);
    f32x4 acc[2][2][4][2];
#pragma unroll
    for (int a = 0; a < 2; ++a)
#pragma unroll
        for (int b = 0; b < 2; ++b)
#pragma unroll
            for (int m = 0; m < 4; ++m)
#pragma unroll
                for (int n = 0; n < 2; ++n) acc[a][b][m][n] = (f32x4){0.f, 0.f, 0.f, 0.f};
    bf16x8 At[4][2], B0[2][2], B1[2][2];
    const char* const Ab = (const char*)g.A; const char* cB = (const char*)g.Bt + (size_t)cur.pn * tstep;
    S.a_ready(cur);
    if constexpr (SP2) {
        PG8_STAGE(PG8_SB(0, 0), cB, voffB); PG8_STAGE(PG8_SB(0, 1), cB + hstep, voffB); PG8_STAGE(PG8_SA(0, 0), Ab, cA0); PG8_STAGE(PG8_SA(0, 1), Ab, cA1);
        if (wr == 1) PG8_BAR;
        PG8_WAIT_V(2); PG8_BAR;
        PG8_STAGE(PG8_SB(1, 0), cB + kstep, voffB); PG8_STAGE(PG8_SA(1, 0), Ab + kstep, cA0); PG8_STAGE(PG8_SB(1, 1), cB + hstep + kstep, voffB);
        PG8_WAIT_V(6); PG8_BAR;
    } else {
        static_assert(SP2, "gather variant: SP2 schedule only");
    }
    for (;;) {
        const bool has_next = S.next(ui + 1, nxt);
        const char* nB = has_next ? (const char*)g.Bt + (size_t)nxt.pn * tstep : cB;
        if (has_next) PG8_ROWS(nxt.pm, nA0, nA1); else { nA0[0] = cA0[0]; nA0[1] = cA0[1]; nA1[0] = cA1[0]; nA1[1] = cA1[1]; }
        for (int t = 0; t < nt; t += 2) {
            const bool last = (t == nt - 2);
            const char* a1 = Ab + (size_t)(t + 1) * kstep;
            const char* a2 = last ? Ab : Ab + (size_t)(t + 2) * kstep; const char* b2 = last ? nB : cB + (size_t)(t + 2) * kstep;
            const char* a3 = a2 + kstep; const char* b3 = b2 + kstep;
            unsigned x0[2], x1[2];
            x0[0] = last ? nA0[0] : cA0[0]; x0[1] = last ? nA0[1] : cA0[1]; x1[0] = last ? nA1[0] : cA1[0]; x1[1] = last ? nA1[1] : cA1[1];
            if (last && has_next) S.a_ready(nxt);
            if constexpr (SP2) {
            PG8_LDB(B0, 0, 0); PG8_LDB(B1, 0, 1); PG8_SCHED; PG8_LDA(At, 0, 0); PG8_STAGE(PG8_SA(1, 1), a1, cA1);
            PG8_WAIT_V(8); PG8_WAIT_L(0); PG8_BAR; PG8_MMA(0, 0, At, B0); PG8_MMA(0, 1, At, B1); PG8_BAR; PG8_SCHED;
            PG8_LDA(At, 0, 1); PG8_STAGE(PG8_SB(0, 0), b2, voffB); PG8_STAGE(PG8_SB(0, 1), b2 + hstep, voffB); PG8_STAGE(PG8_SA(0, 0), a2, x0);
            PG8_WAIT_V(8); PG8_WAIT_L(0); PG8_BAR; PG8_MMA(1, 0, At, B0); PG8_MMA(1, 1, At, B1); PG8_BAR; PG8_SCHED;
            PG8_LDB(B0, 1, 0); PG8_LDB(B1, 1, 1); PG8_SCHED; PG8_LDA(At, 1, 0); PG8_STAGE(PG8_SA(0, 1), a2, x1);
            PG8_WAIT_V(8); PG8_WAIT_L(0); PG8_BAR; PG8_MMA(0, 0, At, B0); PG8_MMA(0, 1, At, B1); PG8_BAR; PG8_SCHED;
            PG8_LDA(At, 1, 1); PG8_STAGE(PG8_SB(1, 0), b3, voffB); PG8_STAGE(PG8_SB(1, 1), b3 + hstep, voffB); PG8_STAGE(PG8_SA(1, 0), a3, x0);
            PG8_WAIT_V(8); PG8_WAIT_L(0); PG8_BAR; PG8_MMA(1, 0, At, B0); PG8_MMA(1, 1, At, B1); PG8_BAR; PG8_SCHED;
            }
        }
        if constexpr (ALIGN_EPI) { if (wr == 0) PG8_BAR; }
        if constexpr (!Epi::AFTER_DRAIN) { E(acc, cur, wr, wc, fr, fq); S.done(cur); }
        if (!has_next) break;
#pragma unroll
        for (int a = 0; a < 2; ++a)
#pragma unroll
            for (int b = 0; b < 2; ++b)
#pragma unroll
                for (int m = 0; m < 4; ++m)
#pragma unroll
                    for (int n = 0; n < 2; ++n) acc[a][b][m][n] = (f32x4){0.f, 0.f, 0.f, 0.f};
        cur = nxt; cB = nB; ++ui; cA0[0] = nA0[0]; cA0[1] = nA0[1]; cA1[0] = nA1[0]; cA1[1] = nA1[1];
        if constexpr (ALIGN_EPI) { if (wr == 1) PG8_BAR; }
    }
    PG8_WAIT_V(0);
    if constexpr (!ALIGN_EPI) { if (wr == 0) PG8_BAR; }
    PG8_BAR;
    if constexpr (Epi::AFTER_DRAIN) { E.fused(acc, cur, wr, wc, fr, fq, lds, wid, lane); S.done(cur); }
#undef PG8_SA
#undef PG8_SB
#undef PG8_STAGE
#undef PG8_LDA
#undef PG8_LDB
#undef PG8_MMA
#undef PG8_WAIT_V
#undef PG8_WAIT_L
#undef PG8_BAR
#undef PG8_SCHED
#undef PG8_ROWS
}
}

#include <hip/hip_bf16.h>
namespace swa {
constexpr int D = 128; constexpr float THR = 8.f; constexpr bool WSKIP = false;
constexpr float SCALE = 0.08838834764831845f;
constexpr int NW = 8, QBLK = 32, KVBLK = 64, QB = NW * QBLK;
constexpr int SHM_V = KVBLK * D * 2, SHM_K = KVBLK * D * 2;
constexpr int SWA_LDS_BYTES = 2 * SHM_V + 2 * SHM_K + NW * 64 * 4;
constexpr int BZ_OFF = 69632;

using bf16 = __hip_bfloat16;
typedef short bf16x8 __attribute__((ext_vector_type(8)));
typedef short s16x4 __attribute__((ext_vector_type(4)));
typedef float f32x16 __attribute__((ext_vector_type(16)));
typedef float f32x4 __attribute__((ext_vector_type(4)));
typedef unsigned u32x4 __attribute__((ext_vector_type(4)));
template <class A, class Bt> struct same_t { static constexpr bool v = false; };
template <class A> struct same_t<A, A> { static constexpr bool v = true; };

#define KSWZ(row, colB) ((row) * 256 + ((colB) ^ (((row) & 7) << 4)))
#define SBAR() __builtin_amdgcn_sched_barrier(0)
__device__ __forceinline__ int v_st(int k, int c) { const int kk = (k & ~0xC) | ((k & 4) << 1) | ((k & 8) >> 1); return ((kk >> 3) * 4 + (c >> 5)) * 512 + ((kk & 7) * 32 + (c & 31)) * 2; }
__device__ __forceinline__ int v_rd_base(int lane) { return ((lane & 3) << 3) | (((lane >> 2) & 3) << 6) | (((lane >> 4) & 1) << 5) | (((lane >> 5) & 1) << 8); }
constexpr int v_rd_off(int d0, int ks, int half) { return d0 * 512 + ks * 4096 + half * 2048; }
__device__ __forceinline__ int crow(int r, int hi) { return (r & 3) + 8 * (r >> 2) + 4 * hi; }
__device__ __forceinline__ unsigned cvtpk(float lo, float hi) {
    unsigned r; asm volatile("v_cvt_pk_bf16_f32 %0, %1, %2" : "=v"(r) : "v"(lo), "v"(hi)); return r;
}
__device__ __forceinline__ bf16x8 pack8(f32x4 a, f32x4 b) {
    u32x4 w = {cvtpk(a[0], a[1]), cvtpk(a[2], a[3]), cvtpk(b[0], b[1]), cvtpk(b[2], b[3])};
    return *reinterpret_cast<bf16x8*>(&w);
}
template <class T> __device__ __forceinline__ bf16x8 load8(const T* p) {
    if constexpr (same_t<T, float>::v) { return pack8(*(const f32x4*)p, *(const f32x4*)(p + 4)); }
    else { return *reinterpret_cast<const bf16x8*>(p); }
}
__device__ __forceinline__ void mask_tile(f32x16& p0, f32x16& p1, int dq, unsigned W) {
    const float NEG = -__builtin_inff();
#pragma unroll
    for (int r = 0; r < 16; ++r) {
        const int c = (r & 3) + 8 * (r >> 2);
        if ((unsigned)(dq - c) >= W) p0[r] = NEG;
        if ((unsigned)(dq - c - 32) >= W) p1[r] = NEG;
    }
}
__device__ __forceinline__ void partialSM(f32x16& p0, f32x16& p1, float& m_reg, float& mn, float& alpha) {
    float pmax = p0[0]; for (int r = 1; r < 16; ++r) pmax = fmaxf(pmax, p0[r]); for (int r = 0; r < 16; ++r) pmax = fmaxf(pmax, p1[r]);
    { auto rr = __builtin_amdgcn_permlane32_swap(__float_as_uint(pmax), __float_as_uint(pmax), false, false);
      pmax = fmaxf(__uint_as_float(rr[0]), __uint_as_float(rr[1])); }
    constexpr float C2 = 1.4426950408889634f * SCALE;
    if (__builtin_expect(__all((pmax - m_reg) * SCALE <= THR), 1)) { mn = m_reg; alpha = 1.f; }
    else { mn = fmaxf(m_reg, pmax); alpha = __builtin_amdgcn_exp2f((m_reg - mn) * C2); m_reg = mn; }
    const float mnL = -mn * C2;
    for (int r = 0; r < 16; ++r) p0[r] = fmaf(p0[r], C2, mnL); for (int r = 0; r < 16; ++r) p1[r] = fmaf(p1[r], C2, mnL);
    for (int r = 0; r < 16; ++r) p0[r] = __builtin_amdgcn_exp2f(p0[r]);
}
__device__ __forceinline__ void finishSM(f32x16& p0, f32x16& p1, float alpha, float& l_reg, bf16x8& pa0, bf16x8& pa1, bf16x8& pa2, bf16x8& pa3) {
    for (int r = 0; r < 16; ++r) p1[r] = __builtin_amdgcn_exp2f(p1[r]);
    float ps = 0; for (int r = 0; r < 16; ++r) ps += p0[r]; for (int r = 0; r < 16; ++r) ps += p1[r];
    { auto rr = __builtin_amdgcn_permlane32_swap(__float_as_uint(ps), __float_as_uint(ps), false, false);
      ps = __uint_as_float(rr[0]) + __uint_as_float(rr[1]); }
    l_reg = l_reg * alpha + ps;
#define PK4(P, B_, OUT) do { unsigned a0 = cvtpk(P[B_+0], P[B_+1]), a1 = cvtpk(P[B_+2], P[B_+3]);                          \
        unsigned b0 = cvtpk(P[B_+4], P[B_+5]), b1 = cvtpk(P[B_+6], P[B_+7]);                                             \
        auto r0 = __builtin_amdgcn_permlane32_swap(a0, b0, false, false); auto r1 = __builtin_amdgcn_permlane32_swap(a1, b1, false, false); \
        u32x4 w = {r0[0], r1[0], r0[1], r1[1]}; OUT = *reinterpret_cast<bf16x8*>(&w); } while (0)
    PK4(p0, 0, pa0); PK4(p0, 8, pa1); PK4(p1, 0, pa2); PK4(p1, 8, pa3);
#undef PK4
}
template <int KB, bool SK, bool BIAS>
__device__ __forceinline__ void qkt(f32x16& p0, f32x16& p1, const char* K_lds, int r32, int hi, const bf16x8* qr, bool act, const float* bz) {
    if (SK && !act) { const float NEG = -__builtin_inff();
#pragma unroll
        for (int r = 0; r < 16; ++r) { p0[r] = NEG; p1[r] = NEG; } return; }
    if constexpr (BIAS) {
#pragma unroll
        for (int g = 0; g < 4; ++g) { const f32x4 b0 = *(const f32x4*)(bz + 8 * g + 4 * hi), b1 = *(const f32x4*)(bz + 32 + 8 * g + 4 * hi);
#pragma unroll
            for (int i = 0; i < 4; ++i) { p0[4 * g + i] = b0[i]; p1[4 * g + i] = b1[i]; } }
    } else { p0 = f32x16{}; p1 = f32x16{}; }
    const char* kb[4];
#pragma unroll
    for (int dd = 0; dd < 4; ++dd) kb[dd] = K_lds + KB * SHM_K + KSWZ(r32, (dd * 16 + hi * 8) * 2);
#pragma unroll
    for (int d0 = 0; d0 < 8; ++d0) { const char* a = kb[d0 & 3] + (d0 >> 2) * 128;
        bf16x8 b0 = *reinterpret_cast<const bf16x8*>(a);
        bf16x8 b1 = *reinterpret_cast<const bf16x8*>(a + 32 * 256);
        p0 = __builtin_amdgcn_mfma_f32_32x32x16_bf16(b0, qr[d0], p0, 0, 0, 0);
        p1 = __builtin_amdgcn_mfma_f32_32x32x16_bf16(b1, qr[d0], p1, 0, 0, 0); }
}
template <int VB, bool SK>
__device__ __forceinline__ void pv_tile(f32x16* o, int vb0, bf16x8 pa0, bf16x8 pa1, bf16x8 pa2, bf16x8 pa3, bool act) {
    if (SK && !act) return;
#define TRRD(dst, off) asm volatile("ds_read_b64_tr_b16 %0, %1 offset:%2" : "=&v"(dst) : "v"(vb0), "i"(off) : "memory")
#define PV_D0(d0) do { s16x4 l0, l1, l2, l3, h0, h1, h2, h3; constexpr int b_ = VB * SHM_V + v_rd_off(d0, 0, 0);     \
        TRRD(l0, b_); TRRD(h0, b_ + 2048); TRRD(l1, b_ + 4096); TRRD(h1, b_ + 6144); TRRD(l2, b_ + 8192); TRRD(h2, b_ + 10240); TRRD(l3, b_ + 12288); TRRD(h3, b_ + 14336); \
        asm volatile("s_waitcnt lgkmcnt(0)" ::: "memory"); SBAR();                 \
        o[d0] = __builtin_amdgcn_mfma_f32_32x32x16_bf16(pa0, (bf16x8){l0[0], l0[1], l0[2], l0[3], h0[0], h0[1], h0[2], h0[3]}, o[d0], 0, 0, 0);   \
        o[d0] = __builtin_amdgcn_mfma_f32_32x32x16_bf16(pa1, (bf16x8){l1[0], l1[1], l1[2], l1[3], h1[0], h1[1], h1[2], h1[3]}, o[d0], 0, 0, 0);   \
        o[d0] = __builtin_amdgcn_mfma_f32_32x32x16_bf16(pa2, (bf16x8){l2[0], l2[1], l2[2], l2[3], h2[0], h2[1], h2[2], h2[3]}, o[d0], 0, 0, 0);   \
        o[d0] = __builtin_amdgcn_mfma_f32_32x32x16_bf16(pa3, (bf16x8){l3[0], l3[1], l3[2], l3[3], h3[0], h3[1], h3[2], h3[3]}, o[d0], 0, 0, 0); } while (0)
    PV_D0(0); PV_D0(1); PV_D0(2); PV_D0(3);
#undef PV_D0
#undef TRRD
}

template <class TIn, class TOut> struct BlockRef { const TIn* Q; const TIn* K; const TIn* V; TOut* O; const float* Bz; int P0; int JLO; };
template <class TIn> struct Seam {
    bf16x8 qr[8];
    bf16x8 st_v0, st_v1, st_k0, st_k1; f32x4 sf0, sf1, sf2, sf3;
    f32x4 tq[16];
};
__device__ __forceinline__ int swa_jlo(int P0, int W) { const int lowk = P0 - W + 1; return lowk > 0 ? lowk / KVBLK : 0; }
__device__ __forceinline__ int swa_jlo2(int P0, int W, int jlo) { const int j = swa_jlo(P0, W); return j > jlo ? j : jlo; }
#define ROW(p, k0, rr) ((p) + (size_t)((k0) + (rr)) * D + sc)
#define VMW() asm volatile("s_waitcnt vmcnt(0)" ::: "memory")
#define VMWN(n) asm volatile("s_waitcnt vmcnt(%0)" :: "i"(n) : "memory")
#define SLOAD_H(Kp, Vp, k0) do { S.st_v0 = load8<TIn>(ROW(Vp, k0, sr)); S.st_v1 = load8<TIn>(ROW(Vp, k0, 32 + sr));              \
                         S.st_k0 = load8<TIn>(ROW(Kp, k0, sr)); S.st_k1 = load8<TIn>(ROW(Kp, k0, 32 + sr)); } while (0)
#define SWRITE_HK(bf) do { *(bf16x8*)(K_lds + (bf) * SHM_K + kws) = S.st_k0; *(bf16x8*)(K_lds + (bf) * SHM_K + kws + 32 * 256) = S.st_k1; } while (0)
#define SWRITE_HV(bf) do { *(bf16x8*)(V_lds + (bf) * SHM_V + vst0) = S.st_v0; *(bf16x8*)(V_lds + (bf) * SHM_V + vst1) = S.st_v1; } while (0)
#define SWRITE_H(bf) do { SWRITE_HV(bf); SWRITE_HK(bf); } while (0)
#define SLOAD_F(p, k0) do { S.sf0 = *(const f32x4*)ROW(p, k0, sr); S.sf1 = *(const f32x4*)(ROW(p, k0, sr) + 4);                \
                            S.sf2 = *(const f32x4*)ROW(p, k0, 32 + sr); S.sf3 = *(const f32x4*)(ROW(p, k0, 32 + sr) + 4); } while (0)
#define SWRITE_KF(bf) do { *(bf16x8*)(K_lds + (bf) * SHM_K + kws) = pack8(S.sf0, S.sf1); *(bf16x8*)(K_lds + (bf) * SHM_K + kws + 32 * 256) = pack8(S.sf2, S.sf3); } while (0)
#define SWRITE_VF(bf) do { *(bf16x8*)(V_lds + (bf) * SHM_V + vst0) = pack8(S.sf0, S.sf1); *(bf16x8*)(V_lds + (bf) * SHM_V + vst1) = pack8(S.sf2, S.sf3); } while (0)
template <class TIn, class TOut>
__device__ __forceinline__ void causal_swa_prime(const BlockRef<TIn, TOut>& cur, int W, char* lds, Seam<TIn>& S) {
    constexpr bool F32 = same_t<TIn, float>::v;
    int tid_ = threadIdx.x; asm volatile("" : "+v"(tid_)); const int tid = tid_, wid = __builtin_amdgcn_readfirstlane(tid >> 6), lane = tid & 63, r32 = lane & 31, hi = lane >> 5;
    const int sr = tid >> 4, sc = (tid & 15) * 8, kws = KSWZ(sr, sc * 2); char* K_lds = lds + 2 * SHM_V;
    const int kb0 = swa_jlo2(cur.P0, W, cur.JLO) * KVBLK;
    for (int d0 = 0; d0 < 8; ++d0) S.qr[d0] = load8<TIn>(cur.Q + (size_t)(wid * QBLK + r32) * D + d0 * 16 + hi * 8);
    if constexpr (F32) { SLOAD_F((const float*)cur.K, kb0); VMW(); SWRITE_KF(0); SBAR(); SLOAD_F((const float*)cur.V, kb0); }
    else { SLOAD_H(cur.K, cur.V, kb0); VMW(); SWRITE_HK(0); }
    __syncthreads();
}
template <class TIn, class TOut, int OLD, bool BIAS>
__device__ __forceinline__ void causal_swa_block(const BlockRef<TIn, TOut>& cur, const BlockRef<TIn, TOut>& nxt, int skv, int W, char* lds, Seam<TIn>& S) {
    constexpr bool F32 = same_t<TIn, float>::v;
    int tid_ = threadIdx.x; asm volatile("" : "+v"(tid_)); const int tid = tid_, wid = __builtin_amdgcn_readfirstlane(tid >> 6), lane = tid & 63, r32 = lane & 31, hi = lane >> 5;
    const int j_lo = swa_jlo2(cur.P0, W, cur.JLO);
    int j_hi = (cur.P0 + QB - 1) / KVBLK + 1; if (j_hi > skv / KVBLK) j_hi = skv / KVBLK;
    const int NT = j_hi - j_lo;
    const float* bzl = (const float*)(lds + BZ_OFF);
    if constexpr (BIAS) {
        float* bzw = (float*)(lds + BZ_OFF); const int nk = j_hi * KVBLK;
        for (int i = j_lo * KVBLK + tid * 4; i < nk; i += 64 * NW * 4) *(f32x4*)(bzw + i) = *(const f32x4*)(cur.Bz + i);
        __syncthreads();
    }
#define BZP(t) (bzl + KBASE(t))
    const int kbn = swa_jlo2(nxt.P0, W, nxt.JLO) * KVBLK;
    const int qlo = cur.P0 + wid * QBLK, qm = qlo + r32 - 4 * hi;
    char* V_lds = lds; char* K_lds = lds + 2 * SHM_V;
    float* ws = (float*)(lds + 2 * SHM_V + 2 * SHM_K) + wid * 64; float* li_l = ws, * al_l = ws + 32;
    float m_reg = -1e30f, l_reg = 0; f32x16 o[4] = {};
    const int sr = tid >> 4, sc = (tid & 15) * 8, vst0 = v_st(sr, sc), vst1 = v_st(32 + sr, sc), kws = KSWZ(sr, sc * 2);
    const int vb0 = (int)(uintptr_t)V_lds + v_rd_base(lane);
    const TIn* Kh = cur.K; const TIn* Vh = cur.V;
#define RESC(a) do { if (__any((a) < 1.f)) { if (hi == 0) al_l[r32] = (a); asm volatile("s_waitcnt lgkmcnt(0)" ::: "memory");              \
                     for (int d_ = 0; d_ < 4; ++d_) for (int r = 0; r < 16; ++r) o[d_][r] *= al_l[crow(r, hi)]; } } while (0)
#define KBASE(t) ((j_lo + (t)) * KVBLK)
#define ACT(t) (KBASE(t) <= qlo + QBLK - 1 && KBASE(t) + KVBLK - 1 >= qlo - W + 1)
#define MASKT(P0_, P1_, t) do { const int kb_ = KBASE(t); if ((!SK || ACT(t)) && (kb_ + KVBLK - 1 > qlo || kb_ <= qlo + QBLK - 1 - W)) mask_tile(P0_, P1_, qm - kb_, (unsigned)W); } while (0)
    constexpr int NQL = F32 ? 16 : 8;
    constexpr bool SK = WSKIP && !F32;
#define SEAM_K0() do { VMWN(NQL); if constexpr (F32) { SWRITE_KF(0); SBAR(); SLOAD_F((const float*)nxt.V, kbn); } else { SWRITE_HK(0); } SBAR(); } while (0)
    f32x16 pA0, pA1, pB0, pB1; float mnA, mnB, alA, alB; bf16x8 pa0, pa1, pa2, pa3;
    if constexpr (F32) { VMW(); SWRITE_VF(0); SBAR(); } else { SWRITE_HV(0); SBAR(); }
    if (NT > 1) { if constexpr (F32) SLOAD_F((const float*)Kh, KBASE(1)); else SLOAD_H(Kh, Vh, KBASE(1)); }
    SBAR(); qkt<0, SK, BIAS>(pA0, pA1, K_lds, r32, hi, S.qr, ACT(0), BZP(0));
    if constexpr (F32) { if (NT > 1) { VMW(); SWRITE_KF(1); SBAR(); SLOAD_F((const float*)Vh, KBASE(1)); } }
    MASKT(pA0, pA1, 0); partialSM(pA0, pA1, m_reg, mnA, alA);
    if (NT > 1) { VMW(); if constexpr (F32) { SWRITE_VF(1); SBAR(); if (NT > 2) SLOAD_F((const float*)Kh, KBASE(2)); } else SWRITE_H(1); }
    __syncthreads();
#define HALF_STEP(PX0, PX1, mnX, alX, PY0, PY1, alY, t, KB, VB, SB) do {                                                      \
        SBAR(); qkt<KB, SK, BIAS>(PX0, PX1, K_lds, r32, hi, S.qr, ACT(t), BZP(t));                                             \
        finishSM(PY0, PY1, alY, l_reg, pa0, pa1, pa2, pa3); SBAR();                                                           \
        if ((t) + 1 < NT) { if constexpr (F32) { VMW(); SWRITE_KF(SB); SBAR(); SLOAD_F((const float*)Vh, KBASE((t) + 1)); }  \
                            else { SLOAD_H(Kh, Vh, KBASE((t) + 1)); } SBAR(); }                                               \
        pv_tile<VB, SK>(o, vb0, pa0, pa1, pa2, pa3, ACT((t) - 1)); MASKT(PX0, PX1, (t)); partialSM(PX0, PX1, m_reg, mnX, alX);                                        \
        __syncthreads();                                                                                                      \
        if ((t) + 1 < NT) { VMW(); if constexpr (F32) { SWRITE_VF(SB); SBAR(); if ((t) + 2 < NT) SLOAD_F((const float*)Kh, KBASE((t) + 2)); } \
                            else { SWRITE_H(SB); } }                                                                          \
        RESC(alX); __syncthreads(); } while (0)
    for (int t = 1; t + 1 < NT; t += 2) {
        HALF_STEP(pB0, pB1, mnB, alB, pA0, pA1, alA, t, 1, 0, 0);
        HALF_STEP(pA0, pA1, mnA, alA, pB0, pB1, alB, t + 1, 0, 1, 1);
    }
    const bool even = (NT & 1) == 0;
    if (even) { SBAR(); qkt<1, SK, BIAS>(pB0, pB1, K_lds, r32, hi, S.qr, ACT(NT - 1), BZP(NT - 1)); SBAR(); }
#define QROW(e) (nxt.Q + (size_t)(wid * QBLK + r32) * D + ((e) >> 1) * 16 + hi * 8 + ((e) & 1) * 4)
    if constexpr (F32) { SLOAD_F((const float*)nxt.K, kbn); SBAR();
#pragma unroll
        for (int e = 0; e < 8; ++e) S.tq[e] = *(const f32x4*)QROW(e); }
    else { SLOAD_H(nxt.K, nxt.V, kbn); SBAR();
#pragma unroll
        for (int d0 = 0; d0 < 8; ++d0) S.qr[d0] = load8<TIn>(nxt.Q + (size_t)(wid * QBLK + r32) * D + d0 * 16 + hi * 8); }
    SBAR();
    finishSM(pA0, pA1, alA, l_reg, pa0, pa1, pa2, pa3); SBAR();
    if constexpr (F32) {
#pragma unroll
        for (int e = 8; e < 16; ++e) S.tq[e] = *(const f32x4*)QROW(e); SBAR(); }
#undef QROW
    pv_tile<0, SK>(o, vb0, pa0, pa1, pa2, pa3, ACT(even ? NT - 2 : NT - 1));
    if (even) { MASKT(pB0, pB1, NT - 1); partialSM(pB0, pB1, m_reg, mnB, alB); __syncthreads(); RESC(alB);
        finishSM(pB0, pB1, alB, l_reg, pa0, pa1, pa2, pa3); SBAR(); pv_tile<1, SK>(o, vb0, pa0, pa1, pa2, pa3, ACT(NT - 1)); }
    SBAR(); SEAM_K0();
    if (hi == 0) li_l[r32] = l_reg; asm volatile("s_waitcnt lgkmcnt(0)" ::: "memory");
    float rli[16];
#pragma unroll
    for (int r = 0; r < 16; ++r) rli[r] = __builtin_amdgcn_rcpf(li_l[crow(r, hi)]);
    TOut* Ow = cur.O + (size_t)(wid * QBLK) * OLD;
#pragma unroll
    for (int r = 0; r < 16; ++r) { const int orow = crow(r, hi);
#pragma unroll
        for (int d0 = 0; d0 < 4; ++d0) { const float v = o[d0][r] * rli[r];
            if constexpr (same_t<TOut, float>::v) { Ow[(size_t)orow * OLD + d0 * 32 + r32] = v; }
            else { const float vn = __shfl_xor(v, 1);
                   if ((r32 & 1) == 0) *(unsigned*)(Ow + (size_t)orow * OLD + d0 * 32 + r32) = cvtpk(v, vn); } } }
    if constexpr (F32) {
#pragma unroll
        for (int d0 = 0; d0 < 8; ++d0) S.qr[d0] = pack8(S.tq[2 * d0], S.tq[2 * d0 + 1]); }
    __syncthreads();
#undef RESC
#undef KBASE
#undef BZP
#undef ACT
#undef MASKT
#undef SEAM_K0
#undef HALF_STEP
}
#undef ROW
#undef VMW
#undef VMWN
#undef SLOAD_H
#undef SWRITE_HK
#undef SWRITE_HV
#undef SWRITE_H
#undef SLOAD_F
#undef SWRITE_KF
#undef SWRITE_VF
}

namespace {
constexpr int D = 2048, NB = 4, S = 4096, NTOK = NB * S;
constexpr int NTHR = 512;
constexpr int MAXSLOT = 40960;
constexpr int NPANEL = MAXSLOT / 256;
constexpr float LN_EPS = 1e-5f, RMS_EPS = 1e-5f;
constexpr float ALPHA = 1.41421356237309515f;
constexpr float LAM_INIT0 = 0.2f;


#define XB_TMO      128
#define XB_XCNT(j)  (256  + 64 * (j))
#define XB_XSUB(j)  (1280 + 64 * (j))
#define XB_XGEN(j)  (2304 + 64 * (j))
#define XB_TOP      3328
#define XB_TOPGEN   3392
#define XCD_BAR_WORDS 3456
#define XB_SPIN_CAP (1u << 18)
#define LAS __attribute__((address_space(3)))
__device__ __forceinline__ unsigned xb_ld(unsigned* p)              { return __hip_atomic_load(p, __ATOMIC_RELAXED, __HIP_MEMORY_SCOPE_AGENT); }
__device__ __forceinline__ unsigned xb_add(unsigned* p, unsigned v) { return __hip_atomic_fetch_add(p, v, __ATOMIC_RELAXED, __HIP_MEMORY_SCOPE_AGENT); }
__device__ __forceinline__ unsigned xb_xcc_id() { return (unsigned)__builtin_amdgcn_s_getreg((3 << 11) | 20) & 0xFu; }
#define XB_SPIN(cond, bar) do { unsigned _sp = 0; while (cond) { __builtin_amdgcn_s_sleep(1); \
    if ((++_sp & 255u) == 0u) { if (xb_ld(&(bar)[XB_TMO])) break; if (_sp > XB_SPIN_CAP) { atomicAdd(&(bar)[XB_TMO], 1u); break; } } } } while (0)
struct XcdBarrier { unsigned* bar; unsigned x; volatile LAS unsigned* st; };
__device__ __forceinline__ XcdBarrier xcd_barrier_post(unsigned* bar, volatile LAS unsigned* st) {
    XcdBarrier b; b.bar = bar; b.x = (unsigned)__builtin_amdgcn_readfirstlane((int)xb_xcc_id()); b.st = st;
    if (threadIdx.x == 0) (void)xb_add(&bar[XB_XCNT(b.x)], 1u);
    return b;
}
__device__ __forceinline__ void xcd_barrier_complete(unsigned* bar, unsigned x, unsigned& nloc, unsigned& nx) {
    const unsigned G = gridDim.x * gridDim.y * gridDim.z;
    unsigned sum, cnt, mine, sp = 0u;
    for (;;) {
        sum = 0u; cnt = 0u; mine = 0u;
#pragma unroll
        for (unsigned j = 0; j < 16; ++j) { const unsigned c = xb_ld(&bar[XB_XCNT(j)]); sum += c; cnt += (c > 0u) ? 1u : 0u; mine = (j == x) ? c : mine; }
        if (sum == G) break;
        __builtin_amdgcn_s_sleep(1);
        if ((++sp & 255u) == 0u) { if (xb_ld(&bar[XB_TMO])) break; if (sp > XB_SPIN_CAP) { atomicAdd(&bar[XB_TMO], 1u); break; } }
    }
    nloc = mine > 0u ? mine : 1u; nx = cnt > 0u ? cnt : 1u;
}
__device__ __forceinline__ void xcd_barrier(const XcdBarrier& b) {
    asm volatile("s_waitcnt vmcnt(0)" ::: "memory");
    __syncthreads();
    int t0_ = threadIdx.x; asm volatile("" : "+v"(t0_));
    if (t0_ == 0) {
        unsigned* bar = b.bar;
        unsigned bx = b.x; asm volatile("" : "+s"(bx));
        __builtin_amdgcn_s_waitcnt(0);
        unsigned nloc = b.st[0], nx = b.st[1];
        if (nloc == 0u) { xcd_barrier_complete(bar, bx, nloc, nx); b.st[0] = nloc; b.st[1] = nx; }
        const unsigned old = xb_add(&bar[XB_XSUB(bx)], 1u);
        const unsigned gen = old / nloc;
        if (old + 1u == (gen + 1u) * nloc) {
            __builtin_amdgcn_fence(__ATOMIC_RELEASE, "agent");
            asm volatile("s_waitcnt vmcnt(0)" ::: "memory");
            const unsigned og = xb_add(&bar[XB_TOP], 1u);
            const unsigned tg = og / nx;
            if (og + 1u == (tg + 1u) * nx) xb_add(&bar[XB_TOPGEN], 1u);
            else XB_SPIN(xb_ld(&bar[XB_TOPGEN]) == tg, bar);
            __builtin_amdgcn_fence(__ATOMIC_ACQUIRE, "agent");
            xb_add(&bar[XB_XGEN(bx)], 1u);
            asm volatile("s_waitcnt vmcnt(0)" ::: "memory");
        } else {
            XB_SPIN(xb_ld(&bar[XB_XGEN(bx)]) == gen, bar);
            __builtin_amdgcn_fence(__ATOMIC_ACQUIRE, "agent");
            asm volatile("s_waitcnt vmcnt(0)" ::: "memory");
        }
    }
    __syncthreads();
}

__device__ __forceinline__ float wave_sum(float v) {
#pragma unroll
    for (int o = 32; o >= 1; o >>= 1) v += __shfl_xor(v, o);
    return v;
}
__device__ __forceinline__ float wave_max(float v) {
#pragma unroll
    for (int o = 32; o >= 1; o >>= 1) v = fmaxf(v, __shfl_xor(v, o));
    return v;
}

extern __shared__ __attribute__((aligned(16))) unsigned char g_lds[];
constexpr int RING_BYTES = 131072, LDS_BYTES = 147456, LDSCTL_OFF = LDS_BYTES - 256;
__device__ __forceinline__ int obid() { int b = blockIdx.x; asm volatile("" : "+s"(b)); return b; }
__device__ __forceinline__ int otid() { int t = threadIdx.x; asm volatile("" : "+v"(t)); return t; }

struct ModF {
    const float* c; const float* w0; const float* w1; float* modp;
    __device__ __forceinline__ void operator()(int vb) const {
        float (*sc)[128] = (float (*)[128])g_lds;
        const int tid = otid();
        const int kc = vb & 15, nb = (vb >> 4) % 12, set = vb / 192, n = nb * NTHR + tid, k0 = kc * 128;
        const float* W = ((set & 1) ? w1 : w0) + (size_t)(set >> 1) * D * 3 * D + (size_t)k0 * (3 * D) + n;
        __syncthreads();
        { const float v = c[(tid >> 7) * D + k0 + (tid & 127)]; sc[tid >> 7][tid & 127] = v / (1.f + expf(-v)); }
        __syncthreads();
        float a0 = 0.f, a1 = 0.f, a2 = 0.f, a3 = 0.f;
#pragma unroll 16
        for (int k = 0; k < 128; ++k) { const float w = W[(size_t)k * (3 * D)]; a0 += sc[0][k] * w; a1 += sc[1][k] * w; a2 += sc[2][k] * w; a3 += sc[3][k] * w; }
        float* o = modp + ((size_t)(kc * 4 + set) * NB) * 3 * D + n;
        o[0 * 3 * D] = a0; o[1 * 3 * D] = a1; o[2 * 3 * D] = a2; o[3 * 3 * D] = a3;
    }
};
struct ModRedF {
    const float* modp; const float* b0; const float* b1; float* out;
    __device__ __forceinline__ void operator()(int vb) const {
        const int i = vb * NTHR + otid();
        const int n = i % (3 * D), set = i / (NB * 3 * D);
        float a = ((set & 1) ? b1 : b0)[(size_t)(set >> 1) * 3 * D + n];
#pragma unroll
        for (int kc = 0; kc < 16; ++kc) a += modp[(size_t)kc * 4 * NB * 3 * D + i];
        out[i] = a;
    }
};

typedef unsigned short bf16_t;
__device__ __forceinline__ unsigned pkbf(float lo, float hi) { unsigned r; asm volatile("v_cvt_pk_bf16_f32 %0, %1, %2" : "=v"(r) : "v"(lo), "v"(hi)); return r; }
struct ModulateF {
    const float* x; const float* mod; float* h; bf16_t* hb;
    __device__ __forceinline__ void operator()(int vb) const {
        const size_t i4 = (size_t)vb * NTHR + otid();
        const size_t e = i4 * 4; const int t = (int)(e / D), d = (int)(e % D), b = t / S;
        const float4 xv = *(const float4*)(x + e);
        const float4 sh = *(const float4*)(mod + (size_t)b * 3 * D + d);
        const float4 sc = *(const float4*)(mod + (size_t)b * 3 * D + D + d);
        float4 o; o.x = xv.x * (1.f + sc.x) + sh.x; o.y = xv.y * (1.f + sc.y) + sh.y; o.z = xv.z * (1.f + sc.z) + sh.z; o.w = xv.w * (1.f + sc.w) + sh.w;
        if (h) *(float4*)(h + e) = o;
        if (hb) { uint2 w; w.x = pkbf(o.x, o.y); w.y = pkbf(o.z, o.w); *(uint2*)(hb + e) = w; }
    }
};
struct Mod0F {
    const float* x; const float* modp; const float* bias; bf16_t* hb;
    __device__ __forceinline__ void run() const {
        float* sv = (float*)g_lds;
        const int tid = otid(), wave = tid >> 6, lane = tid & 63;
        const int G = gridDim.x, per = G >> 2, bid = obid();
        if (per == 0 || bid >= 4 * per) return;
        const int b = bid / per, r = bid - b * per;
        __syncthreads();
        for (int i = tid; i < 2 * D; i += NTHR) { float a = bias[i];
#pragma unroll
            for (int kc = 0; kc < 16; ++kc) a += modp[((size_t)(kc * 4 + 0) * NB + b) * 3 * D + i];
            sv[i] = a; }
        __syncthreads();
        for (int row = r * 8 + wave; row < S; row += per * 8) { const size_t t = (size_t)b * S + row;
            float4 xv[8];
#pragma unroll
            for (int i = 0; i < 8; ++i) xv[i] = *(const float4*)(x + t * D + (i * 64 + lane) * 4);
#pragma unroll
            for (int i = 0; i < 8; ++i) { const int d = (i * 64 + lane) * 4; const float4 s4 = *(const float4*)(sv + d), c4 = *(const float4*)(sv + D + d);
                uint2 w; w.x = pkbf(xv[i].x * (1.f + c4.x) + s4.x, xv[i].y * (1.f + c4.y) + s4.y); w.y = pkbf(xv[i].z * (1.f + c4.z) + s4.z, xv[i].w * (1.f + c4.w) + s4.w);
                *(uint2*)(hb + t * D + d) = w; } }
        __syncthreads();
    }
};
struct ConvF {
    const float* src; bf16_t* dst;
    __device__ __forceinline__ void operator()(int vb) const {
        const size_t e = ((size_t)vb * NTHR + otid()) * 4;
        const float4 v = *(const float4*)(src + e); uint2 w; w.x = pkbf(v.x, v.y); w.y = pkbf(v.z, v.w); *(uint2*)(dst + e) = w;
    }
};
struct TransF {
    const float* W; bf16_t* WT; int K, ldw, ncols, ileave;
    __device__ __forceinline__ int nitems() const { return (K / 64) * (ncols / 64); }
    __device__ __forceinline__ void load(int it, int lane, float4 (&v)[16]) const {
        const int nblk = ncols / 64, kb = it / nblk, nb = it - kb * nblk, k0 = 64 * kb, n0 = 64 * nb;
        const int n4 = lane & 15, kr = lane >> 4;
        const float* src = W + (size_t)(k0 + kr * 16) * ldw + n0 + 4 * n4;
#pragma unroll
        for (int i = 0; i < 16; ++i) v[i] = *(const float4*)(src + (size_t)i * ldw);
    }
    __device__ __forceinline__ void item(int it, int wave, int lane) const { float4 v[16]; load(it, lane, v); finish(it, wave, lane, v); }
    __device__ __forceinline__ void finish(int it, int wave, int lane, const float4 (&v)[16]) const {
        unsigned char* scr = g_lds + wave * 16384;
        const int nblk = ncols / 64, kb = it / nblk, nb = it - kb * nblk, k0 = 64 * kb, n0 = 64 * nb;
        const int n4 = lane & 15, kr = lane >> 4;
#pragma unroll
        for (int j = 0; j < 4; ++j) { uint4 lo4, hi4;
            const float e0 = j == 0 ? v[0].x : j == 1 ? v[0].y : j == 2 ? v[0].z : v[0].w; (void)e0;
#define TF_EL(i) (j == 0 ? v[i].x : j == 1 ? v[i].y : j == 2 ? v[i].z : v[i].w)
            lo4.x = pkbf(TF_EL(0), TF_EL(1)); lo4.y = pkbf(TF_EL(2), TF_EL(3)); lo4.z = pkbf(TF_EL(4), TF_EL(5)); lo4.w = pkbf(TF_EL(6), TF_EL(7));
            hi4.x = pkbf(TF_EL(8), TF_EL(9)); hi4.y = pkbf(TF_EL(10), TF_EL(11)); hi4.z = pkbf(TF_EL(12), TF_EL(13)); hi4.w = pkbf(TF_EL(14), TF_EL(15));
#undef TF_EL
            unsigned char* d = scr + (4 * n4 + j) * 144 + kr * 32;
            *(uint4*)d = lo4; *(uint4*)(d + 16) = hi4; }
        asm volatile("s_waitcnt lgkmcnt(0)" ::: "memory");
        const int c = lane & 7;
        uint4 ov[8];
#pragma unroll
        for (int j = 0; j < 8; ++j) ov[j] = *(const uint4*)(scr + ((lane >> 3) + 8 * j) * 144 + c * 16);
#pragma unroll
        for (int j = 0; j < 8; ++j) { const int n = (lane >> 3) + 8 * j; const uint4 o = ov[j];
            const int nn = n0 + n;
            const int dr = ileave == 0 ? nn : (ileave == 3 ? (nn < 4096 ? ((nn >> 8) * 256 + ((nn >> 6) & 1) * 128 + ((nn >> 7) & 1) * 64 + (nn & 63)) : nn)
                                                         : ((nn >> 7) * 256 + (ileave - 1) * 128 + (nn & 127)));
            *(uint4*)(WT + (size_t)dr * K + k0 + 8 * c) = o; }
        asm volatile("s_waitcnt lgkmcnt(0)" ::: "memory");
    }
    __device__ __forceinline__ void run() const {
        const int tid = otid(), wave = tid >> 6, lane = tid & 63;
        for (int it = obid() * 8 + wave; it < nitems(); it += gridDim.x * 8) item(it, wave, lane);
    }
};

struct GemmF {
    const float* A; const float* B; float* C;
    const int* rowidx;
    const int* panel_e;
    long long strideBe;
    int lda, ldb, ldc, M, N, K;
    int transB, causal;
    int tilesN, pad0;
    __device__ __forceinline__ void operator()(int vb) const {
        float (*As)[132] = (float (*)[132])g_lds; float (*Bs)[132] = (float (*)[132])(g_lds + 16 * 132 * 4);
        const int tm = vb / tilesN, tn = vb % tilesN, m0 = tm * 128, n0 = tn * 128;
        const float* Bp = B;
        if (panel_e) { const int e = panel_e[m0 >> 8]; if (e < 0) return; Bp += (size_t)e * strideBe; }
        if (causal == 1 && n0 > m0 + 127) return;
        int Kend = K; if (causal == 2 && m0 + 128 < K) Kend = m0 + 128;
        const int tid = otid(), tx = tid & 31, ty = tid >> 5;
        float acc[8][4];
#pragma unroll
        for (int i = 0; i < 8; ++i)
#pragma unroll
            for (int j = 0; j < 4; ++j) acc[i][j] = 0.f;
        const int ar = tid >> 2, ak = (tid & 3) * 4;
        long long arow = m0 + ar; bool aval = arow < M;
        if (rowidx && aval) { const int ri = rowidx[arow]; aval = ri >= 0; arow = ri; }
        const float* Ap = A + (aval ? arow : 0) * (long long)lda + ak;
        int bk, bn; if (!transB) { bk = tid >> 5; bn = (tid & 31) * 4; } else { bn = tid >> 2; bk = (tid & 3) * 4; }
        const bool bval = (n0 + bn) < N;
        for (int k0 = 0; k0 < Kend; k0 += 16) {
            float4 av = make_float4(0.f, 0.f, 0.f, 0.f), bv = make_float4(0.f, 0.f, 0.f, 0.f);
            if (aval) av = *(const float4*)(Ap + k0);
            if (bval) { if (!transB) bv = *(const float4*)(Bp + (size_t)(k0 + bk) * ldb + n0 + bn); else bv = *(const float4*)(Bp + (size_t)(n0 + bn) * ldb + k0 + bk); }
            __syncthreads();
            As[ak + 0][ar] = av.x; As[ak + 1][ar] = av.y; As[ak + 2][ar] = av.z; As[ak + 3][ar] = av.w;
            if (!transB) { *(float4*)&Bs[bk][bn] = bv; } else { Bs[bk + 0][bn] = bv.x; Bs[bk + 1][bn] = bv.y; Bs[bk + 2][bn] = bv.z; Bs[bk + 3][bn] = bv.w; }
            __syncthreads();
#pragma unroll
            for (int kk = 0; kk < 16; ++kk) {
                const float4 a0 = *(const float4*)&As[kk][ty * 8], a1 = *(const float4*)&As[kk][ty * 8 + 4], b = *(const float4*)&Bs[kk][tx * 4];
                const float a[8] = {a0.x, a0.y, a0.z, a0.w, a1.x, a1.y, a1.z, a1.w};
#pragma unroll
                for (int i = 0; i < 8; ++i) { acc[i][0] += a[i] * b.x; acc[i][1] += a[i] * b.y; acc[i][2] += a[i] * b.z; acc[i][3] += a[i] * b.w; }
            }
        }
        const int col = n0 + tx * 4;
        if (col < N) {
#pragma unroll
            for (int i = 0; i < 8; ++i) { const int row = m0 + ty * 8 + i; if (row < M) *(float4*)(C + (size_t)row * ldc + col) = make_float4(acc[i][0], acc[i][1], acc[i][2], acc[i][3]); }
        }
        __syncthreads();
    }
};

struct RopeTab { float inv_freq[64]; };
struct RopeTableF {
    float* tab;
    __device__ __forceinline__ void operator()(int vb) const {
        const int idx = vb * NTHR + otid(); const int s = idx >> 6, i = idx & 63;
        const float inv_freq = (float)exp2(-(double)i * (13.287712379549449 / 64.0));
        const float angf = (float)s * inv_freq;
        double r = (double)angf;
        const double k = rint(r * 0.63661977236758134308);
        r = fma(-k, 1.57079632679489655800e+00, r); r = fma(-k, 6.12323399573676603587e-17, r);
        const int q = ((int)k) & 3;
        const double r2 = r * r;
        double sn = -1.0 / 6227020800.0 * -1.0;
        sn = 1.0 / 6227020800.0;
        sn = sn * r2 - 1.0 / 39916800.0; sn = sn * r2 + 1.0 / 362880.0; sn = sn * r2 - 1.0 / 5040.0; sn = sn * r2 + 1.0 / 120.0; sn = sn * r2 - 1.0 / 6.0; sn = sn * r2 + 1.0; sn = sn * r;
        double cs = -1.0 / 87178291200.0;
        cs = cs * r2 + 1.0 / 479001600.0; cs = cs * r2 - 1.0 / 3628800.0; cs = cs * r2 + 1.0 / 40320.0; cs = cs * r2 - 1.0 / 720.0; cs = cs * r2 + 1.0 / 24.0; cs = cs * r2 - 0.5; cs = cs * r2 + 1.0;
        double c, sv;
        if (q == 0) { c = cs; sv = sn; } else if (q == 1) { c = -sn; sv = cs; } else if (q == 2) { c = -cs; sv = -sn; } else { c = sn; sv = -cs; }
        tab[(size_t)idx * 2] = (float)c; tab[(size_t)idx * 2 + 1] = (float)sv;
    }
};
struct RopeF {
    float* p; const float* tab; int ld, pad0;
    __device__ __forceinline__ void operator()(int vb) const {
        const int idx = vb * NTHR + otid();
        const int i = idx & 63, head = (idx >> 6) & 31, s = idx >> 11;
        float* q = p + (size_t)s * ld + head * 128 + i;
        const float c = tab[((size_t)s * 64 + i) * 2], sn = tab[((size_t)s * 64 + i) * 2 + 1];
        const float x1 = q[0], x2 = q[64];
        q[0] = x1 * c - x2 * sn; q[64] = x2 * c + x1 * sn;
    }
};

struct LamF {
    const float* q1; const float* k1; const float* q2; const float* k2; float* lam;
    __device__ __forceinline__ void operator()(int vb) const {
        const int tid = otid();
        if (tid < 64) {
            float a = q1[tid] * k1[tid] + q1[tid + 64] * k1[tid + 64], b = q2[tid] * k2[tid] + q2[tid + 64] * k2[tid + 64];
            a = wave_sum(a); b = wave_sum(b);
            if (tid == 0) lam[0] = expf(a) - expf(b) + LAM_INIT0;
        }
    }
};

struct SoftmaxF {
    float* S1; float* S2;
    const float* lam; const float* cum;
    float scale; int pad0;
    __device__ __forceinline__ void operator()(int vb) const {
        const int tid = otid(), wave = tid >> 6, lane = tid & 63;
        const int i = vb * 8 + wave;
        float* r1 = S1 + (size_t)i * S; float* r2 = S2 ? S2 + (size_t)i * S : nullptr;
        const float ci = cum ? cum[i] : 0.f;
        float m1 = -INFINITY, m2 = -INFINITY;
        for (int j = lane; j <= i; j += 64) {
            float s = r1[j] * scale; if (cum) s += ci - cum[j]; m1 = fmaxf(m1, s);
            if (r2) m2 = fmaxf(m2, r2[j] * scale);
        }
        m1 = wave_max(m1); m2 = wave_max(m2);
        float l1 = 0.f, l2 = 0.f;
        for (int j = lane; j <= i; j += 64) {
            float s = r1[j] * scale; if (cum) s += ci - cum[j]; l1 += expf(s - m1);
            if (r2) l2 += expf(r2[j] * scale - m2);
        }
        l1 = wave_sum(l1); l2 = wave_sum(l2);
        const float lm = r2 ? lam[0] : 0.f;
        const int jend = ((i >> 7) + 1) << 7;
        for (int j = lane; j < jend; j += 64) {
            float o = 0.f;
            if (j <= i) {
                float s = r1[j] * scale; if (cum) s += ci - cum[j];
                o = expf(s - m1) / l1;
                if (r2) o -= lm * (expf(r2[j] * scale - m2) / l2);
            }
            r1[j] = o;
        }
    }
};

struct RmsF {
    float* o; const float* w; bf16_t* ob;
    __device__ __forceinline__ void operator()(int vb) const {
        const int tid = otid(), wave = tid >> 6, lane = tid & 63;
        const size_t g = (size_t)vb * 8 + wave;
        float4 v = *(float4*)(o + g * 256 + lane * 4);
        float ss = v.x * v.x + v.y * v.y + v.z * v.z + v.w * v.w; ss = wave_sum(ss);
        const float r = 1.0f / sqrtf(ss * (1.f / 256.f) + RMS_EPS) * (1.f - LAM_INIT0);
        const float4 ww = *(const float4*)(w + lane * 4);
        v.x = v.x * r * ww.x; v.y = v.y * r * ww.y; v.z = v.z * r * ww.z; v.w = v.w * r * ww.w;
        *(float4*)(o + g * 256 + lane * 4) = v;
        if (ob) { uint2 q; q.x = pkbf(v.x, v.y); q.y = pkbf(v.z, v.w); *(uint2*)(ob + g * 256 + lane * 4) = q; }
    }
};

struct CumF {
    const float* proj; const float* fb; float* cum; int ld, pad0;
    __device__ __forceinline__ void operator()(int vb) const {
        float* tot = (float*)g_lds;
        const int h = vb, tid = otid();
        float v[8]; float run = 0.f;
#pragma unroll
        for (int j = 0; j < 8; ++j) { const float x = proj[(size_t)(tid * 8 + j) * ld + 6144 + h] + fb[h];
            const float ls = fminf(x, 0.f) - log1pf(expf(-fabsf(x))); run += ls; v[j] = run; }
        __syncthreads();
        tot[tid] = run;
        __syncthreads();
        if (tid == 0) { float a = 0.f; for (int i = 0; i < NTHR; ++i) { const float t = tot[i]; tot[i] = a; a += t; } }
        __syncthreads();
        const float off = tot[tid];
#pragma unroll
        for (int j = 0; j < 8; ++j) cum[(size_t)h * S + tid * 8 + j] = v[j] + off;
        __syncthreads();
    }
};

struct LnF {
    const float* x; const float* ya; const int* tok_slot;
    const bf16_t* yb;
    const float* mod; const float* g; const float* bta; float* out;
    __device__ __forceinline__ void operator()(int vb) const {
        const int tid = otid(), wave = tid >> 6, lane = tid & 63;
        const int t = vb * 8 + wave, b = t / S;
        const float* xr = x + (size_t)t * D; const float* gt = mod + (size_t)b * 3 * D + 2 * D;
        const float* y0; const float* y1 = nullptr;
        if (tok_slot) { y0 = ya + (size_t)tok_slot[2 * t] * D; y1 = ya + (size_t)tok_slot[2 * t + 1] * D; } else y0 = ya + (size_t)t * D;
        if (yb) { y0 = xr; y1 = nullptr; }
        float4 z[8]; float sum = 0.f;
#pragma unroll
        for (int i = 0; i < 8; ++i) { const int d = (i * 64 + lane) * 4;
            const float4 xv = *(const float4*)(xr + d), gv = *(const float4*)(gt + d); float4 yv;
            if (yb) { const uint2 a = *(const uint2*)(yb + (size_t)(2 * t) * D + d), bq = *(const uint2*)(yb + (size_t)(2 * t + 1) * D + d);
                yv.x = __uint_as_float(a.x << 16) + __uint_as_float(bq.x << 16); yv.y = __uint_as_float(a.x & 0xffff0000u) + __uint_as_float(bq.x & 0xffff0000u);
                yv.z = __uint_as_float(a.y << 16) + __uint_as_float(bq.y << 16); yv.w = __uint_as_float(a.y & 0xffff0000u) + __uint_as_float(bq.y & 0xffff0000u); }
            else yv = *(const float4*)(y0 + d);
            if (y1) { const float4 y2 = *(const float4*)(y1 + d); yv.x += y2.x; yv.y += y2.y; yv.z += y2.z; yv.w += y2.w; }
            z[i].x = ALPHA * xv.x + (1.f + gv.x) * yv.x; z[i].y = ALPHA * xv.y + (1.f + gv.y) * yv.y; z[i].z = ALPHA * xv.z + (1.f + gv.z) * yv.z; z[i].w = ALPHA * xv.w + (1.f + gv.w) * yv.w;
            sum += (z[i].x + z[i].y) + (z[i].z + z[i].w); }
        sum = wave_sum(sum); const float mu = sum * (1.f / D);
        float var = 0.f;
#pragma unroll
        for (int i = 0; i < 8; ++i) { const float a = z[i].x - mu, bq = z[i].y - mu, c = z[i].z - mu, dd = z[i].w - mu; var += (a * a + bq * bq) + (c * c + dd * dd); }
        var = wave_sum(var) * (1.f / D);
        const float rs = 1.0f / sqrtf(var + LN_EPS);
#pragma unroll
        for (int i = 0; i < 8; ++i) { const int d = (i * 64 + lane) * 4; const float4 gg = *(const float4*)(g + d), bb = *(const float4*)(bta + d);
            float4 o; o.x = (z[i].x - mu) * rs * gg.x + bb.x; o.y = (z[i].y - mu) * rs * gg.y + bb.y; o.z = (z[i].z - mu) * rs * gg.z + bb.z; o.w = (z[i].w - mu) * rs * gg.w + bb.w;
            *(float4*)(out + (size_t)t * D + d) = o; }
    }
};

__device__ __forceinline__ int rowf_vb(int w, int i, int G, int nvb) { return (G == 256 && nvb == 1024) ? ((w >> 6) * 256 + (w & 63) + 64 * i) : (w + i * G); }
__device__ __forceinline__ int rowf_wg(int vb, int G, int nvb) { return (G == 256 && nvb == 1024) ? ((vb >> 8) * 64 + (vb & 63)) : (vb % G); }
typedef short bf16x8_t __attribute__((ext_vector_type(8)));
typedef _Float16 f16x8_t __attribute__((ext_vector_type(8)));
typedef float f32x4_t __attribute__((ext_vector_type(4)));
template <int MODE, bool XBF> struct RowF {
    const bf16_t* xb; bf16_t* outb;
    const float* x; const bf16_t* y; const bf16_t* yb; const float* modg; const float* g; const float* bta; float* out;
    const float* modn; bf16_t* hb; const bf16_t* whi; const bf16_t* wlo;
    const float* bg; const float* br; int* wgcnt; int* tok_e; int* tok_pos; float* tok_w; float* flog;
    __device__ __forceinline__ void run(int nvb) const {
        constexpr int NCB = MODE == 0 ? 3 : 1, NC = NCB * 16, HS = 2056, LOGIT_BATCHES = MODE == 0 ? 2 : 1;
        _Float16* H = (_Float16*)g_lds; float* P = (float*)(g_lds + 66048); float* Lg = (float*)(g_lds + 90624);
        LAS int* lc = (LAS int*)(g_lds + 93696);
        float* Vg = (float*)(g_lds + 93952); float* Vb = Vg + D; float* Vgate = Vb + D; float* Vsh = Vgate + D; float* Vsc = Vsh + D;
        const int tid = otid(), wave = tid >> 6, lane = tid & 63, G = gridDim.x;
        __syncthreads();
        float* Bs = (float*)(g_lds + 134912);
        if (MODE == 0) { if (tid < 32) lc[tid] = 0; if (tid < 36) Bs[tid] = tid < 4 ? bg[tid] : br[tid - 4]; }
        { const float4 a = *(const float4*)(g + tid * 4), c = *(const float4*)(bta + tid * 4); *(float4*)(Vg + tid * 4) = a; *(float4*)(Vb + tid * 4) = c; }
        int bcur = -1;
        float4 xv[8]; uint2 xq[8], ya[8], yc[8];
#define ROWF_LOAD(t_) do { _Pragma("unroll") for (int i_ = 0; i_ < 8; ++i_) { const int d_ = (i_ * 64 + lane) * 4; \
                    if (XBF) { xq[i_] = *(const uint2*)(xb + (size_t)(t_) * D + d_); xv[i_] = make_float4(0.f, 0.f, 0.f, 0.f); } else { xv[i_] = *(const float4*)(x + (size_t)(t_) * D + d_); xq[i_] = make_uint2(0u, 0u); } \
                    if (MODE != 0) { ya[i_] = *(const uint2*)(yb + (size_t)(2 * (t_)) * D + d_); yc[i_] = *(const uint2*)(yb + (size_t)(2 * (t_) + 1) * D + d_); } \
                    else { ya[i_] = *(const uint2*)(y + (size_t)(t_) * D + d_); yc[i_] = make_uint2(0u, 0u); } } } while (0)
        const bool bmap = G == 256 && nvb == 1024; const int vstep = bmap ? 64 : G, vb0 = rowf_vb(obid(), 0, G, nvb), vend = bmap ? vb0 + 256 : nvb;
        if (vb0 < vend) ROWF_LOAD(vb0 * 16 + wave * 2);
        for (int vb = vb0; vb < vend; vb += vstep) {
            const int b = (vb * 16) / S;
            if (b != bcur) {
                __syncthreads();
                const int tq = otid() * 4;
                { float4 a = *(const float4*)(modg + (size_t)b * 3 * D + 2 * D + tq); a.x += 1.f; a.y += 1.f; a.z += 1.f; a.w += 1.f; *(float4*)(Vgate + tq) = a; }
                if (MODE != 2) { const float4 sh4 = *(const float4*)(modn + (size_t)b * 3 * D + tq); float4 c = *(const float4*)(modn + (size_t)b * 3 * D + D + tq); c.x += 1.f; c.y += 1.f; c.z += 1.f; c.w += 1.f;
                    *(float4*)(Vsh + tq) = sh4; *(float4*)(Vsc + tq) = c; }
                __syncthreads(); bcur = b; }
            const int t0 = vb * 16 + wave * 2;
#pragma unroll
            for (int r = 0; r < 2; ++r) { const int t = t0 + r;
                float4 z[8]; float sum = 0.f;
#pragma unroll
                for (int i = 0; i < 8; ++i) { const int d = (i * 64 + lane) * 4;
                    const float4 gv = *(const float4*)(Vgate + d); float4 yv;
                    yv.x = __uint_as_float(ya[i].x << 16); yv.y = __uint_as_float(ya[i].x & 0xffff0000u); yv.z = __uint_as_float(ya[i].y << 16); yv.w = __uint_as_float(ya[i].y & 0xffff0000u);
                    if (MODE != 0) { yv.x += __uint_as_float(yc[i].x << 16); yv.y += __uint_as_float(yc[i].x & 0xffff0000u); yv.z += __uint_as_float(yc[i].y << 16); yv.w += __uint_as_float(yc[i].y & 0xffff0000u); }
                    float4 xf = xv[i]; if (XBF) { xf.x = __uint_as_float(xq[i].x << 16); xf.y = __uint_as_float(xq[i].x & 0xffff0000u); xf.z = __uint_as_float(xq[i].y << 16); xf.w = __uint_as_float(xq[i].y & 0xffff0000u); }
                    z[i].x = ALPHA * xf.x + gv.x * yv.x; z[i].y = ALPHA * xf.y + gv.y * yv.y; z[i].z = ALPHA * xf.z + gv.z * yv.z; z[i].w = ALPHA * xf.w + gv.w * yv.w;
                    sum += (z[i].x + z[i].y) + (z[i].z + z[i].w); }
                if (r == 0) { __builtin_amdgcn_sched_barrier(0); ROWF_LOAD(t0 + 1); __builtin_amdgcn_sched_barrier(0); }
                else if (vb + vstep < vend) { __builtin_amdgcn_sched_barrier(0); ROWF_LOAD((vb + vstep) * 16 + wave * 2); __builtin_amdgcn_sched_barrier(0); }
                sum = wave_sum(sum); const float mu = sum * (1.f / D);
                float var = 0.f;
#pragma unroll
                for (int i = 0; i < 8; ++i) { const float a = z[i].x - mu, bq = z[i].y - mu, c = z[i].z - mu, dd = z[i].w - mu; var += (a * a + bq * bq) + (c * c + dd * dd); }
                var = wave_sum(var) * (1.f / D);
                const float rs = 1.0f / sqrtf(var + LN_EPS);
#pragma unroll
                for (int i = 0; i < 8; ++i) { const int d = (i * 64 + lane) * 4; const float4 gg = *(const float4*)(Vg + d), bb = *(const float4*)(Vb + d);
                    float4 s4 = make_float4(0.f, 0.f, 0.f, 0.f), c4 = s4;
                    if (MODE != 2) { s4 = *(const float4*)(Vsh + d); c4 = *(const float4*)(Vsc + d); }
                    float4 o; o.x = (z[i].x - mu) * rs * gg.x + bb.x; o.y = (z[i].y - mu) * rs * gg.y + bb.y; o.z = (z[i].z - mu) * rs * gg.z + bb.z; o.w = (z[i].w - mu) * rs * gg.w + bb.w;
                    if (MODE == 2) { *(float4*)(out + (size_t)t * D + d) = o; continue; }
                    { uint2 ow; ow.x = pkbf(o.x, o.y); ow.y = pkbf(o.z, o.w); *(uint2*)(outb + (size_t)t * D + d) = ow; }
                    float4 h; h.x = o.x * c4.x + s4.x; h.y = o.y * c4.y + s4.y; h.z = o.z * c4.z + s4.z; h.w = o.w * c4.w + s4.w;
                    uint2 w; w.x = pkbf(h.x, h.y); w.y = pkbf(h.z, h.w); *(uint2*)(hb + (size_t)t * D + d) = w;
                    typedef _Float16 f16x4_t __attribute__((ext_vector_type(4)));
                    f16x4_t hq; hq[0] = (_Float16)h.x; hq[1] = (_Float16)h.y; hq[2] = (_Float16)h.z; hq[3] = (_Float16)h.w;
                    *(f16x4_t*)(H + (wave * 2 + r) * HS + d) = hq; } }
            if (MODE == 2) continue;
            __syncthreads();
            f32x4_t acc[NCB];
#pragma unroll
            for (int cb = 0; cb < NCB; ++cb) acc[cb] = (f32x4_t){0.f, 0.f, 0.f, 0.f};
            const int row = lane & 15, kg = lane >> 4, col = lane & 15;
            constexpr int KBATCH = 8 / LOGIT_BATCHES;
#pragma unroll
            for (int kq = 0; kq < LOGIT_BATCHES; ++kq) {
                f16x8_t Bw[KBATCH][NCB];
#pragma unroll
                for (int k2 = 0; k2 < KBATCH; ++k2)
#pragma unroll
                    for (int cb = 0; cb < NCB; ++cb) Bw[k2][cb] = *(const f16x8_t*)((const _Float16*)whi + ((size_t)((wave * 8 + kq * KBATCH + k2) * NCB + cb) * 64 + lane) * 8);
                __builtin_amdgcn_sched_barrier(0);
#pragma unroll
                for (int k2 = 0; k2 < KBATCH; ++k2) { const int kb = wave * 256 + (kq * KBATCH + k2) * 32 + kg * 8;
                    const f16x8_t A = *(const f16x8_t*)(H + row * HS + kb);
#pragma unroll
                    for (int cb = 0; cb < NCB; ++cb) acc[cb] = __builtin_amdgcn_mfma_f32_16x16x32_f16(A, Bw[k2][cb], acc[cb], 0, 0, 0); }
                __builtin_amdgcn_sched_barrier(0); }
#pragma unroll
            for (int cb = 0; cb < NCB; ++cb)
#pragma unroll
                for (int i = 0; i < 4; ++i) P[(wave * 16 + 4 * (lane >> 4) + i) * 48 + cb * 16 + col] = acc[cb][i];
            __syncthreads();
            for (int idx = tid; idx < 16 * NC; idx += NTHR) { const int r = idx / NC, c = idx - r * NC; float a = 0.f;
#pragma unroll
                for (int w = 0; w < 8; ++w) a += P[(w * 16 + r) * 48 + c];
                Lg[r * 48 + c] = a; }
            __syncthreads();
#pragma unroll
            for (int r = 0; r < 2; ++r) { const int t = t0 + r; const float* lr = Lg + (wave * 2 + r) * 48;
                if (MODE == 1) { if (lane < 16) flog[(size_t)t * 16 + lane] = lr[lane]; }
                else {
                    float gl[4] = {lr[0] + Bs[0], lr[1] + Bs[1], lr[2] + Bs[2], lr[3] + Bs[3]};
                    int gi = 0; float gm = gl[0];
#pragma unroll
                    for (int c = 1; c < 4; ++c) if (gl[c] > gm) { gm = gl[c]; gi = c; }
                    float gs = 0.f;
#pragma unroll
                    for (int c = 0; c < 4; ++c) gs += expf(gl[c] - gm);
                    const float gw = 1.f / gs;
                    float e[8];
#pragma unroll
                    for (int c = 0; c < 8; ++c) e[c] = lr[4 + gi * 8 + c] + Bs[4 + gi * 8 + c];
                    int i0 = 0; float v0 = e[0];
#pragma unroll
                    for (int c = 1; c < 8; ++c) if (e[c] > v0) { v0 = e[c]; i0 = c; }
                    int i1 = -1; float v1 = -INFINITY;
#pragma unroll
                    for (int c = 0; c < 8; ++c) if (c != i0 && e[c] > v1) { v1 = e[c]; i1 = c; }
                    const float ex = expf(v1 - v0), pa = 1.f / (1.f + ex), pb = ex / (1.f + ex);
                    if (lane == 0) {
                        const int e0 = gi * 8 + i0, e1 = gi * 8 + i1;
                        tok_e[2 * t] = e0; tok_e[2 * t + 1] = e1;
                        tok_w[2 * t] = gw * pa; tok_w[2 * t + 1] = gw * pb;
                        tok_pos[2 * t] = __hip_atomic_fetch_add(lc + e0, 1, __ATOMIC_RELAXED, __HIP_MEMORY_SCOPE_WORKGROUP); tok_pos[2 * t + 1] = __hip_atomic_fetch_add(lc + e1, 1, __ATOMIC_RELAXED, __HIP_MEMORY_SCOPE_WORKGROUP);
                    }
                }
            }
        }
#undef ROWF_LOAD
        if (MODE == 0) { __syncthreads(); const int t2 = otid(); if (t2 < 32) wgcnt[obid() * 32 + t2] = lc[t2]; }
    }
};
struct SmallWF {
    const float* wg; const float* wr; const float* bwin; bf16_t* rhi; bf16_t* rlo; bf16_t* fhi; bf16_t* flo;
    __device__ __forceinline__ void operator()(int vb) const {
        const int i = vb * NTHR + otid();
        float w; bf16_t* ph; bf16_t* pl; int k, col, ncb;
        if (i < 2 * 48 * D) { const int layer = i / (48 * D); k = i % D; col = (i / D) % 48; ncb = 3;
            if (col < 4) w = wg[((size_t)layer * D + k) * 4 + col];
            else if (col < 36) { const int gq = (col - 4) >> 3, e = (col - 4) & 7; w = wr[(((size_t)layer * 4 + gq) * D + k) * 8 + e]; }
            else w = 0.f;
            ph = rhi + (size_t)layer * 48 * D; pl = rlo + (size_t)layer * 48 * D; }
        else { const int j = i - 2 * 48 * D; k = j % D; col = j / D; ncb = 1; w = bwin[(size_t)k * 6160 + 6144 + col]; ph = fhi; pl = flo; }
        const size_t o = ((size_t)((((k >> 8) * 8 + ((k >> 5) & 7)) * ncb + (col >> 4)) * 64 + ((k >> 3) & 3) * 16 + (col & 15))) * 8 + (k & 7);
        (void)pl; ((_Float16*)ph)[o] = (_Float16)w;
    }
};

struct InitF {
    int* cnt; int* slot_token; int* panel_e; unsigned* nrm2;
    __device__ __forceinline__ void operator()(int vb) const {
        const int i = vb * NTHR + otid();
        if (i < 32) cnt[i] = 0;
        if (nrm2 && i < 512) nrm2[i] = 0u;
        if (i < NPANEL) panel_e[i] = -1;
        if (i < MAXSLOT) slot_token[i] = -1;
    }
};
struct RouteF {
    const float* h; const float* wg; const float* bg; const float* wr; const float* br;
    int* cnt; int* tok_e; int* tok_pos; float* tok_w;
    __device__ __forceinline__ void operator()(int vb) const {
        const int tid = otid(), wave = tid >> 6, lane = tid & 63;
        const int t = vb * 8 + wave;
        const float* hr = h + (size_t)t * D;
        float hv[32];
#pragma unroll
        for (int i = 0; i < 32; ++i) hv[i] = hr[lane + 64 * i];
        float p0 = 0.f, p1 = 0.f, p2 = 0.f, p3 = 0.f;
#pragma unroll
        for (int i = 0; i < 32; ++i) { const float4 w = *(const float4*)(wg + (size_t)(lane + 64 * i) * 4); p0 += hv[i] * w.x; p1 += hv[i] * w.y; p2 += hv[i] * w.z; p3 += hv[i] * w.w; }
        float gl[4] = {wave_sum(p0) + bg[0], wave_sum(p1) + bg[1], wave_sum(p2) + bg[2], wave_sum(p3) + bg[3]};
        int gi = 0; float gm = gl[0];
#pragma unroll
        for (int c = 1; c < 4; ++c) if (gl[c] > gm) { gm = gl[c]; gi = c; }
        float gs = 0.f;
#pragma unroll
        for (int c = 0; c < 4; ++c) gs += expf(gl[c] - gm);
        const float gw = 1.f / gs;
        const float* wrg = wr + (size_t)gi * D * 8;
        float e[8];
#pragma unroll
        for (int c = 0; c < 8; ++c) e[c] = 0.f;
#pragma unroll
        for (int i = 0; i < 32; ++i) { const float4 wa = *(const float4*)(wrg + (size_t)(lane + 64 * i) * 8), wb = *(const float4*)(wrg + (size_t)(lane + 64 * i) * 8 + 4);
            e[0] += hv[i] * wa.x; e[1] += hv[i] * wa.y; e[2] += hv[i] * wa.z; e[3] += hv[i] * wa.w; e[4] += hv[i] * wb.x; e[5] += hv[i] * wb.y; e[6] += hv[i] * wb.z; e[7] += hv[i] * wb.w; }
#pragma unroll
        for (int c = 0; c < 8; ++c) e[c] = wave_sum(e[c]) + br[gi * 8 + c];
        int i0 = 0; float v0 = e[0];
#pragma unroll
        for (int c = 1; c < 8; ++c) if (e[c] > v0) { v0 = e[c]; i0 = c; }
        int i1 = -1; float v1 = -INFINITY;
#pragma unroll
        for (int c = 0; c < 8; ++c) if (c != i0 && e[c] > v1) { v1 = e[c]; i1 = c; }
        const float ex = expf(v1 - v0), pa = 1.f / (1.f + ex), pb = ex / (1.f + ex);
        if (lane == 0) {
            const int e0 = gi * 8 + i0, e1 = gi * 8 + i1;
            tok_e[2 * t] = e0; tok_e[2 * t + 1] = e1;
            tok_w[2 * t] = gw * pa; tok_w[2 * t + 1] = gw * pb;
            tok_pos[2 * t] = atomicAdd(cnt + e0, 1); tok_pos[2 * t + 1] = atomicAdd(cnt + e1, 1);
        }
    }
};
struct ScatterF {
    const int* cnt; const int* tok_e; const int* tok_pos; const float* tok_w;
    int* tok_slot; int* slot_token; float* slot_w; int* panel_e; int* npan;
    __device__ __forceinline__ void operator()(int vb) const {
        const int i = vb * NTHR + otid();
        if (i < 2 * NTOK) {
            const int e = tok_e[i]; int off = 0;
            for (int q = 0; q < e; ++q) off += (cnt[q] + 255) & ~255;
            const int slot = off + tok_pos[i];
            tok_slot[i] = slot; slot_token[slot] = i; slot_w[slot] = tok_w[i];
        }
        if (vb == 0 && otid() < 32) {
            const int e = otid(); int off = 0;
            for (int q = 0; q < e; ++q) off += (cnt[q] + 255) & ~255;
            const int np = (cnt[e] + 255) >> 8;
            for (int p = 0; p < np; ++p) panel_e[(off >> 8) + p] = e;
            if (e == 31) npan[0] = (off >> 8) + np;
        }
    }
};
struct GatherF {
    const bf16_t* hb; bf16_t* Hs; const int* slot_token; float* slot_w; const int* npan;
    __device__ __forceinline__ void operator()(int vb) const {
        const int tid = otid(), wave = tid >> 6, lane = tid & 63;
        const int slot = vb * 8 + wave;
        if (slot >= npan[0] * 256) return;
        const int st = slot_token[slot];
        uint4* dst = (uint4*)(Hs + (size_t)slot * D) + lane;
        if (st >= 0) { const uint4* src = (const uint4*)(hb + (size_t)(st >> 1) * D) + lane;
#pragma unroll
            for (int j = 0; j < 4; ++j) dst[64 * j] = src[64 * j]; }
        else { const uint4 z = make_uint4(0u, 0u, 0u, 0u);
#pragma unroll
            for (int j = 0; j < 4; ++j) dst[64 * j] = z;
            if (lane == 0) slot_w[slot] = 0.f; }
    }
};
struct ScatF {
    const int* wgcnt; const int* tok_e; const int* tok_pos; const float* tok_w;
    int* slot_token; float* slot_w; int* panel_e; int* npan;
    __device__ __forceinline__ void operator()(int vb) const {
        int* base = (int*)g_lds;
        int* sego = base + 256 * 32;
        int* tot = sego + 16 * 32;
        int* off = tot + 32;
        const int tid = otid(), G = gridDim.x;
        __syncthreads();
        { const int e = tid & 31, seg = tid >> 5; int run = 0;
#pragma unroll
          for (int j = 0; j < 16; ++j) { const int w = seg * 16 + j; const int c = w < G ? wgcnt[w * 32 + e] : 0; base[w * 32 + e] = run; run += c; }
          sego[seg * 32 + e] = run; }
        __syncthreads();
        if (tid < 32) { int run = 0;
#pragma unroll
            for (int sgi = 0; sgi < 16; ++sgi) { const int c = sego[sgi * 32 + tid]; sego[sgi * 32 + tid] = run; run += c; }
            tot[tid] = run; }
        __syncthreads();
        if (tid == 0) { int run = 0; for (int e = 0; e < 32; ++e) { off[e] = run; run += (tot[e] + 255) & ~255; } }
        __syncthreads();
        const int i = vb * NTHR + tid;
        if (i < 2 * NTOK) {
            const int e = tok_e[i], w = rowf_wg((i >> 1) >> 4, G, NTOK / 16);
            const int slot = off[e] + sego[(w >> 4) * 32 + e] + base[w * 32 + e] + tok_pos[i];
            slot_token[slot] = i; slot_w[slot] = tok_w[i];
        } else if (i < 2 * NTOK + 32 * 256) {
            const int idx = i - 2 * NTOK, e = idx >> 8, r = idx & 255, c = tot[e], npad = ((c + 255) & ~255) - c;
            if (r < npad) slot_w[off[e] + c + r] = 0.f;
        }
        if (vb == 0 && tid < 32) {
            const int e = tid, np = (tot[e] + 255) >> 8;
            for (int q = 0; q < np; ++q) panel_e[(off[e] >> 8) + q] = e;
            if (e == 31) npan[0] = (off[e] >> 8) + np;
        }
        __syncthreads();
    }
};
struct HidF {
    float* a; const float* u; const float* slot_w; const int* slot_token; const int* panel_e;
    __device__ __forceinline__ void operator()(int vb) const {
        const size_t i4 = (size_t)vb * NTHR + otid(); const size_t e = i4 * 4; const int slot = (int)(e / 512);
        if (panel_e[slot >> 8] < 0) return;
        float4 o = make_float4(0.f, 0.f, 0.f, 0.f);
        if (slot_token[slot] >= 0) { const float w = slot_w[slot]; const float4 av = *(const float4*)(a + e), uv = *(const float4*)(u + e);
            o.x = av.x / (1.f + expf(-av.x)) * uv.x * w; o.y = av.y / (1.f + expf(-av.y)) * uv.y * w; o.z = av.z / (1.f + expf(-av.z)) * uv.z * w; o.w = av.w / (1.f + expf(-av.w)) * uv.w * w; }
        *(float4*)(a + e) = o;
    }
};

struct RopeHF {
    bf16_t* q; bf16_t* k; const float* tab;
    __device__ __forceinline__ void operator()(int vb) const {
        const size_t idx = (size_t)vb * NTHR + otid();
        const int i = (int)(idx & 63), s = (int)((idx >> 6) & 4095), bh = (int)((idx >> 18) & 63), which = (int)(idx >> 24);
        bf16_t* pp = (which ? k : q) + ((size_t)bh * S + s) * 128 + i;
        const float c = tab[((size_t)s * 64 + i) * 2], sn = tab[((size_t)s * 64 + i) * 2 + 1];
        const float x1 = __uint_as_float((unsigned)pp[0] << 16), x2 = __uint_as_float((unsigned)pp[64] << 16);
        pp[0] = (bf16_t)(pkbf(x1 * c - x2 * sn, 0.f) & 0xffffu); pp[64] = (bf16_t)(pkbf(x2 * c + x1 * sn, 0.f) & 0xffffu);
    }
};
struct CombineF {
    const bf16_t* o1; const bf16_t* o2; const float* lam; const float* w; bf16_t* ob;
    __device__ __forceinline__ void load(int vb, int wave, int lane, uint2 (&a)[4], uint2 (&bq)[4]) const {
        const size_t g0 = ((size_t)vb * 8 + wave) * 4;
#pragma unroll
        for (int j = 0; j < 4; ++j) { a[j] = *(const uint2*)(o1 + (g0 + j) * 256 + lane * 4); bq[j] = *(const uint2*)(o2 + (g0 + j) * 256 + lane * 4); }
    }
    __device__ __forceinline__ void finish(int vb, int wave, int lane, const uint2 (&a)[4], const uint2 (&bq)[4], float lm, const float4 ww) const {
        const size_t g0 = ((size_t)vb * 8 + wave) * 4;
#pragma unroll
        for (int j = 0; j < 4; ++j) {
            const float v0 = __uint_as_float(a[j].x << 16) - lm * __uint_as_float(bq[j].x << 16), v1 = __uint_as_float(a[j].x & 0xffff0000u) - lm * __uint_as_float(bq[j].x & 0xffff0000u);
            const float v2 = __uint_as_float(a[j].y << 16) - lm * __uint_as_float(bq[j].y << 16), v3 = __uint_as_float(a[j].y & 0xffff0000u) - lm * __uint_as_float(bq[j].y & 0xffff0000u);
            float ss = v0 * v0 + v1 * v1 + v2 * v2 + v3 * v3; ss = wave_sum(ss);
            const float r = 1.0f / sqrtf(ss * (1.f / 256.f) + RMS_EPS) * (1.f - LAM_INIT0);
            uint2 q; q.x = pkbf(v0 * r * ww.x, v1 * r * ww.y); q.y = pkbf(v2 * r * ww.z, v3 * r * ww.w);
            *(uint2*)(ob + (g0 + j) * 256 + lane * 4) = q; }
    }
    __device__ __forceinline__ void run(int nvb) const {
        const int tid = otid(), wave = __builtin_amdgcn_readfirstlane(tid >> 6), lane = tid & 63, G = gridDim.x, it0 = obid();
        const int nit = it0 < nvb ? (nvb - it0 + G - 1) / G : 0;
        if (nit <= 0) return;
        const int last = it0 + (nit - 1) * G;
        const float lm = lam[0]; const float4 ww = *(const float4*)(w + lane * 4);
        uint2 a0[4], b0[4], a1[4], b1[4];
        int it = it0, k = 0;
        load(it, wave, lane, a0, b0);
        for (; k + 1 < nit; k += 2) {
            load(it + G, wave, lane, a1, b1);
            __builtin_amdgcn_sched_barrier(0);
            finish(it, wave, lane, a0, b0, lm, ww);
            __builtin_amdgcn_sched_barrier(0);
            load(it + 2 * G < last ? it + 2 * G : last, wave, lane, a0, b0);
            __builtin_amdgcn_sched_barrier(0);
            finish(it + G, wave, lane, a1, b1, lm, ww);
            it += 2 * G;
        }
        if (k < nit) finish(it, wave, lane, a0, b0, lm, ww);
    }
};
struct CumBF {
    const float* flog; const float* fb; float* bz;
    __device__ __forceinline__ void operator()(int vb) const {
        float* tot = (float*)g_lds;
        const int b = vb >> 4, h = vb & 15, tid = otid();
        float v[8]; float run = 0.f;
#pragma unroll
        for (int j = 0; j < 8; ++j) { const float x = flog[((size_t)b * S + tid * 8 + j) * 16 + h] + fb[h];
            const float ls = fminf(x, 0.f) - log1pf(expf(-fabsf(x))); run += ls; v[j] = run; }
        __syncthreads();
        tot[tid] = run;
        __syncthreads();
        if (tid < 64) { float t8[8]; float a = 0.f;
#pragma unroll
            for (int j = 0; j < 8; ++j) { t8[j] = tot[tid * 8 + j]; a += t8[j]; }
            float inc = a;
#pragma unroll
            for (int o = 1; o < 64; o <<= 1) { const float v = __shfl_up(inc, o); if (tid >= o) inc += v; }
            float ex = inc - a;
#pragma unroll
            for (int j = 0; j < 8; ++j) { tot[tid * 8 + j] = ex; ex += t8[j]; } }
        __syncthreads();
        const float off = tot[tid];
#pragma unroll
        for (int j = 0; j < 8; ++j) bz[((size_t)b * 16 + h) * S + tid * 8 + j] = -(v[j] + off) * 11.313708498984761f;
        __syncthreads();
    }
};
struct AttnArgs { const bf16_t* q; const bf16_t* k; const bf16_t* v; bf16_t* o0; bf16_t* o1; const float* bz; const unsigned* nrm2; };
typedef swa::BlockRef<__hip_bfloat16, __hip_bfloat16> ARef;
template <int LAYER> __device__ __forceinline__ ARef attn_ref(const AttnArgs& a, int prob, int qb) {
    ARef r; r.P0 = qb * 256; r.Bz = nullptr; r.JLO = 0;
    if (LAYER == 0) {
        const int vh = prob & 1, c = (prob >> 1) & 1, h = (prob >> 2) & 7, b = prob >> 5, qh = 2 * h + c, vv = 2 * h + vh;
        r.Q = (const __hip_bfloat16*)a.q + ((size_t)(b * 16 + qh) * S + qb * 256) * 128;
        r.K = (const __hip_bfloat16*)a.k + (size_t)(b * 16 + qh) * S * 128;
        r.V = (const __hip_bfloat16*)a.v + (size_t)(b * 16 + vv) * S * 128;
        r.O = (__hip_bfloat16*)(c ? a.o1 : a.o0) + ((size_t)b * S + qb * 256) * D + h * 256 + vh * 128;
    } else {
        r.Q = (const __hip_bfloat16*)a.q + ((size_t)prob * S + qb * 256) * 128;
        r.K = (const __hip_bfloat16*)a.k + (size_t)prob * S * 128;
        r.V = (const __hip_bfloat16*)a.v + (size_t)prob * S * 128;
        r.O = (__hip_bfloat16*)a.o0 + ((size_t)(prob >> 4) * S + qb * 256) * D + (prob & 15) * 128;
        r.Bz = a.bz + (size_t)prob * S;
    }
    return r;
}
template <int NPROB> __device__ __forceinline__ void attn_item(int L, int& prob, int& x) { const int xc = L & 7, j = L >> 3; prob = xc * (NPROB / 8) + (j >> 3); x = j & 7; }
__device__ __forceinline__ float fox_R(const AttnArgs& a, int prob) {
    const float q2 = __uint_as_float(__hip_atomic_load(a.nrm2 + prob, __ATOMIC_RELAXED, __HIP_MEMORY_SCOPE_AGENT)), k2 = __uint_as_float(__hip_atomic_load(a.nrm2 + 64 + prob, __ATOMIC_RELAXED, __HIP_MEMORY_SCOPE_AGENT));
    return 2.f * sqrtf(q2 * k2) * 1.02f + 339.5f;
}
__device__ __forceinline__ int fox_jlo2(const AttnArgs& a, int prob, int x) {
    const float* bzp = a.bz + (size_t)prob * S; const int lane = otid() & 63;
    const float v = bzp[64 * lane + 63], f = bzp[256 * (lane & 15)], R = fox_R(a, prob);
    const float f0 = __shfl(f, x), f1 = __shfl(f, 15 - x);
    return __popcll(__ballot(f0 - v >= R)) | (__popcll(__ballot(f1 - v >= R)) << 8);
}
struct FoxPair { int probA, probB, x; bool paired; };
__device__ __forceinline__ FoxPair fox_pairing(const AttnArgs& a) {
    FoxPair fp; fp.probA = fp.probB = fp.x = 0; fp.paired = gridDim.x == 256;
    if (!fp.paired) return fp;
    const int bid = obid(), c = bid & 7, b = c >> 1, g = c & 1, j = bid >> 3, slot = j >> 3;
    LAS int* cost = (LAS int*)(g_lds + 100 * 1024); LAS int* order = cost + 16;
    const int tid = otid(), wave = __builtin_amdgcn_readfirstlane(tid >> 6), lane = tid & 63;
    __syncthreads();
#pragma unroll 1
    for (int hh = 0; hh < 2; ++hh) { const int h = wave * 2 + hh, prob = b * 16 + h;
        const float* bzp = a.bz + (size_t)prob * S;
        const float v = bzp[64 * lane + 63], f = bzp[256 * (lane & 15)], R = fox_R(a, prob);
        int cst = 0;
#pragma unroll
        for (int q = 0; q < 16; ++q) cst += 4 * (q + 1) + 1 - __popcll(__ballot(__shfl(f, q) - v >= R));
        if (lane == 0) cost[h] = cst; }
    __syncthreads();
    if (tid < 16) { const int ch = cost[tid]; int rk = 0;
        for (int h2 = 0; h2 < 16; ++h2) { const int c2 = cost[h2]; rk += (c2 > ch || (c2 == ch && h2 < tid)) ? 1 : 0; }
        order[rk] = tid; }
    __syncthreads();
    const int p = g == 0 ? (slot == 0 ? 0 : slot == 1 ? 3 : slot == 2 ? 4 : 7) : (slot == 0 ? 1 : slot == 1 ? 2 : slot == 2 ? 5 : 6);
    fp.probA = b * 16 + order[p]; fp.probB = b * 16 + order[15 - p]; fp.x = j & 7;
    __syncthreads();
    return fp;
}
template <int LAYER> __device__ __forceinline__ void attn_item_of(const FoxPair& fp, int i, int L, int& prob, int& x) {
    if (LAYER == 1 && fp.paired) { prob = (i & 1) ? fp.probB : fp.probA; x = (i & 1) ? 7 - fp.x : fp.x; }
    else { attn_item<LAYER == 0 ? 128 : 64>(L, prob, x); if (LAYER == 1 && (i & 1)) x = 7 - x; }
}
template <int LAYER> __device__ __forceinline__ void attn_stream(const AttnArgs& a, const FoxPair& fp, int i0, int i1) {
    constexpr int NPROB = LAYER == 0 ? 128 : 64, NX = 8, TOTAL = NPROB * NX;
    char* lds = (char*)g_lds;
    const int stride = gridDim.x;
    int i = i0, L = obid() + i0 * stride; if (i0 >= i1 || L >= TOTAL) return;
    int pass = 0, prob, x, jp = 0;
    if (LAYER == 1) {
        attn_item_of<LAYER>(fp, i0, L, prob, x); jp = fox_jlo2(a, prob, x);
        if (i0 + 1 < i1 && L + stride < TOTAL) { attn_item_of<LAYER>(fp, i0 + 1, L + stride, prob, x); jp |= fox_jlo2(a, prob, x) << 16; } }
#define JLO_OF(ii, ps) ((LAYER == 1 && (ii) - i0 < 2) ? ((jp >> (16 * ((ii) - i0) + 8 * (ps))) & 255) : 0)
    attn_item_of<LAYER>(fp, i, L, prob, x);
    ARef cur = attn_ref<LAYER>(a, prob, x); cur.JLO = JLO_OF(i, 0);
    swa::Seam<__hip_bfloat16> Sm;
    swa::causal_swa_prime<__hip_bfloat16, __hip_bfloat16>(cur, S, lds, Sm);
    for (;;) {
        const bool more_pass = pass == 0, more_item = (i + 1 < i1) && (L + stride < TOTAL), last = !more_pass && !more_item;
        int passn = pass + 1, Ln = L, in = i;
        if (!more_pass) { passn = 0; if (more_item) { Ln = L + stride; in = i + 1; } }
        attn_item_of<LAYER>(fp, in, Ln, prob, x);
        ARef nxt = last ? cur : attn_ref<LAYER>(a, prob, passn ? 15 - x : x);
        if (!last) nxt.JLO = JLO_OF(in, passn);
        swa::causal_swa_block<__hip_bfloat16, __hip_bfloat16, D, LAYER == 1>(cur, nxt, S, S, lds, Sm);
        if (last) break;
        cur = nxt; pass = passn; L = Ln; i = in;
    }
#undef JLO_OF
}
struct Params {
    const float* x; const float* c;
    const float* mix_mod_w; const float* mix_mod_b; const float* mix_ln_g; const float* mix_ln_b;
    const float* a_w_in; const float* a_lq1; const float* a_lk1; const float* a_lq2; const float* a_lk2; const float* a_subln; const float* a_w_out;
    const float* b_w_in; const float* b_fb; const float* b_w_out;
    const float* ffn_mod_w; const float* ffn_mod_b; const float* ffn_ln_g; const float* ffn_ln_b;
    const float* moe_wg; const float* moe_bg; const float* moe_wr; const float* moe_br; const float* moe_gate; const float* moe_up; const float* moe_down;
    float* out; unsigned* bar;
    float* modv; float* ropet; float* lam; float* cum; int* cnt; int* tok_e; int* tok_pos; float* tok_w; int* tok_slot; int* slot_token; float* slot_w; int* panel_e;
    float* xA; float* xB; float* hbuf; float* abuf; float* ubuf; float* obuf; float* projb; float* sc1; float* sc2; float* y2;
    bf16_t* hb; bf16_t* ob; bf16_t* wt_in[2]; bf16_t* wt_out[2];
    bf16_t* qh; bf16_t* kh; bf16_t* vh; bf16_t* o1; bf16_t* o2; float* flog; float* bz;
    bf16_t* wgu; bf16_t* wdn; bf16_t* wgu1; bf16_t* wdn1; bf16_t* Hs; bf16_t* hid; bf16_t* y2b; int* npan; float* modp; bf16_t* yb16;
    bf16_t* rhi; bf16_t* rlo; bf16_t* fhi; bf16_t* flo; int* wgcnt; bf16_t* xAb; bf16_t* xBb; unsigned* nrm2;
};

template <class F> __device__ __forceinline__ void phase(const F& f, int nvb, const XcdBarrier& bar) {
    for (int vb = obid(); vb < nvb; vb += gridDim.x) f(vb);
    xcd_barrier(bar);
}
template <class F> __device__ __forceinline__ void run_nb(const F& f, int nvb) { for (int vb = obid(); vb < nvb; vb += gridDim.x) f(vb); }
__device__ __forceinline__ void gemm(const XcdBarrier& bar, const float* A, int lda, const float* B, int ldb, float* C, int ldc, int M, int N, int K, int transB, int causal,
          const int* rowidx = nullptr, const int* panel_e = nullptr, long long strideBe = 0, bool sync = true) {
    GemmF g; g.A = A; g.B = B; g.C = C; g.rowidx = rowidx; g.panel_e = panel_e; g.strideBe = strideBe; g.lda = lda; g.ldb = ldb; g.ldc = ldc; g.M = M; g.N = N; g.K = K;
    g.transB = transB; g.causal = causal; g.tilesN = (N + 127) / 128; g.pad0 = 0;
    run_nb(g, ((M + 127) / 128) * g.tilesN);
    if (sync) xcd_barrier(bar);
}
__device__ __forceinline__ void mgemm_f32(const bf16_t* A, const bf16_t* Bt, float* C, int ldc, int M, int N, int K) {
    pg8::Gemm g{A, Bt, M, N, K}; pg8::StaticOrder S; S.init(M, N, (int)gridDim.x, obid());
    pg8::EpiF32 E{C, ldc};
    pg8::gemm_phase<pg8::EpiF32, pg8::StaticOrder, true, true>((PG8_LAS unsigned char*)g_lds, g, S, E);
}

__device__ __forceinline__ void mgemm_b16(const bf16_t* A, const bf16_t* Bt, bf16_t* C, int ldc, int M, int N, int K) {
    pg8::Gemm g{A, Bt, M, N, K}; pg8::StaticOrder So; So.init(M, N, (int)gridDim.x, obid());
    pg8::EpiB16 E{C, ldc};
    pg8::gemm_phase<pg8::EpiB16, pg8::StaticOrder, true, true>((PG8_LAS unsigned char*)g_lds, g, So, E);
}
__device__ __forceinline__ void mgemm_qkv(const bf16_t* A, const bf16_t* Bt, bf16_t* q, const float* rope, unsigned* nrm2) {
    pg8::Gemm g{A, Bt, NTOK, 6144, D}; pg8::StaticOrder So; So.init(NTOK, 6144, (int)gridDim.x, obid());
    PG8_LAS float* rowsq = (PG8_LAS float*)(g_lds + 131072);
    pg8::EpiQKV E{q, nrm2, rowsq, rope};
    pg8::gemm_phase<pg8::EpiQKV, pg8::StaticOrder, true, true>((PG8_LAS unsigned char*)g_lds, g, So, E);
}

__device__ __forceinline__ void moe_weights(const float* gate, const float* up, const float* down, bf16_t* wgu, bf16_t* wdn) {
    const int tid = otid(), wave = __builtin_amdgcn_readfirstlane(tid >> 6), lane = tid & 63;
    constexpr int IPE = 256;
#define MW_DESC(it_) const int which = (it_) / (32 * IPE), r = (it_) - which * (32 * IPE), e = r / IPE, ii = r - e * IPE; TransF t; \
        if (which == 0) { t.W = gate + (size_t)e * D * 512; t.WT = wgu + (size_t)e * 1024 * D; t.K = D; t.ldw = 512; t.ncols = 512; t.ileave = 1; } \
        else if (which == 1) { t.W = up + (size_t)e * D * 512; t.WT = wgu + (size_t)e * 1024 * D; t.K = D; t.ldw = 512; t.ncols = 512; t.ileave = 2; } \
        else { t.W = down + (size_t)e * 512 * D; t.WT = wdn + (size_t)e * D * 512; t.K = 512; t.ldw = D; t.ncols = D; t.ileave = 0; }
    const int step = gridDim.x * 8, total = 3 * 32 * IPE, it0 = obid() * 8 + wave;
    const int nit = it0 < total ? (total - it0 + step - 1) / step : 0;
    if (nit > 0) {
        const int last = it0 + (nit - 1) * step;
        int it = it0, k = 0;
        float4 va[16], vb[16];
        { MW_DESC(it); t.load(ii, lane, va); }
        for (; k + 1 < nit; k += 2) {
            { MW_DESC(it + step); t.load(ii, lane, vb); }
            __builtin_amdgcn_sched_barrier(0);
            { MW_DESC(it); t.finish(ii, wave, lane, va); }
            __builtin_amdgcn_sched_barrier(0);
            { const int itn = it + 2 * step < last ? it + 2 * step : last; MW_DESC(itn); t.load(ii, lane, va); }
            __builtin_amdgcn_sched_barrier(0);
            { MW_DESC(it + step); t.finish(ii, wave, lane, vb); }
            it += 2 * step;
        }
        if (k < nit) { MW_DESC(it); t.finish(ii, wave, lane, va); }
    }
#undef MW_DESC
}
__device__ __forceinline__ void moe_gemm1(const bf16_t* Hs, const int* rowmap, const bf16_t* wgu, bf16_t* hid, const float* slot_w, const int* panel_e, const int* npan) {
    pg8::Gemm g{Hs, wgu, MAXSLOT, 1024, D}; pg8::MoeOrder So{panel_e, npan[0], 4, (int)gridDim.x, obid()};
    pg8::EpiSwiGLU E{hid, slot_w};
    pg8::gemm_phase_gather<pg8::EpiSwiGLU, pg8::MoeOrder>((PG8_LAS unsigned char*)g_lds, g, rowmap, So, E);
}
__device__ __forceinline__ void moe_gemm2(const bf16_t* hid, const bf16_t* wdn, bf16_t* y2, const int* slot_dst, const int* panel_e, const int* npan) {
    pg8::Gemm g{hid, wdn, MAXSLOT, D, 512}; pg8::MoeOrder So{panel_e, npan[0], 8, (int)gridDim.x, obid()};
    pg8::EpiScatter E{y2, slot_dst};
    pg8::gemm_phase<pg8::EpiScatter, pg8::MoeOrder, true, true>((PG8_LAS unsigned char*)g_lds, g, So, E);
}

template <int LAYER> __device__ __forceinline__ void attn_conv_phase(const AttnArgs& a, const float* gate, const float* up, const float* down, bf16_t* wgu, bf16_t* wdn) {
    constexpr int TOTAL = (LAYER == 0 ? 128 : 64) * 8;
    const int bid = obid(), G = gridDim.x, n = bid < TOTAL ? (TOTAL - bid + G - 1) / G : 0, cls = bid % 3, split = cls == 0 ? 0 : (cls == 1 ? n / 2 : n);
    FoxPair fp; fp.probA = fp.probB = fp.x = 0; fp.paired = false;
    if (LAYER == 1) fp = fox_pairing(a);
    attn_stream<LAYER>(a, fp, 0, split);
    __syncthreads();
    moe_weights(gate, up, down, wgu, wdn);
    __syncthreads();
    attn_stream<LAYER>(a, fp, split, n);
}

typedef const __attribute__((address_space(4))) Params* KParamsPtr;
__device__ __forceinline__ KParamsPtr kp() { KParamsPtr q = (KParamsPtr)__builtin_amdgcn_kernarg_segment_ptr(); asm volatile("" : "+s"(q)); return q; }
__global__ void __launch_bounds__(NTHR, 2) fwd_kernel(Params p_arg) {
#define p (*kp())
    for (int u = threadIdx.x; u < (LDS_BYTES - LDSCTL_OFF) / 4; u += NTHR) ((LAS unsigned*)(g_lds + LDSCTL_OFF))[u] = 0u;
    __syncthreads();
    const XcdBarrier bar = xcd_barrier_post(p.bar, (volatile LAS unsigned*)(g_lds + LDSCTL_OFF + 64));

    { ModF f; f.c = p.c; f.w0 = p.mix_mod_w; f.w1 = p.ffn_mod_w; f.modp = p.modp; run_nb(f, 768); }
    __syncthreads();
    { RopeTableF f; f.tab = p.ropet; run_nb(f, S * 64 / NTHR); }
    { SmallWF f; f.wg = p.moe_wg; f.wr = p.moe_wr; f.bwin = p.b_w_in; f.rhi = p.rhi; f.rlo = p.rlo; f.fhi = p.fhi; f.flo = p.flo; run_nb(f, (2 * 48 * D + 16 * D) / NTHR); }
    { LamF f; f.q1 = p.a_lq1; f.k1 = p.a_lk1; f.q2 = p.a_lq2; f.k2 = p.a_lk2; f.lam = p.lam; if (obid() == gridDim.x - 1) f(0); }
    { TransF t; t.W = p.a_w_in; t.WT = p.wt_in[0]; t.K = D; t.ldw = 6144; t.ncols = 6144; t.ileave = 3; t.run(); }
    { TransF t; t.W = p.b_w_in; t.WT = p.wt_in[1]; t.K = D; t.ldw = 6160; t.ncols = 6144; t.ileave = 0; t.run(); }
    { TransF t; t.W = p.a_w_out; t.WT = p.wt_out[0]; t.K = D; t.ldw = D; t.ncols = D; t.ileave = 0; t.run(); }
    { TransF t; t.W = p.b_w_out; t.WT = p.wt_out[1]; t.K = D; t.ldw = D; t.ncols = D; t.ileave = 0; t.run(); }
    xcd_barrier(bar);
    { ModRedF f; f.modp = p.modp; f.b0 = p.mix_mod_b; f.b1 = p.ffn_mod_b; f.out = p.modv; run_nb(f, 4 * NB * 3 * D / NTHR); }
    { Mod0F f; f.x = p.x; f.modp = p.modp; f.bias = p.mix_mod_b; f.hb = p.hb; f.run(); }
    xcd_barrier(bar);
    const float scale = 0.08838834764831845f;

    const float* xin = p.x;
#pragma unroll 1
    for (int layer = 0; layer < 2; ++layer) {
        const float* modm = p.modv + (size_t)(2 * layer) * NB * 3 * D; const float* modf = p.modv + (size_t)(2 * layer + 1) * NB * 3 * D;
        if (layer == 1) { CumBF f; f.flog = p.flog; f.fb = p.b_fb; f.bz = p.bz; run_nb(f, NB * 16); __syncthreads(); }
        mgemm_qkv(p.hb, p.wt_in[layer], p.qh, layer == 0 ? p.ropet : nullptr, layer == 1 ? p.nrm2 : nullptr);
        xcd_barrier(bar);
        AttnArgs aa; aa.q = p.qh; aa.k = p.kh; aa.v = p.vh; aa.o0 = layer == 0 ? p.o1 : p.ob; aa.o1 = p.o2; aa.bz = p.bz; aa.nrm2 = p.nrm2;
        if (layer == 0) {
            attn_conv_phase<0>(aa, p.moe_gate, p.moe_up, p.moe_down, p.wgu, p.wdn);
            xcd_barrier(bar);
            { CombineF f; f.o1 = p.o1; f.o2 = p.o2; f.lam = p.lam; f.w = p.a_subln; f.ob = p.ob; f.run(NTOK * 8 / 8 / 4); xcd_barrier(bar); }
        } else {
            attn_conv_phase<1>(aa, p.moe_gate + (size_t)32 * D * 512, p.moe_up + (size_t)32 * D * 512, p.moe_down + (size_t)32 * 512 * D, p.wgu1, p.wdn1);
            xcd_barrier(bar);
        }
        { InitF f; f.cnt = p.cnt; f.slot_token = p.slot_token; f.panel_e = p.panel_e; f.nrm2 = layer == 0 ? p.nrm2 : nullptr; run_nb(f, MAXSLOT / NTHR); }
        mgemm_b16(p.ob, p.wt_out[layer], p.yb16, D, NTOK, D, D);
        xcd_barrier(bar);
#define ROWF0_ARGS f.y = p.yb16; f.yb = nullptr; f.modg = modm; f.g = p.mix_ln_g + (size_t)layer * D; f.bta = p.mix_ln_b + (size_t)layer * D; f.out = nullptr; f.outb = p.xAb; \
          f.modn = modf; f.hb = p.hb; f.whi = p.rhi + (size_t)layer * 48 * D; f.wlo = p.rlo + (size_t)layer * 48 * D; \
          f.bg = p.moe_bg + layer * 4; f.br = p.moe_br + layer * 32; f.wgcnt = p.wgcnt; f.tok_e = p.tok_e; f.tok_pos = p.tok_pos; f.tok_w = p.tok_w; f.flog = nullptr
        if (layer == 0) { RowF<0, false> f; f.x = p.x; f.xb = nullptr; ROWF0_ARGS; f.run(NTOK / 16); }
        else { RowF<0, true> f; f.x = nullptr; f.xb = p.xBb; ROWF0_ARGS; f.run(NTOK / 16); }
#undef ROWF0_ARGS
        xcd_barrier(bar);
        { ScatF f; f.wgcnt = p.wgcnt; f.tok_e = p.tok_e; f.tok_pos = p.tok_pos; f.tok_w = p.tok_w; f.slot_token = p.slot_token; f.slot_w = p.slot_w; f.panel_e = p.panel_e; f.npan = p.npan;
          phase(f, (2 * NTOK + 32 * 256) / NTHR, bar); }
        moe_gemm1(p.hb, p.slot_token, layer == 0 ? p.wgu : p.wgu1, p.hid, p.slot_w, p.panel_e, p.npan);
        xcd_barrier(bar);
        moe_gemm2(p.hid, layer == 0 ? p.wdn : p.wdn1, p.y2b, p.slot_token, p.panel_e, p.npan);
        xcd_barrier(bar);
        if (layer == 0) {
            RowF<1, true> f; f.x = nullptr; f.xb = p.xAb; f.y = nullptr; f.yb = p.y2b; f.modg = modf; f.g = p.ffn_ln_g; f.bta = p.ffn_ln_b; f.out = nullptr; f.outb = p.xBb;
            f.modn = p.modv + (size_t)2 * NB * 3 * D; f.hb = p.hb; f.whi = p.fhi; f.wlo = p.flo;
            f.bg = nullptr; f.br = nullptr; f.wgcnt = nullptr; f.tok_e = nullptr; f.tok_pos = nullptr; f.tok_w = nullptr; f.flog = p.flog;
            f.run(NTOK / 16);
        } else {
            RowF<2, true> f; f.x = nullptr; f.xb = p.xAb; f.outb = nullptr; f.y = nullptr; f.yb = p.y2b; f.modg = modf; f.g = p.ffn_ln_g + (size_t)layer * D; f.bta = p.ffn_ln_b + (size_t)layer * D; f.out = p.out;
            f.modn = nullptr; f.hb = nullptr; f.whi = nullptr; f.wlo = nullptr; f.bg = nullptr; f.br = nullptr; f.wgcnt = nullptr; f.tok_e = nullptr; f.tok_pos = nullptr; f.tok_w = nullptr; f.flog = nullptr;
            f.run(NTOK / 16);
        }
        if (layer == 0) xcd_barrier(bar);
        xin = p.xB;
    }
#undef p
}
}

extern "C" void kernel_launch(void* const* d_in, const int* in_sizes, int n_in, void* d_out, int out_size, void* d_ws, size_t ws_size, hipStream_t stream) {
    (void)in_sizes; (void)out_size;
    if (n_in != 27) { fprintf(stderr, "kernel_launch: expected 27 inputs, got %d\n", n_in); return; }
    Params p; memset(&p, 0, sizeof(p));
    p.x = (const float*)d_in[0]; p.c = (const float*)d_in[1];
    p.mix_mod_w = (const float*)d_in[2]; p.mix_mod_b = (const float*)d_in[3]; p.mix_ln_g = (const float*)d_in[4]; p.mix_ln_b = (const float*)d_in[5];
    p.a_w_in = (const float*)d_in[6]; p.a_lq1 = (const float*)d_in[7]; p.a_lk1 = (const float*)d_in[8]; p.a_lq2 = (const float*)d_in[9]; p.a_lk2 = (const float*)d_in[10];
    p.a_subln = (const float*)d_in[11]; p.a_w_out = (const float*)d_in[12];
    p.b_w_in = (const float*)d_in[13]; p.b_fb = (const float*)d_in[14]; p.b_w_out = (const float*)d_in[15];
    p.ffn_mod_w = (const float*)d_in[16]; p.ffn_mod_b = (const float*)d_in[17]; p.ffn_ln_g = (const float*)d_in[18]; p.ffn_ln_b = (const float*)d_in[19];
    p.moe_wg = (const float*)d_in[20]; p.moe_bg = (const float*)d_in[21]; p.moe_wr = (const float*)d_in[22]; p.moe_br = (const float*)d_in[23];
    p.moe_gate = (const float*)d_in[24]; p.moe_up = (const float*)d_in[25]; p.moe_down = (const float*)d_in[26];
    p.out = (float*)d_out;

    size_t off = 0; float* ws = (float*)d_ws;
    auto take = [&](size_t n) { float* q = ws + off; off += (n + 63) & ~(size_t)63; return q; };
    p.bar = (unsigned*)take(XCD_BAR_WORDS);
    p.modv = take((size_t)4 * NB * 3 * D); p.modp = take((size_t)16 * 4 * NB * 3 * D);
    p.ropet = take((size_t)S * 64 * 2);
    p.lam = take(64);
    p.cum = take((size_t)16 * S); p.flog = take((size_t)NTOK * 16); p.bz = take((size_t)NB * 16 * S);
    p.cnt = (int*)take(64); p.wgcnt = (int*)take(256 * 32); p.nrm2 = (unsigned*)take(512);
    p.tok_e = (int*)take(2 * NTOK); p.tok_pos = (int*)take(2 * NTOK); p.tok_w = take(2 * NTOK); p.tok_slot = (int*)take(2 * NTOK);
    p.slot_token = (int*)take(MAXSLOT); p.slot_w = take(MAXSLOT); p.panel_e = (int*)take(256);
    p.wt_in[0] = (bf16_t*)take((size_t)6144 * D / 2); p.wt_in[1] = (bf16_t*)take((size_t)6144 * D / 2);
    p.wt_out[0] = (bf16_t*)take((size_t)D * D / 2); p.wt_out[1] = (bf16_t*)take((size_t)D * D / 2);
    p.hb = (bf16_t*)take((size_t)NTOK * D / 2); p.ob = (bf16_t*)take((size_t)NTOK * D / 2);
    p.xA = nullptr; p.xB = nullptr; p.xAb = (bf16_t*)take((size_t)NTOK * D / 2); p.xBb = (bf16_t*)take((size_t)NTOK * D / 2); p.yb16 = (bf16_t*)take((size_t)NTOK * D / 2);
    p.rhi = (bf16_t*)take((size_t)2 * 48 * D / 2); p.rlo = (bf16_t*)take((size_t)2 * 48 * D / 2); p.fhi = (bf16_t*)take((size_t)16 * D / 2); p.flo = (bf16_t*)take((size_t)16 * D / 2);
    p.wgu = (bf16_t*)take((size_t)32 * 1024 * D / 2); p.wdn = (bf16_t*)take((size_t)32 * D * 512 / 2);
    p.wgu1 = (bf16_t*)take((size_t)32 * 1024 * D / 2); p.wdn1 = (bf16_t*)take((size_t)32 * D * 512 / 2); p.npan = (int*)take(64);
    float* region = ws + off;
    p.qh = (bf16_t*)take((size_t)NTOK * D / 2); p.kh = (bf16_t*)take((size_t)NTOK * D / 2); p.vh = (bf16_t*)take((size_t)NTOK * D / 2);
    p.o1 = (bf16_t*)take((size_t)NTOK * D / 2); p.o2 = (bf16_t*)take((size_t)NTOK * D / 2);
    take((size_t)3 << 20);
    p.Hs = (bf16_t*)region; p.hid = p.Hs + (size_t)MAXSLOT * D; p.y2b = p.hid + (size_t)MAXSLOT * 512;
    if (off * sizeof(float) > ws_size) { fprintf(stderr, "kernel_launch: workspace too small (%zu > %zu)\n", off * sizeof(float), ws_size); return; }

    static int grid = 0;
    if (!grid) { int dev = 0, cus = 0; (void)hipGetDevice(&dev);
        if (hipDeviceGetAttribute(&cus, hipDeviceAttributeMultiprocessorCount, dev) != hipSuccess || cus <= 0) cus = 256;
        if (hipFuncSetAttribute((const void*)fwd_kernel, hipFuncAttributeMaxDynamicSharedMemorySize, LDS_BYTES) != hipSuccess) fprintf(stderr, "kernel_launch: hipFuncSetAttribute failed\n");
        grid = cus; }
    (void)hipMemsetAsync(p.bar, 0, XCD_BAR_WORDS * sizeof(unsigned), stream);
    hipLaunchKernelGGL(fwd_kernel, dim3(grid), dim3(NTHR), LDS_BYTES, stream, p);
}
```
